# Optimizing an MI355X kernel written in HIP

```python
import jax, jax.numpy as jnp
from jax import lax
import numpy as np

D_MODEL = 1024
BATCH = 4
SEQ = 4096
DEPTH = 4

GRID_W = 64
CTX_LEN = 256
EPS = 1e-6
F_FLOOR = 1e-20
N_MOD = 6
HG_WIDTH = 512
HG_HEADS = 4
HG_DIM = HG_WIDTH // HG_HEADS
CHUNK = 16
SC_WIDTH = 512
SC_HALF = SC_WIDTH // 2
CONV_W = 3
IN_COLS = 5 * HG_WIDTH + 3 * SC_WIDTH
SPLITS = tuple(HG_WIDTH * i for i in range(1, 6)) + (5 * HG_WIDTH + SC_WIDTH, 5 * HG_WIDTH + 2 * SC_WIDTH)
PEER_HEADS = 8
PEER_QDIM = 256
PEER_HALF = PEER_QDIM // 2
N_KEYS = 128
N_EXPERTS = N_KEYS * N_KEYS
PEER_TOPK = 16
PEER_BLOCK = 128

kernel_name = 'hybrid_hgrn2_shortconv_peer_dit'


def rms_norm(x, g):
    xf = x.astype(jnp.float32)
    y = xf * lax.rsqrt(jnp.mean(xf * xf, axis=-1, keepdims=True) + EPS)
    return (y * g.astype(jnp.float32)).astype(x.dtype)


def modulate(h, shift, scale):
    return h * (1 + scale) + shift


def to_heads(a):
    return a.reshape(a.shape[0], a.shape[1], HG_HEADS, HG_DIM).astype(jnp.float32)


def flip(a):
    return a[:, ::-1]


def forget_terms(z, lb):
    f = lb + (1.0 - lb) * jax.nn.sigmoid(z)
    logf = jnp.log(jnp.maximum(f, F_FLOOR))
    key = (1.0 - lb) * jax.nn.sigmoid(-z)
    return logf, key


def gla_chunk(q, k, v, logf, s0):
    bsz, t, h, _ = q.shape
    dv = v.shape[-1]
    n = t // CHUNK
    q, k, v, logf = (a.reshape(bsz, n, CHUNK, h, a.shape[-1]) for a in (q, k, v, logf))
    b = jnp.cumsum(logf, axis=2)
    mask = jnp.tril(jnp.ones((CHUNK, CHUNK), bool))[None, None, :, :, None, None]
    diff = b[:, :, :, None] - b[:, :, None, :]
    decay = jnp.where(mask, jnp.exp(jnp.where(mask, diff, 0.0)), 0.0)
    att = jnp.einsum('bnthk,bntshk,bnshk->bnhts', q, decay, k)
    o_intra = jnp.einsum('bnhts,bnshv->bnthv', att, v)
    b_last = b[:, :, -1]
    q_in = q * jnp.exp(b)
    k_out = k * jnp.exp(b_last[:, :, None] - b)

    def step(s, xs):
        qc, kc, vc, dc = xs
        o = jnp.einsum('bchk,bhkv->bchv', qc, s)
        s = dc[..., None] * s + jnp.einsum('bchk,bchv->bhkv', kc, vc)
        return s, o

    xs = tuple(jnp.moveaxis(a, 1, 0) for a in (q_in, k_out, v, jnp.exp(b_last)))
    s_final, o_inter = lax.scan(step, s0, xs)
    o = o_intra + jnp.moveaxis(o_inter, 0, 1)
    return o.reshape(bsz, t, h, dv), s_final


def gla_final_state(k, v, logf):
    b = jnp.cumsum(logf, axis=1)
    kd = k * jnp.exp(b[:, -1:] - b)
    return jnp.einsum('bthk,bthv->bhkv', kd, v)


def hgrn2_mix(q, iv, zf, zb, g, lbf, lbb, s0f, s0b):
    q, iv, zf, zb = (to_heads(a) for a in (q, iv, zf, zb))
    logf_f, k_f = forget_terms(zf, lbf)
    o_f, s_f = gla_chunk(q, k_f, iv, logf_f, s0f)
    logf_b, k_b = forget_terms(zb, lbb)
    o_b, s_b = gla_chunk(flip(q), flip(k_b), flip(iv), flip(logf_b), s0b)
    o = o_f + flip(o_b)
    o = o * lax.rsqrt(jnp.mean(o * o, axis=-1, keepdims=True) + EPS)
    o = o.reshape(g.shape).astype(g.dtype) * jax.nn.silu(g)
    return o, s_f, s_b


def hgrn2_final_states(iv, zf, zb, lbf, lbb):
    iv, zf, zb = (to_heads(a) for a in (iv, zf, zb))
    logf_f, k_f = forget_terms(zf, lbf)
    s_f = gla_final_state(k_f, iv, logf_f)
    logf_b, k_b = forget_terms(zb, lbb)
    s_b = gla_final_state(flip(k_b), flip(iv), flip(logf_b))
    return s_f, s_b


def conv3(u, w, axis):
    n = u.shape[axis]
    pad = [(0, 0)] * u.ndim
    pad[axis] = (1, 1)
    up = jnp.pad(u, pad)
    return (w[0] * lax.slice_in_dim(up, 0, n, axis=axis)
            + w[1] * lax.slice_in_dim(up, 1, n + 1, axis=axis)
            + w[2] * lax.slice_in_dim(up, 2, n + 2, axis=axis))


def grid_conv(u, w, rows):
    bsz, t, ch = u.shape
    grid = u.reshape(bsz, rows, GRID_W, ch)
    horiz = conv3(grid[..., :SC_HALF], w[:, :SC_HALF], axis=2)
    vert = conv3(grid[..., SC_HALF:], w[:, SC_HALF:], axis=1)
    return jnp.concatenate([horiz, vert], axis=-1).reshape(bsz, t, ch)


def seq_conv(u, w):
    return conv3(u, w, axis=1)


def token_mixer(h, w_in_l, w_out_l, conv_w_l, lbf, lbb, s0f, s0b, conv_fn):
    iv, zf, zb, q, g, cg, bg, hv = jnp.split(h @ w_in_l, SPLITS, axis=-1)
    o_rec, s_f, s_b = hgrn2_mix(q, iv, zf, zb, g, lbf, lbb, s0f, s0b)
    o_conv = bg * conv_fn(cg * hv, conv_w_l)
    y = jnp.concatenate([o_rec, o_conv], axis=-1) @ w_out_l
    return y, s_f, s_b


def peer_ffn(h, wq, subkeys, u, v):
    bsz, t, d = h.shape
    qr = (h @ wq).astype(jnp.float32).reshape(bsz, t, PEER_HEADS, 2, PEER_HALF)
    scores = jnp.einsum('bthpd,hpkd->bthpk', qr, subkeys.astype(jnp.float32))
    s1, i1 = lax.top_k(scores[..., 0, :], PEER_TOPK)
    s2, i2 = lax.top_k(scores[..., 1, :], PEER_TOPK)
    n_cand = PEER_TOPK * PEER_TOPK
    cand = (s1[..., :, None] + s2[..., None, :]).reshape(bsz, t, PEER_HEADS, n_cand)
    cidx = (i1[..., :, None] * N_KEYS + i2[..., None, :]).reshape(bsz, t, PEER_HEADS, n_cand)
    top, pos = lax.top_k(cand, PEER_TOPK)
    eidx = jnp.take_along_axis(cidx, pos, axis=-1)
    gate = jax.nn.softmax(top, axis=-1).astype(h.dtype)
    n_blk = bsz * t // PEER_BLOCK
    n_sel = PEER_HEADS * PEER_TOPK
    hb = h.reshape(n_blk, PEER_BLOCK, d)
    eb = eidx.reshape(n_blk, PEER_BLOCK, n_sel)
    gb = gate.reshape(n_blk, PEER_BLOCK, n_sel)

    def block(args):
        hk, ek, gk = args
        act = jax.nn.gelu(jnp.einsum('ted,td->te', u[ek], hk), approximate=False)
        return jnp.einsum('te,ted->td', gk * act, v[ek])

    return lax.map(block, (hb, eb, gb)).reshape(bsz, t, d)


def setup_inputs(seed: int = 0) -> dict:
    key = jax.random.key(seed)
    ks = jax.random.split(key, 17)
    nrm = lambda k, shape, scale: jax.random.normal(k, shape, jnp.float32) * scale
    mix_w = HG_WIDTH + SC_WIDTH
    return {
        'x': nrm(ks[0], (BATCH, SEQ, D_MODEL), 1.0),
        'c': nrm(ks[1], (BATCH, D_MODEL), 1.0),
        'ctx': nrm(ks[2], (BATCH, CTX_LEN, D_MODEL), 1.0),
        'c_ctx': nrm(ks[3], (D_MODEL,), 1.0),
        'w_mod': nrm(ks[4], (DEPTH, D_MODEL, N_MOD * D_MODEL), 0.5 * D_MODEL ** -0.5),
        'b_mod': nrm(ks[5], (DEPTH, N_MOD * D_MODEL), 0.01),
        'norm1_g': 1.0 + nrm(ks[6], (DEPTH, D_MODEL), 0.1),
        'norm2_g': 1.0 + nrm(ks[7], (DEPTH, D_MODEL), 0.1),
        'w_in': nrm(ks[8], (DEPTH, D_MODEL, IN_COLS), D_MODEL ** -0.5),
        'conv_w': nrm(ks[9], (DEPTH, CONV_W, SC_WIDTH), CONV_W ** -0.5),
        'w_out': nrm(ks[10], (DEPTH, mix_w, D_MODEL), mix_w ** -0.5),
        'lb_logits': nrm(ks[11], (DEPTH, 2, HG_WIDTH), 0.5),
        'peer_wq': nrm(ks[12], (DEPTH, D_MODEL, PEER_HEADS * PEER_QDIM), D_MODEL ** -0.5),
        'peer_subkeys': nrm(ks[13], (DEPTH, PEER_HEADS, 2, N_KEYS, PEER_HALF), PEER_HALF ** -0.5),
        'peer_u': nrm(ks[14], (DEPTH, N_EXPERTS, D_MODEL), D_MODEL ** -0.5),
        'peer_v': nrm(ks[15], (DEPTH, N_EXPERTS, D_MODEL), PEER_HEADS ** -0.5),
        'final_g': 1.0 + nrm(ks[16], (D_MODEL,), 0.1),
    }


def reference(x, c, ctx, c_ctx, w_mod, b_mod, norm1_g, norm2_g, w_in, conv_w, w_out,
              lb_logits, peer_wq, peer_subkeys, peer_u, peer_v, final_g):
    rows = x.shape[1] // GRID_W
    p_lb = jax.nn.softmax(lb_logits.astype(jnp.float32), axis=0)
    lower = jnp.cumsum(p_lb, axis=0) - p_lb[0]
    cond_x = jax.nn.silu(c)
    cond_c = jax.nn.silu(c_ctx)
    latent_conv = lambda u, w: grid_conv(u, w, rows)
    zero_state = jnp.zeros((ctx.shape[0], HG_HEADS, HG_DIM, HG_DIM), jnp.float32)
    xc = ctx
    for l in range(DEPTH):
        lbf = lower[l, 0].reshape(HG_HEADS, HG_DIM)
        lbb = lower[l, 1].reshape(HG_HEADS, HG_DIM)
        mod_x = (cond_x @ w_mod[l] + b_mod[l])[:, None, :]
        mod_c = (cond_c @ w_mod[l] + b_mod[l])[None, None, :]
        sh1x, sc1x, g1x, sh2x, sc2x, g2x = jnp.split(mod_x, N_MOD, axis=-1)
        sh1c, sc1c, g1c, sh2c, sc2c, g2c = jnp.split(mod_c, N_MOD, axis=-1)
        hc = modulate(rms_norm(xc, norm1_g[l]), sh1c, sc1c)
        if l < DEPTH - 1:
            yc, s_f, s_b = token_mixer(hc, w_in[l], w_out[l], conv_w[l], lbf, lbb,
                                       zero_state, zero_state, seq_conv)
            xc = xc + g1c * yc
            hc2 = modulate(rms_norm(xc, norm2_g[l]), sh2c, sc2c)
            xc = xc + g2c * peer_ffn(hc2, peer_wq[l], peer_subkeys[l], peer_u[l], peer_v[l])
        else:
            iv_c, zf_c, zb_c = jnp.split(hc @ w_in[l][:, :3 * HG_WIDTH], 3, axis=-1)
            s_f, s_b = hgrn2_final_states(iv_c, zf_c, zb_c, lbf, lbb)
        hx = modulate(rms_norm(x, norm1_g[l]), sh1x, sc1x)
        yx, _, _ = token_mixer(hx, w_in[l], w_out[l], conv_w[l], lbf, lbb, s_f, s_b, latent_conv)
        x = x + g1x * yx
        hx2 = modulate(rms_norm(x, norm2_g[l]), sh2x, sc2x)
        x = x + g2x * peer_ffn(hx2, peer_wq[l], peer_subkeys[l], peer_u[l], peer_v[l])
    return rms_norm(x, final_g)
```

```cpp
#include <hip/hip_runtime.h>
#include <hip/hip_cooperative_groups.h>
#include <stdint.h>
#include <stdio.h>
namespace cg = cooperative_groups;

#ifndef MULTI_LAUNCH
#define MULTI_LAUNCH 1
#endif

#define DI __device__ __forceinline__
typedef unsigned short u16;
using bf16x8 = __attribute__((ext_vector_type(8))) short;
using f32x16 = __attribute__((ext_vector_type(16))) float;
using u32x4  = __attribute__((ext_vector_type(4))) unsigned;
using u32x2  = __attribute__((ext_vector_type(2))) unsigned;
using f32x4  = __attribute__((ext_vector_type(4))) float;

constexpr int D = 1024, NLAT = 16384, NCTX = 1024, NTOK = 17408, DEPTH = 4, INC = 4096;
constexpr int SEQ = 4096, CTXL = 256, BATCH = 4;
constexpr int NTHR = 512;
constexpr int NEXP = 16384;
constexpr float EPS = 1e-6f;

constexpr size_t al256(size_t x) { return (x + 255) & ~(size_t)255; }
constexpr size_t WS_BAR   = 0;
constexpr size_t WS_MOD   = 16384;
constexpr size_t WS_LOWER = WS_MOD + al256((size_t)4 * 5 * 6144 * 4);
constexpr size_t WS_XW    = WS_LOWER + al256((size_t)4 * 2 * 512 * 4);
constexpr size_t WS_HX    = WS_XW + (size_t)NTOK * D * 4;
constexpr size_t WS_Z     = WS_HX + (size_t)NTOK * D * 2;
constexpr size_t WS_CAT   = WS_Z + (size_t)NTOK * INC * 2;
constexpr size_t WS_OF    = WS_CAT + (size_t)NTOK * D * 2;
constexpr size_t WS_OB    = WS_OF + (size_t)NTOK * 512 * 4;
constexpr size_t WS_TOPK  = WS_OB + (size_t)NTOK * 512 * 4;
constexpr size_t WS_WIN   = WS_TOPK + (size_t)NTOK * 256 * 4;
constexpr size_t WS_WOUT  = WS_WIN + (size_t)4 * 4096 * 1024 * 2;
constexpr size_t WS_WS    = WS_WOUT + (size_t)4 * 1024 * 1024 * 2;
constexpr size_t WS_UB    = WS_WS + (size_t)4 * 2048 * 1024 * 2;
constexpr size_t WS_VB    = WS_UB + (size_t)4 * NEXP * D * 2;
constexpr size_t WS_END   = WS_VB + (size_t)4 * NEXP * D * 2;

struct Params {
  const float* x; const float* c; const float* ctx; const float* c_ctx; const float* w_mod; const float* b_mod;
  const float* norm1_g; const float* norm2_g; const float* w_in; const float* conv_w; const float* w_out;
  const float* lb_logits; const float* peer_wq; const float* peer_subkeys; const float* peer_u; const float* peer_v;
  const float* final_g; float* out; unsigned char* ws;
  int ph_lo, ph_hi;
};

DI u16 f2bf(float x) { unsigned u = __float_as_uint(x); u += 0x7fffu + ((u >> 16) & 1u); return (u16)(u >> 16); }
DI float bf2f(u16 b) { return __uint_as_float(((unsigned)b) << 16); }
DI unsigned pack2(float a, float b) { return (unsigned)f2bf(a) | ((unsigned)f2bf(b) << 16); }
DI float bflo(unsigned w) { return __uint_as_float(w << 16); }
DI float bfhi(unsigned w) { return __uint_as_float(w & 0xffff0000u); }
DI float sigmoidf_(float x) { return 1.f / (1.f + __expf(-x)); }
DI float siluf_(float x) { return x / (1.f + __expf(-x)); }
DI float wave_sum(float v) {
#pragma unroll
  for (int o = 32; o >= 1; o >>= 1) v += __shfl_xor(v, o);
  return v;
}
DI int row_cls(int row) { return row < NLAT ? (row >> 12) : 4; }

DI void p0_mod(const Params& p, float* smem, int item, int tid) {
  const int l = item / 48, ng = item % 48;
  float* cond = smem;
  float* red = smem + 5 * 1024;
  for (int i = tid; i < 5 * 1024; i += NTHR) {
    const int r = i >> 10, k = i & 1023;
    const float v = r < 4 ? p.c[r * 1024 + k] : p.c_ctx[k];
    cond[i] = siluf_(v);
  }
  __syncthreads();
  const int col = tid & 127, ks = tid >> 7, n = ng * 128 + col;
  float a0 = 0, a1 = 0, a2 = 0, a3 = 0, a4 = 0;
  const float* w = p.w_mod + (size_t)l * 1024 * 6144 + n;
  for (int k = ks * 256; k < ks * 256 + 256; ++k) {
    const float wv = w[(size_t)k * 6144];
    a0 += cond[k] * wv; a1 += cond[1024 + k] * wv; a2 += cond[2048 + k] * wv; a3 += cond[3072 + k] * wv; a4 += cond[4096 + k] * wv;
  }
  red[(ks * 5 + 0) * 128 + col] = a0; red[(ks * 5 + 1) * 128 + col] = a1; red[(ks * 5 + 2) * 128 + col] = a2;
  red[(ks * 5 + 3) * 128 + col] = a3; red[(ks * 5 + 4) * 128 + col] = a4;
  __syncthreads();
  float* mod = (float*)(p.ws + WS_MOD);
  for (int i = tid; i < 5 * 128; i += NTHR) {
    const int r = i >> 7, cc = i & 127;
    const float s = red[(0 * 5 + r) * 128 + cc] + red[(1 * 5 + r) * 128 + cc] + red[(2 * 5 + r) * 128 + cc] + red[(3 * 5 + r) * 128 + cc];
    mod[((size_t)l * 5 + r) * 6144 + ng * 128 + cc] = s + p.b_mod[l * 6144 + ng * 128 + cc];
  }
  __syncthreads();
}

DI void p0_transpose_tile(const float* src, u16* dst, int K, int N, int k0, int n0, float* smem, int tid) {
  float* t = smem;
  {
    const int i = tid >> 4, j4 = (tid & 15) * 4;
#pragma unroll
    for (int pp = 0; pp < 2; ++pp) {
      const int ii = i + pp * 32;
      const float4 v = *(const float4*)(src + (size_t)(k0 + ii) * N + n0 + j4);
      t[ii * 65 + j4 + 0] = v.x; t[ii * 65 + j4 + 1] = v.y; t[ii * 65 + j4 + 2] = v.z; t[ii * 65 + j4 + 3] = v.w;
    }
  }
  __syncthreads();
  {
    const int j = tid >> 3, i8 = (tid & 7) * 8;
    u32x4 o;
    o[0] = pack2(t[(i8 + 0) * 65 + j], t[(i8 + 1) * 65 + j]);
    o[1] = pack2(t[(i8 + 2) * 65 + j], t[(i8 + 3) * 65 + j]);
    o[2] = pack2(t[(i8 + 4) * 65 + j], t[(i8 + 5) * 65 + j]);
    o[3] = pack2(t[(i8 + 6) * 65 + j], t[(i8 + 7) * 65 + j]);
    *(u32x4*)(dst + (size_t)(n0 + j) * K + k0 + i8) = o;
  }
  __syncthreads();
}

DI void p0_ws_item(const Params& p, float* smem, int item, int tid) {
  const int l = item >> 8, hp = (item >> 4) & 15, kt = item & 15;
  float* sk = smem;
  float* wqt = smem + 128 * 129;
  const float* skg = p.peer_subkeys + ((size_t)l * 16 + hp) * 128 * 128;
  for (int i = tid; i < 128 * 128; i += NTHR) sk[(i >> 7) * 129 + (i & 127)] = skg[i];
  const float* wqg = p.peer_wq + (size_t)l * 1024 * 2048 + (size_t)(kt * 64) * 2048 + hp * 128;
  for (int i = tid; i < 64 * 128; i += NTHR) wqt[i] = wqg[(size_t)(i >> 7) * 2048 + (i & 127)];
  __syncthreads();
  const int key = tid & 127, kq = tid >> 7;
  float acc[16];
#pragma unroll
  for (int j = 0; j < 16; ++j) acc[j] = 0.f;
  for (int d = 0; d < 128; ++d) {
    const float s = sk[key * 129 + d];
#pragma unroll
    for (int j = 0; j < 16; ++j) acc[j] += s * wqt[(kq * 16 + j) * 128 + d];
  }
  u16* dst = (u16*)(p.ws + WS_WS) + ((size_t)l * 2048 + hp * 128 + key) * 1024 + kt * 64 + kq * 16;
  u32x4 o0, o1;
  o0[0] = pack2(acc[0], acc[1]); o0[1] = pack2(acc[2], acc[3]); o0[2] = pack2(acc[4], acc[5]); o0[3] = pack2(acc[6], acc[7]);
  o1[0] = pack2(acc[8], acc[9]); o1[1] = pack2(acc[10], acc[11]); o1[2] = pack2(acc[12], acc[13]); o1[3] = pack2(acc[14], acc[15]);
  *(u32x4*)dst = o0; *(u32x4*)(dst + 8) = o1;
  __syncthreads();
}

DI void p0_cvt_chunk(const float* src, u16* dst, size_t e0, int tid) {
#pragma unroll 4
  for (int i = 0; i < 16; ++i) {
    const size_t e = e0 + ((size_t)i * NTHR + tid) * 8;
    const float4 a = *(const float4*)(src + e), b = *(const float4*)(src + e + 4);
    u32x4 o; o[0] = pack2(a.x, a.y); o[1] = pack2(a.z, a.w); o[2] = pack2(b.x, b.y); o[3] = pack2(b.z, b.w);
    *(u32x4*)(dst + e) = o;
  }
}

constexpr int P0_N_MOD = 192, P0_N_TIN = 4096, P0_N_TOUT = 1024, P0_N_WS = 1024, P0_N_UV = 1024, P0_N_XW = 272;
constexpr int P0_TOTAL = 1 + P0_N_MOD + P0_N_TIN + P0_N_TOUT + P0_N_WS + 2 * P0_N_UV + P0_N_XW;

DI void phase_p0a(const Params& p, float* smem, int bid, int nb, int tid) {
  for (int it = bid; it < P0_TOTAL; it += nb) {
    int i = it;
    if (i == 0) {
      float* lower = (float*)(p.ws + WS_LOWER);
      for (int e = tid; e < 1024; e += NTHR) {
        const float a0 = p.lb_logits[e], a1 = p.lb_logits[1024 + e], a2 = p.lb_logits[2048 + e], a3 = p.lb_logits[3072 + e];
        const float m = fmaxf(fmaxf(a0, a1), fmaxf(a2, a3));
        const float e0 = expf(a0 - m), e1 = expf(a1 - m), e2 = expf(a2 - m), e3 = expf(a3 - m);
        const float inv = 1.f / (e0 + e1 + e2 + e3);
        lower[e] = 0.f; lower[1024 + e] = e1 * inv; lower[2048 + e] = (e1 + e2) * inv; lower[3072 + e] = (e1 + e2 + e3) * inv;
      }
      continue;
    }
    i -= 1;
    if (i < P0_N_MOD) { p0_mod(p, smem, i, tid); continue; }
    i -= P0_N_MOD;
    if (i < P0_N_TIN) {
      const int l = i >> 10, r = i & 1023, kt = r >> 6, nt = r & 63;
      p0_transpose_tile(p.w_in + (size_t)l * 1024 * 4096, (u16*)(p.ws + WS_WIN) + (size_t)l * 4096 * 1024, 1024, 4096, kt * 64, nt * 64, smem, tid);
      continue;
    }
    i -= P0_N_TIN;
    if (i < P0_N_TOUT) {
      const int l = i >> 8, r = i & 255, kt = r >> 4, nt = r & 15;
      p0_transpose_tile(p.w_out + (size_t)l * 1024 * 1024, (u16*)(p.ws + WS_WOUT) + (size_t)l * 1024 * 1024, 1024, 1024, kt * 64, nt * 64, smem, tid);
      continue;
    }
    i -= P0_N_TOUT;
    if (i < P0_N_WS) { p0_ws_item(p, smem, i, tid); continue; }
    i -= P0_N_WS;
    if (i < P0_N_UV) { p0_cvt_chunk(p.peer_u, (u16*)(p.ws + WS_UB), (size_t)i * 65536, tid); continue; }
    i -= P0_N_UV;
    if (i < P0_N_UV) { p0_cvt_chunk(p.peer_v, (u16*)(p.ws + WS_VB), (size_t)i * 65536, tid); continue; }
    i -= P0_N_UV;
    {
      float* xw = (float*)(p.ws + WS_XW);
      const size_t e0 = (size_t)i * 65536;
      for (int q = 0; q < 32; ++q) {
        const size_t e = e0 + ((size_t)q * NTHR + tid) * 4;
        const float4 v = e < (size_t)NLAT * D ? *(const float4*)(p.x + e) : *(const float4*)(p.ctx + (e - (size_t)NLAT * D));
        *(float4*)(xw + e) = v;
      }
    }
  }
}

DI void phase_norm(const Params& p, const float* g, int l, int sh_off, int sc_off, int bid, int nb, int row_end, int tid) {
  const int lane = tid & 63, wave = tid >> 6;
  const float* xw = (const float*)(p.ws + WS_XW);
  u16* hx = (u16*)(p.ws + WS_HX);
  const float* mod = (const float*)(p.ws + WS_MOD) + (size_t)l * 5 * 6144;
  for (int row = bid * 8 + wave; row < row_end; row += nb * 8) {
    const float* xr = xw + (size_t)row * D;
    float v[16];
    float ss = 0.f;
#pragma unroll
    for (int q = 0; q < 4; ++q) {
      const float4 a = *(const float4*)(xr + q * 256 + lane * 4);
      v[q * 4 + 0] = a.x; v[q * 4 + 1] = a.y; v[q * 4 + 2] = a.z; v[q * 4 + 3] = a.w;
      ss += a.x * a.x + a.y * a.y + a.z * a.z + a.w * a.w;
    }
    ss = wave_sum(ss);
    const float rs = rsqrtf(ss * (1.f / 1024.f) + EPS);
    const float* mr = mod + (size_t)row_cls(row) * 6144;
#pragma unroll
    for (int q = 0; q < 4; ++q) {
      const int c0 = q * 256 + lane * 4;
      const float4 gg = *(const float4*)(g + c0);
      const float4 sh = *(const float4*)(mr + sh_off + c0);
      const float4 sc = *(const float4*)(mr + sc_off + c0);
      u32x2 o;
      o[0] = pack2(v[q * 4 + 0] * rs * gg.x * (1.f + sc.x) + sh.x, v[q * 4 + 1] * rs * gg.y * (1.f + sc.y) + sh.y);
      o[1] = pack2(v[q * 4 + 2] * rs * gg.z * (1.f + sc.z) + sh.z, v[q * 4 + 3] * rs * gg.w * (1.f + sc.w) + sh.w);
      *(u32x2*)(hx + (size_t)row * D + c0) = o;
    }
  }
}

constexpr int GEMM_LDS_STAGE = 256 * 128 + 128 * 128;
enum { EPI_Z = 0, EPI_RES = 1, EPI_TOPK = 2 };

DI unsigned lds_off(int row, int c) { return (unsigned)(row * 128 + ((c ^ ((row >> 1) & 7)) << 4)); }

template <int EPI>
DI void gemm_phase(const Params& p, unsigned char* smem, const u16* A, const u16* Bt, int M, int N, int K, int l, int bid, int nb, int m_tiles_active, int tid) {
  const int lane = tid & 63, wave = tid >> 6;
  const int wm = wave >> 1, wn = wave & 1, r = lane & 31, h = lane >> 5;
  const int ntn = N / 128;
  const int ntiles = m_tiles_active * ntn;
  for (int tile = bid; tile < ntiles; tile += nb) {
    const int mt = tile / ntn, nt = tile % ntn;
    const int m0 = mt * 256, n0 = nt * 128;
    f32x16 acc[2][2];
#pragma unroll
    for (int i = 0; i < 2; ++i)
#pragma unroll
      for (int j = 0; j < 2; ++j)
#pragma unroll
        for (int e = 0; e < 16; ++e) acc[i][j][e] = 0.f;
    u32x4 ra[4], rb[2];
    const int nk = K / 64;
    auto gload = [&](int kt) {
#pragma unroll
      for (int i = 0; i < 4; ++i) {
        const int q = tid + i * NTHR, row = q >> 3, c = q & 7;
        ra[i] = *(const u32x4*)(A + (size_t)(m0 + row) * K + kt * 64 + c * 8);
      }
#pragma unroll
      for (int i = 0; i < 2; ++i) {
        const int q = tid + i * NTHR, row = q >> 3, c = q & 7;
        rb[i] = *(const u32x4*)(Bt + (size_t)(n0 + row) * K + kt * 64 + c * 8);
      }
    };
    auto lstore = [&](int buf) {
      unsigned char* sa = smem + buf * GEMM_LDS_STAGE;
      unsigned char* sb = sa + 256 * 128;
#pragma unroll
      for (int i = 0; i < 4; ++i) {
        const int q = tid + i * NTHR, row = q >> 3, c = q & 7;
        *(u32x4*)(sa + lds_off(row, c)) = ra[i];
      }
#pragma unroll
      for (int i = 0; i < 2; ++i) {
        const int q = tid + i * NTHR, row = q >> 3, c = q & 7;
        *(u32x4*)(sb + lds_off(row, c)) = rb[i];
      }
    };
    gload(0);
    lstore(0);
    __syncthreads();
    for (int kt = 0; kt < nk; ++kt) {
      if (kt + 1 < nk) gload(kt + 1);
      const unsigned char* sa = smem + (kt & 1) * GEMM_LDS_STAGE;
      const unsigned char* sb = sa + 256 * 128;
#pragma unroll
      for (int s = 0; s < 4; ++s) {
        bf16x8 fa[2], fb[2];
#pragma unroll
        for (int i = 0; i < 2; ++i) fa[i] = *(const bf16x8*)(sa + lds_off(wm * 64 + i * 32 + r, 2 * s + h));
#pragma unroll
        for (int j = 0; j < 2; ++j) fb[j] = *(const bf16x8*)(sb + lds_off(wn * 64 + j * 32 + r, 2 * s + h));
#pragma unroll
        for (int i = 0; i < 2; ++i)
#pragma unroll
          for (int j = 0; j < 2; ++j) acc[i][j] = __builtin_amdgcn_mfma_f32_32x32x16_bf16(fa[i], fb[j], acc[i][j], 0, 0, 0);
      }
      if (kt + 1 < nk) lstore((kt + 1) & 1);
      __syncthreads();
    }
    if constexpr (EPI == EPI_Z) {
      u16* st = (u16*)smem;
      u16* lb = st + (wm * 64 + 4 * h) * 136 + wn * 64 + r;
#pragma unroll
      for (int i = 0; i < 2; ++i)
#pragma unroll
        for (int j = 0; j < 2; ++j)
#pragma unroll
          for (int e = 0; e < 16; ++e) lb[(i * 32 + (e & 3) + 8 * (e >> 2)) * 136 + j * 32] = f2bf(acc[i][j][e]);
      __syncthreads();
      u16* Z = (u16*)(p.ws + WS_Z) + (size_t)m0 * N + n0;
#pragma unroll
      for (int i = 0; i < 8; ++i) {
        const int q = tid + i * NTHR, row = q >> 4, c = q & 15;
        *(u32x4*)(Z + (size_t)row * N + c * 8) = *(const u32x4*)(st + row * 136 + c * 8);
      }
      __syncthreads();
    } else if constexpr (EPI == EPI_RES) {
      float* st = (float*)smem;
      float* lb = st + (wm * 64 + 4 * h) * 132 + wn * 64 + r;
#pragma unroll
      for (int i = 0; i < 2; ++i)
#pragma unroll
        for (int j = 0; j < 2; ++j)
#pragma unroll
          for (int e = 0; e < 16; ++e) lb[(i * 32 + (e & 3) + 8 * (e >> 2)) * 132 + j * 32] = acc[i][j][e];
      __syncthreads();
      float* xw = (float*)(p.ws + WS_XW) + (size_t)m0 * D + n0;
      const float* g1p = (const float*)(p.ws + WS_MOD) + ((size_t)l * 5 + row_cls(m0)) * 6144 + 2048 + n0;
      const int c = tid & 31;
      const float4 g1 = *(const float4*)(g1p + c * 4);
#pragma unroll 4
      for (int i = 0; i < 16; ++i) {
        const int row = (tid >> 5) + i * 16;
        const float4 a = *(const float4*)(st + row * 132 + c * 4);
        float4 xv = *(const float4*)(xw + (size_t)row * D + c * 4);
        xv.x += g1.x * a.x; xv.y += g1.y * a.y; xv.z += g1.z * a.z; xv.w += g1.w * a.w;
        *(float4*)(xw + (size_t)row * D + c * 4) = xv;
      }
      __syncthreads();
    } else {
      float* st = (float*)smem;
      float* lb = st + (wm * 64 + 4 * h) * 129 + wn * 64 + r;
#pragma unroll
      for (int i = 0; i < 2; ++i)
#pragma unroll
        for (int j = 0; j < 2; ++j)
#pragma unroll
          for (int e = 0; e < 16; ++e) lb[(i * 32 + (e & 3) + 8 * (e >> 2)) * 129 + j * 32] = acc[i][j][e];
      __syncthreads();
      if (tid < 256) {
        float t16[16];
#pragma unroll
        for (int i = 0; i < 16; ++i) t16[i] = __uint_as_float(0xff800000u);
        for (int kk = 0; kk < 128; ++kk) {
          const float sv = st[tid * 129 + kk];
          const float x = __uint_as_float((__float_as_uint(sv) & ~0x7fu) | (unsigned)(127 - kk));
#pragma unroll
          for (int i = 15; i >= 1; --i) t16[i] = __builtin_amdgcn_fmed3f(x, t16[i - 1], t16[i]);
          t16[0] = fmaxf(t16[0], x);
        }
        unsigned* tk = (unsigned*)(p.ws + WS_TOPK) + ((size_t)(m0 + tid) * 16 + nt) * 16;
#pragma unroll
        for (int q = 0; q < 4; ++q) {
          u32x4 o; o[0] = __float_as_uint(t16[q * 4]); o[1] = __float_as_uint(t16[q * 4 + 1]); o[2] = __float_as_uint(t16[q * 4 + 2]); o[3] = __float_as_uint(t16[q * 4 + 3]);
          *(u32x4*)(tk + q * 4) = o;
        }
      }
      __syncthreads();
    }
  }
}

DI void rec_naive(const Params& p, float* smem, int l, int item, int tid) {
  const int b = item >> 3, hd = (item >> 1) & 3, dir = item & 1;
  const int vcol = tid & 127, kq = tid >> 7;
  float* fb = smem;
  float* kb = fb + 16 * 128;
  float* qb = kb + 16 * 128;
  float* vb = qb + 16 * 128;
  float* op = vb + 16 * 128;
  const u16* Z = (const u16*)(p.ws + WS_Z);
  float* O = (float*)(p.ws + (dir ? WS_OB : WS_OF));
  const float* lower = (const float*)(p.ws + WS_LOWER) + ((size_t)l * 2 + dir) * 512 + hd * 128;
  float S[32];
#pragma unroll
  for (int i = 0; i < 32; ++i) S[i] = 0.f;
  const int zg_off = dir ? 1024 : 512;
  for (int seg = 0; seg < 2; ++seg) {
    const int len = seg == 0 ? CTXL : SEQ;
    const int rbase = seg == 0 ? NLAT + b * CTXL : b * SEQ;
    for (int c0 = 0; c0 < len; c0 += 16) {
      {
        const int tk = tid >> 5, c4 = (tid & 31) * 4;
        const int pos = c0 + tk;
        const int row = rbase + (dir ? (len - 1 - pos) : pos);
        const u16* zr = Z + (size_t)row * INC + hd * 128 + c4;
        const u32x2 iv = *(const u32x2*)(zr);
        const u32x2 zg = *(const u32x2*)(zr + zg_off);
        const u32x2 qq = *(const u32x2*)(zr + 1536);
        const float4 lb4 = *(const float4*)(lower + c4);
        const float lbv[4] = {lb4.x, lb4.y, lb4.z, lb4.w};
        const float zv[4] = {bflo(zg[0]), bfhi(zg[0]), bflo(zg[1]), bfhi(zg[1])};
        float f4[4], k4[4];
#pragma unroll
        for (int e = 0; e < 4; ++e) {
          const float sg = sigmoidf_(zv[e]);
          f4[e] = fmaxf(lbv[e] + (1.f - lbv[e]) * sg, 1e-20f);
          k4[e] = (1.f - lbv[e]) * (1.f - sg);
        }
        *(float4*)(fb + tk * 128 + c4) = make_float4(f4[0], f4[1], f4[2], f4[3]);
        *(float4*)(kb + tk * 128 + c4) = make_float4(k4[0], k4[1], k4[2], k4[3]);
        *(float4*)(qb + tk * 128 + c4) = make_float4(bflo(qq[0]), bfhi(qq[0]), bflo(qq[1]), bfhi(qq[1]));
        *(float4*)(vb + tk * 128 + c4) = make_float4(bflo(iv[0]), bfhi(iv[0]), bflo(iv[1]), bfhi(iv[1]));
      }
      __syncthreads();
      for (int i = 0; i < 16; ++i) {
        const float v = vb[i * 128 + vcol];
        float o = 0.f;
#pragma unroll
        for (int k4i = 0; k4i < 8; ++k4i) {
          const float4 f = *(const float4*)(fb + i * 128 + kq * 32 + k4i * 4);
          const float4 kk = *(const float4*)(kb + i * 128 + kq * 32 + k4i * 4);
          const float4 q = *(const float4*)(qb + i * 128 + kq * 32 + k4i * 4);
          S[k4i * 4 + 0] = f.x * S[k4i * 4 + 0] + kk.x * v; o += q.x * S[k4i * 4 + 0];
          S[k4i * 4 + 1] = f.y * S[k4i * 4 + 1] + kk.y * v; o += q.y * S[k4i * 4 + 1];
          S[k4i * 4 + 2] = f.z * S[k4i * 4 + 2] + kk.z * v; o += q.z * S[k4i * 4 + 2];
          S[k4i * 4 + 3] = f.w * S[k4i * 4 + 3] + kk.w * v; o += q.w * S[k4i * 4 + 3];
        }
        op[(i * 4 + kq) * 128 + vcol] = o;
      }
      __syncthreads();
      {
        const int tk = tid >> 5, c4 = (tid & 31) * 4;
        const int pos = c0 + tk;
        const int row = rbase + (dir ? (len - 1 - pos) : pos);
        const float4 a0 = *(const float4*)(op + (tk * 4 + 0) * 128 + c4), a1 = *(const float4*)(op + (tk * 4 + 1) * 128 + c4);
        const float4 a2 = *(const float4*)(op + (tk * 4 + 2) * 128 + c4), a3 = *(const float4*)(op + (tk * 4 + 3) * 128 + c4);
        *(float4*)(O + (size_t)row * 512 + hd * 128 + c4) = make_float4(a0.x + a1.x + a2.x + a3.x, a0.y + a1.y + a2.y + a3.y, a0.z + a1.z + a2.z + a3.z, a0.w + a1.w + a2.w + a3.w);
      }
      __syncthreads();
    }
  }
}

DI void conv_row(const Params& p, int l, int row, int tid) {
  const int ch = tid;
  const u16* Z = (const u16*)(p.ws + WS_Z);
  u16* cat = (u16*)(p.ws + WS_CAT);
  const float* cw = p.conv_w + (size_t)l * 3 * 512;
  int rm, rp; bool hm, hp_;
  if (row < NLAT) {
    const int t = row & 4095, gr = t >> 6, gc = t & 63;
    if (ch < 256) { hm = gc > 0; hp_ = gc < 63; rm = row - 1; rp = row + 1; }
    else { hm = gr > 0; hp_ = gr < 63; rm = row - 64; rp = row + 64; }
  } else {
    const int t = (row - NLAT) & 255;
    hm = t > 0; hp_ = t < 255; rm = row - 1; rp = row + 1;
  }
  auto uval = [&](int rr) { const u16* zr = Z + (size_t)rr * INC; return bf2f(zr[2560 + ch]) * bf2f(zr[3584 + ch]); };
  float acc = cw[512 + ch] * uval(row);
  if (hm) acc += cw[ch] * uval(rm);
  if (hp_) acc += cw[1024 + ch] * uval(rp);
  const float bg = bf2f(Z[(size_t)row * INC + 3072 + ch]);
  cat[(size_t)row * D + 512 + ch] = f2bf(bg * acc);
}

DI void phase_rec(const Params& p, float* smem, int l, int bid, int nb, int tid) {
  const int nitems = 32 + NTOK;
  for (int it = bid; it < nitems; it += nb) {
    if (it < 32) rec_naive(p, smem, l, it, tid);
    else conv_row(p, l, it - 32, tid);
  }
}

DI void phase_recpost(const Params& p, int l, int bid, int nb, int tid) {
  const int lane = tid & 63, wave = tid >> 6;
  const float* OF = (const float*)(p.ws + WS_OF);
  const float* OB = (const float*)(p.ws + WS_OB);
  const u16* Z = (const u16*)(p.ws + WS_Z);
  u16* cat = (u16*)(p.ws + WS_CAT);
  for (int row = bid * 8 + wave; row < NTOK; row += nb * 8) {
    const float4 a0 = *(const float4*)(OF + (size_t)row * 512 + lane * 8), a1 = *(const float4*)(OF + (size_t)row * 512 + lane * 8 + 4);
    const float4 b0 = *(const float4*)(OB + (size_t)row * 512 + lane * 8), b1 = *(const float4*)(OB + (size_t)row * 512 + lane * 8 + 4);
    float o[8] = {a0.x + b0.x, a0.y + b0.y, a0.z + b0.z, a0.w + b0.w, a1.x + b1.x, a1.y + b1.y, a1.z + b1.z, a1.w + b1.w};
    float ss = 0.f;
#pragma unroll
    for (int e = 0; e < 8; ++e) ss += o[e] * o[e];
    ss += __shfl_xor(ss, 1); ss += __shfl_xor(ss, 2); ss += __shfl_xor(ss, 4); ss += __shfl_xor(ss, 8);
    const float rs = rsqrtf(ss * (1.f / 128.f) + EPS);
    const u32x4 gw = *(const u32x4*)(Z + (size_t)row * INC + 2048 + lane * 8);
    u32x4 ow;
#pragma unroll
    for (int e = 0; e < 4; ++e) {
      const float g0 = bflo(gw[e]), g1 = bfhi(gw[e]);
      ow[e] = pack2(o[2 * e] * rs * siluf_(g0), o[2 * e + 1] * rs * siluf_(g1));
    }
    *(u32x4*)(cat + (size_t)row * D + lane * 8) = ow;
  }
}

DI float gelu_exact(float x) { return 0.5f * x * (1.f + erff(x * 0.70710678118654752f)); }

DI void phase_peer(const Params& p, unsigned char* smem, int l, int bid, int nb, int tid) {
  const int lane = tid & 63, wave = tid >> 6;
  int* el = (int*)smem + wave * 512;
  float* gl = (float*)(el + 128);
  unsigned char* ib = (unsigned char*)(el + 256);
  const unsigned* TK = (const unsigned*)(p.ws + WS_TOPK);
  const u16* hx = (const u16*)(p.ws + WS_HX);
  float* xw = (float*)(p.ws + WS_XW);
  const u16* UB = (const u16*)(p.ws + WS_UB) + (size_t)l * NEXP * D;
  const u16* VB = (const u16*)(p.ws + WS_VB) + (size_t)l * NEXP * D;
  const float* mod = (const float*)(p.ws + WS_MOD);
  const int row_end = (l == DEPTH - 1) ? NLAT : NTOK;
  for (int row = bid * 8 + wave; row < row_end; row += nb * 8) {
    if (lane < 8) {
      const unsigned* t1 = TK + ((size_t)row * 16 + lane * 2) * 16;
      float s1[16], s2[16];
#pragma unroll
      for (int q = 0; q < 4; ++q) {
        const u32x4 a = *(const u32x4*)(t1 + q * 4), b = *(const u32x4*)(t1 + 16 + q * 4);
#pragma unroll
        for (int e = 0; e < 4; ++e) {
          s1[q * 4 + e] = __uint_as_float(a[e]); s2[q * 4 + e] = __uint_as_float(b[e]);
          ib[(lane * 2) * 16 + q * 4 + e] = (unsigned char)(127u - (a[e] & 127u));
          ib[(lane * 2 + 1) * 16 + q * 4 + e] = (unsigned char)(127u - (b[e] & 127u));
        }
      }
      float t16[16];
#pragma unroll
      for (int i = 0; i < 16; ++i) t16[i] = __uint_as_float(0xff800000u);
#pragma unroll
      for (int i = 0; i < 16; ++i)
#pragma unroll
        for (int j = 0; j < 16; ++j)
          if ((i + 1) * (j + 1) <= 16) {
            const float sm = s1[i] + s2[j];
            const float x = __uint_as_float((__float_as_uint(sm) & ~0xffu) | (unsigned)(255 - (i * 16 + j)));
#pragma unroll
            for (int q = 15; q >= 1; --q) t16[q] = __builtin_amdgcn_fmed3f(x, t16[q - 1], t16[q]);
            t16[0] = fmaxf(t16[0], x);
          }
      float ex[16], den = 0.f;
#pragma unroll
      for (int i = 0; i < 16; ++i) { ex[i] = __expf(t16[i] - t16[0]); den += ex[i]; }
      const float inv = 1.f / den;
#pragma unroll
      for (int i = 0; i < 16; ++i) {
        const unsigned ci = 255u - (__float_as_uint(t16[i]) & 255u);
        const int i1 = ib[(lane * 2) * 16 + (ci >> 4)], i2 = ib[(lane * 2 + 1) * 16 + (ci & 15)];
        el[lane * 16 + i] = i1 * 128 + i2;
        gl[lane * 16 + i] = ex[i] * inv;
      }
    }
    float hv[16];
    {
      const u32x4 a = *(const u32x4*)(hx + (size_t)row * D + lane * 8), b = *(const u32x4*)(hx + (size_t)row * D + 512 + lane * 8);
#pragma unroll
      for (int e = 0; e < 4; ++e) { hv[2 * e] = bflo(a[e]); hv[2 * e + 1] = bfhi(a[e]); hv[8 + 2 * e] = bflo(b[e]); hv[8 + 2 * e + 1] = bfhi(b[e]); }
    }
    float acc[16];
#pragma unroll
    for (int i = 0; i < 16; ++i) acc[i] = 0.f;
    for (int j0 = 0; j0 < 128; j0 += 4) {
      u32x4 ua[4], ub[4], va[4], vb[4];
      float gg[4];
#pragma unroll
      for (int q = 0; q < 4; ++q) {
        const int e = el[j0 + q];
        gg[q] = gl[j0 + q];
        const u16* ur = UB + (size_t)e * D + lane * 8;
        const u16* vr = VB + (size_t)e * D + lane * 8;
        ua[q] = *(const u32x4*)ur; ub[q] = *(const u32x4*)(ur + 512);
        va[q] = *(const u32x4*)vr; vb[q] = *(const u32x4*)(vr + 512);
      }
      float dt[4];
#pragma unroll
      for (int q = 0; q < 4; ++q) {
        float s = 0.f;
#pragma unroll
        for (int e = 0; e < 4; ++e) {
          s += hv[2 * e] * bflo(ua[q][e]) + hv[2 * e + 1] * bfhi(ua[q][e]);
          s += hv[8 + 2 * e] * bflo(ub[q][e]) + hv[8 + 2 * e + 1] * bfhi(ub[q][e]);
        }
        dt[q] = s;
      }
#pragma unroll
      for (int o = 32; o >= 1; o >>= 1) {
#pragma unroll
        for (int q = 0; q < 4; ++q) dt[q] += __shfl_xor(dt[q], o);
      }
#pragma unroll
      for (int q = 0; q < 4; ++q) {
        const float cf = gg[q] * gelu_exact(dt[q]);
#pragma unroll
        for (int e = 0; e < 4; ++e) {
          acc[2 * e] += cf * bflo(va[q][e]); acc[2 * e + 1] += cf * bfhi(va[q][e]);
          acc[8 + 2 * e] += cf * bflo(vb[q][e]); acc[8 + 2 * e + 1] += cf * bfhi(vb[q][e]);
        }
      }
    }
    const int cls = row_cls(row);
    const float* g2 = mod + ((size_t)l * 5 + cls) * 6144 + 5120;
    float xn[16];
    float ss = 0.f;
#pragma unroll
    for (int hh = 0; hh < 2; ++hh) {
      const int c0 = hh * 512 + lane * 8;
      const float4 x0 = *(const float4*)(xw + (size_t)row * D + c0), x1 = *(const float4*)(xw + (size_t)row * D + c0 + 4);
      const float4 q0 = *(const float4*)(g2 + c0), q1 = *(const float4*)(g2 + c0 + 4);
      xn[hh * 8 + 0] = x0.x + q0.x * acc[hh * 8 + 0]; xn[hh * 8 + 1] = x0.y + q0.y * acc[hh * 8 + 1];
      xn[hh * 8 + 2] = x0.z + q0.z * acc[hh * 8 + 2]; xn[hh * 8 + 3] = x0.w + q0.w * acc[hh * 8 + 3];
      xn[hh * 8 + 4] = x1.x + q1.x * acc[hh * 8 + 4]; xn[hh * 8 + 5] = x1.y + q1.y * acc[hh * 8 + 5];
      xn[hh * 8 + 6] = x1.z + q1.z * acc[hh * 8 + 6]; xn[hh * 8 + 7] = x1.w + q1.w * acc[hh * 8 + 7];
#pragma unroll
      for (int e = 0; e < 8; ++e) ss += xn[hh * 8 + e] * xn[hh * 8 + e];
    }
    ss = wave_sum(ss);
    const float rs = rsqrtf(ss * (1.f / 1024.f) + EPS);
    if (l < DEPTH - 1) {
      const float* ng = p.norm1_g + (size_t)(l + 1) * D;
      const float* mr = mod + ((size_t)(l + 1) * 5 + cls) * 6144;
      u16* hxw = (u16*)(p.ws + WS_HX);
#pragma unroll
      for (int hh = 0; hh < 2; ++hh) {
        const int c0 = hh * 512 + lane * 8;
        *(float4*)(xw + (size_t)row * D + c0) = make_float4(xn[hh * 8 + 0], xn[hh * 8 + 1], xn[hh * 8 + 2], xn[hh * 8 + 3]);
        *(float4*)(xw + (size_t)row * D + c0 + 4) = make_float4(xn[hh * 8 + 4], xn[hh * 8 + 5], xn[hh * 8 + 6], xn[hh * 8 + 7]);
        float y[8];
#pragma unroll
        for (int e = 0; e < 8; ++e) y[e] = xn[hh * 8 + e] * rs * ng[c0 + e] * (1.f + mr[1024 + c0 + e]) + mr[c0 + e];
        u32x4 o; o[0] = pack2(y[0], y[1]); o[1] = pack2(y[2], y[3]); o[2] = pack2(y[4], y[5]); o[3] = pack2(y[6], y[7]);
        *(u32x4*)(hxw + (size_t)row * D + c0) = o;
      }
    } else {
#pragma unroll
      for (int hh = 0; hh < 2; ++hh) {
        const int c0 = hh * 512 + lane * 8;
        const float4 f0 = *(const float4*)(p.final_g + c0), f1 = *(const float4*)(p.final_g + c0 + 4);
        *(float4*)(p.out + (size_t)row * D + c0) = make_float4(xn[hh * 8 + 0] * rs * f0.x, xn[hh * 8 + 1] * rs * f0.y, xn[hh * 8 + 2] * rs * f0.z, xn[hh * 8 + 3] * rs * f0.w);
        *(float4*)(p.out + (size_t)row * D + c0 + 4) = make_float4(xn[hh * 8 + 4] * rs * f1.x, xn[hh * 8 + 5] * rs * f1.y, xn[hh * 8 + 6] * rs * f1.z, xn[hh * 8 + 7] * rs * f1.w);
      }
    }
  }
}

constexpr int PH_PER_LAYER = 7;
constexpr int N_PHASES = 2 + DEPTH * PH_PER_LAYER;
constexpr int SMEM_BYTES = 256 * 132 * 4;

#ifndef ONLYMASK
#define ONLYMASK 0xffff
#endif
#define PHON(x) ((ONLYMASK >> (x)) & 1)
DI void run_phase(const Params& p, unsigned char* smem, int ph, int bid, int nb, int tid) {
  if (ph == 0) { if (PHON(10)) phase_p0a(p, (float*)smem, bid, nb, tid); return; }
  if (ph == 1) { if (PHON(4)) phase_norm(p, p.norm1_g, 0, 0, 1024, bid, nb, NTOK, tid); return; }
  const int l = (ph - 2) / PH_PER_LAYER, s = (ph - 2) % PH_PER_LAYER;
  const bool last = (l == DEPTH - 1);
  switch (s) {
    case 0: if (PHON(0)) gemm_phase<EPI_Z>(p, smem, (const u16*)(p.ws + WS_HX), (const u16*)(p.ws + WS_WIN) + (size_t)l * 4096 * 1024, NTOK, 4096, 1024, l, bid, nb, NTOK / 256, tid); break;
    case 1: if (PHON(1)) phase_rec(p, (float*)smem, l, bid, nb, tid); break;
    case 2: if (PHON(2)) phase_recpost(p, l, bid, nb, tid); break;
    case 3: if (PHON(3)) gemm_phase<EPI_RES>(p, smem, (const u16*)(p.ws + WS_CAT), (const u16*)(p.ws + WS_WOUT) + (size_t)l * 1024 * 1024, NTOK, 1024, 1024, l, bid, nb, last ? NLAT / 256 : NTOK / 256, tid); break;
    case 4: if (PHON(4)) phase_norm(p, p.norm2_g + (size_t)l * D, l, 3072, 4096, bid, nb, last ? NLAT : NTOK, tid); break;
    case 5: if (PHON(5)) gemm_phase<EPI_TOPK>(p, smem, (const u16*)(p.ws + WS_HX), (const u16*)(p.ws + WS_WS) + (size_t)l * 2048 * 1024, NTOK, 2048, 1024, l, bid, nb, last ? NLAT / 256 : NTOK / 256, tid); break;
    case 6: if (PHON(6)) phase_peer(p, smem, l, bid, nb, tid); break;
  }
}

typedef const Params __attribute__((address_space(4)))* KArgs;

__global__ void __launch_bounds__(NTHR, 2) mega_kernel(Params p_unused) {
#if defined(__HIP_DEVICE_COMPILE__)
  __shared__ __attribute__((aligned(16))) unsigned char smem[SMEM_BYTES];
#if !MULTI_LAUNCH
  cg::grid_group grid = cg::this_grid();
#endif
  KArgs ka = (KArgs)__builtin_amdgcn_kernarg_segment_ptr();
  const int ph_lo = ka->ph_lo, ph_hi = ka->ph_hi;
  for (int ph = ph_lo; ph < ph_hi; ++ph) {
    int tid = threadIdx.x, bid = blockIdx.x, nb = gridDim.x;
    KArgs kq = ka;
    asm volatile("" : "+v"(tid), "+s"(bid), "+s"(nb), "+s"(kq));
    Params p;
    __builtin_memcpy(&p, (const void __attribute__((address_space(4)))*)kq, sizeof(Params));
    run_phase(p, smem, ph, bid, nb, tid);
#if !MULTI_LAUNCH
    if (ph + 1 < ph_hi) grid.sync();
#endif
  }
#endif
}

extern "C" void kernel_launch(void* const* d_in, const int* in_sizes, int n_in, void* d_out, int out_size, void* d_ws, size_t ws_size, hipStream_t stream) {
  static int grid = 0;
  if (grid == 0) {
    if (n_in != 17 || ws_size < WS_END) { fprintf(stderr, "kernel_launch: unexpected n_in %d or ws_size %zu (need %zu)\n", n_in, ws_size, (size_t)WS_END); grid = -1; return; }
    int dev = 0, cus = 0, per_cu = 0;
    hipGetDevice(&dev);
    hipDeviceGetAttribute(&cus, hipDeviceAttributeMultiprocessorCount, dev);
    hipOccupancyMaxActiveBlocksPerMultiprocessor(&per_cu, (const void*)mega_kernel, NTHR, 0);
    if (per_cu < 1) { fprintf(stderr, "kernel_launch: occupancy query says %d blocks per CU\n", per_cu); grid = -1; return; }
    grid = cus;
  }
  if (grid < 0) return;
  Params p{};
  p.x = (const float*)d_in[0]; p.c = (const float*)d_in[1]; p.ctx = (const float*)d_in[2]; p.c_ctx = (const float*)d_in[3];
  p.w_mod = (const float*)d_in[4]; p.b_mod = (const float*)d_in[5]; p.norm1_g = (const float*)d_in[6]; p.norm2_g = (const float*)d_in[7];
  p.w_in = (const float*)d_in[8]; p.conv_w = (const float*)d_in[9]; p.w_out = (const float*)d_in[10]; p.lb_logits = (const float*)d_in[11];
  p.peer_wq = (const float*)d_in[12]; p.peer_subkeys = (const float*)d_in[13]; p.peer_u = (const float*)d_in[14]; p.peer_v = (const float*)d_in[15];
  p.final_g = (const float*)d_in[16]; p.out = (float*)d_out; p.ws = (unsigned char*)d_ws;
#if MULTI_LAUNCH
  for (int ph = 0; ph < N_PHASES; ++ph) {
    p.ph_lo = ph; p.ph_hi = ph + 1;
    hipLaunchKernelGGL(mega_kernel, dim3(grid), dim3(NTHR), 0, stream, p);
  }
#else
  p.ph_lo = 0; p.ph_hi = N_PHASES;
  void* args[] = {&p};
  hipError_t e = hipLaunchCooperativeKernel((const void*)mega_kernel, dim3(grid), dim3(NTHR), args, 0, stream);
  if (e != hipSuccess) fprintf(stderr, "cooperative launch failed: %s (grid %d)\n", hipGetErrorString(e), grid);
#endif
}
```

```cpp
#include <hip/hip_runtime.h>
#include <hip/hip_cooperative_groups.h>
#include <stdint.h>
#include <stdio.h>
namespace cg = cooperative_groups;

#ifndef MULTI_LAUNCH
#define MULTI_LAUNCH 0
#endif

#define DI __device__ __forceinline__
typedef unsigned short u16;
using bf16x8 = __attribute__((ext_vector_type(8))) short;
using f32x16 = __attribute__((ext_vector_type(16))) float;
using u32x4  = __attribute__((ext_vector_type(4))) unsigned;
using u32x2  = __attribute__((ext_vector_type(2))) unsigned;
using f32x4  = __attribute__((ext_vector_type(4))) float;

constexpr int D = 1024, NLAT = 16384, NCTX = 1024, NTOK = 17408, DEPTH = 4, INC = 4096;
constexpr int SEQ = 4096, CTXL = 256, BATCH = 4;
constexpr int NTHR = 512;
constexpr int NEXP = 16384;
constexpr float EPS = 1e-6f;

constexpr size_t al256(size_t x) { return (x + 255) & ~(size_t)255; }
constexpr size_t WS_BAR   = 0;
constexpr size_t WS_MOD   = 16384;
constexpr size_t WS_LOWER = WS_MOD + al256((size_t)4 * 5 * 6144 * 4);
constexpr size_t WS_XW    = WS_LOWER + al256((size_t)4 * 2 * 512 * 4);
constexpr size_t WS_HX    = WS_XW + (size_t)NTOK * D * 4;
constexpr size_t WS_Z     = WS_HX + (size_t)NTOK * D * 2;
constexpr size_t WS_CAT   = WS_Z + (size_t)NTOK * INC * 2;
constexpr size_t WS_OF    = WS_CAT + (size_t)NTOK * D * 2;
constexpr size_t WS_OB    = WS_OF + (size_t)NTOK * 512 * 4;
constexpr size_t WS_TOPK  = WS_OB + (size_t)NTOK * 512 * 4;
constexpr size_t WS_WIN   = WS_TOPK + (size_t)NTOK * 256 * 4;
constexpr size_t WS_WOUT  = WS_WIN + (size_t)4 * 4096 * 1024 * 2;
constexpr size_t WS_WS    = WS_WOUT + (size_t)4 * 1024 * 1024 * 2;
constexpr size_t WS_UB    = WS_WS + (size_t)4 * 2048 * 1024 * 2;
constexpr size_t WS_VB    = WS_UB + (size_t)4 * NEXP * D;
constexpr size_t WS_US    = WS_VB + (size_t)4 * NEXP * D;
constexpr size_t WS_VS    = WS_US + (size_t)4 * NEXP * 4;
constexpr size_t WS_SLOC  = WS_VS + (size_t)4 * NEXP * 4;
constexpr size_t WS_SST   = WS_SLOC + (size_t)32 * 34 * 16384 * 2;
constexpr size_t WS_DT    = WS_SST + (size_t)32 * 34 * 16384 * 2;
constexpr size_t WS_HXQ   = WS_DT + (size_t)32 * 34 * 128 * 4;
constexpr size_t WS_HXS   = WS_HXQ + (size_t)NTOK * D;
constexpr size_t WS_WSQ   = WS_HXS + al256((size_t)NTOK * 4);
constexpr size_t WS_WSS   = WS_WSQ + (size_t)4 * 2048 * 1024;
constexpr size_t WS_WINQ  = WS_WSS + (size_t)4 * 2048 * 4;
constexpr size_t WS_WINS  = WS_WINQ + (size_t)4 * 4096 * 1024;
constexpr size_t WS_END   = WS_WINS + (size_t)4 * 4096 * 4;

struct Params {
  const float* x; const float* c; const float* ctx; const float* c_ctx; const float* w_mod; const float* b_mod;
  const float* norm1_g; const float* norm2_g; const float* w_in; const float* conv_w; const float* w_out;
  const float* lb_logits; const float* peer_wq; const float* peer_subkeys; const float* peer_u; const float* peer_v;
  const float* final_g; float* out; unsigned char* ws;
  int ph_lo, ph_hi;
};

typedef __attribute__((ext_vector_type(2))) __bf16 bf16v2;
typedef __attribute__((ext_vector_type(2))) float f32v2;
typedef const Params __attribute__((address_space(4)))& KP;

DI u16 f2bf(float x) { return __builtin_bit_cast(u16, (__bf16)x); }
DI float bf2f(u16 b) { return __uint_as_float(((unsigned)b) << 16); }
DI unsigned pack2(float a, float b) { f32v2 v = {a, b}; return __builtin_bit_cast(unsigned, __builtin_convertvector(v, bf16v2)); }
DI float bflo(unsigned w) { return __uint_as_float(w << 16); }
DI float bfhi(unsigned w) { return __uint_as_float(w & 0xffff0000u); }
DI float sigmoidf_(float x) { return 1.f / (1.f + __expf(-x)); }
DI float siluf_(float x) { return x / (1.f + __expf(-x)); }
DI float wave_sum(float v) {
#pragma unroll
  for (int o = 32; o >= 1; o >>= 1) v += __shfl_xor(v, o);
  return v;
}
DI int row_cls(int row) { return row < NLAT ? (row >> 12) : 4; }
DI unsigned sw128(int row, int col) { return (unsigned)(row * 256 + ((((col >> 3) ^ (row & 15))) << 4) + (col & 7) * 2); }

DI void p0_mod_all(KP p, float* smem, int bid, int nb, int tid) {
  float* cond = smem;
  float* red = smem + 5 * 1024;
  for (int i = tid; i < 5 * 1024; i += NTHR) {
    const int r = i >> 10, k = i & 1023;
    const float v = r < 4 ? p.c[r * 1024 + k] : p.c_ctx[k];
    cond[i] = siluf_(v);
  }
  __syncthreads();
  const int col = tid & 31, ks = tid >> 5;
  const float* cd0 = cond + ks * 64;
  float* mod = (float*)(p.ws + WS_MOD);
  for (int g0 = bid; g0 < 768; g0 += 3 * nb) {
    float wa[16], wb[16];
    const unsigned vo = (unsigned)((ks * 64 * 6144 + col) * 4);
    auto wbase = [&](int g) { return (const char*)(p.w_mod + (size_t)(g / 192) * 1024 * 6144 + (g % 192) * 32); };
    {
      const char* w = wbase(g0);
#pragma unroll
      for (int u = 0; u < 16; ++u) wa[u] = *(const float*)(w + (size_t)u * 24576 + vo);
    }
#pragma unroll 1
    for (int q = 0; q < 3; ++q) {
      const int g = g0 + q * nb;
      if (g >= 768) break;
      float a0 = 0, a1 = 0, a2 = 0, a3 = 0, a4 = 0;
#pragma unroll 1
      for (int hb = 0; hb < 2; ++hb) {
        const float* cd = cd0 + 32 * hb;
        asm volatile("" : "+v"(cd));
        {
          const char* w = wbase(g) + (size_t)(32 * hb + 16) * 24576;
#pragma unroll
          for (int u = 0; u < 16; ++u) wb[u] = *(const float*)(w + (size_t)u * 24576 + vo);
        }
#pragma unroll
        for (int u = 0; u < 16; ++u) { a0 += cd[u] * wa[u]; a1 += cd[1024 + u] * wa[u]; a2 += cd[2048 + u] * wa[u]; a3 += cd[3072 + u] * wa[u]; a4 += cd[4096 + u] * wa[u]; }
        __builtin_amdgcn_sched_barrier(0);
        if (hb == 0 || (q + 1 < 3 && g + nb < 768)) {
          const char* w = hb == 0 ? wbase(g) + (size_t)32 * 24576 : wbase(g + nb);
#pragma unroll
          for (int u = 0; u < 16; ++u) wa[u] = *(const float*)(w + (size_t)u * 24576 + vo);
        }
#pragma unroll
        for (int u = 0; u < 16; ++u) { a0 += cd[16 + u] * wb[u]; a1 += cd[1040 + u] * wb[u]; a2 += cd[2064 + u] * wb[u]; a3 += cd[3088 + u] * wb[u]; a4 += cd[4112 + u] * wb[u]; }
        __builtin_amdgcn_sched_barrier(0);
      }
      float* rq = red + q * 2560;
      rq[(ks * 5 + 0) * 32 + col] = a0; rq[(ks * 5 + 1) * 32 + col] = a1; rq[(ks * 5 + 2) * 32 + col] = a2;
      rq[(ks * 5 + 3) * 32 + col] = a3; rq[(ks * 5 + 4) * 32 + col] = a4;
    }
    __syncthreads();
    if (tid < 480) {
      const int q = tid / 160, rr = tid % 160, r = rr >> 5, cc = rr & 31, g = g0 + q * nb;
      if (g < 768) {
        const float* rq = red + q * 2560;
        float sacc = 0.f;
#pragma unroll
        for (int t = 0; t < 16; ++t) sacc += rq[(t * 5 + r) * 32 + cc];
        const int l = g / 192, ng = g % 192;
        mod[((size_t)l * 5 + r) * 6144 + ng * 32 + cc] = sacc + p.b_mod[l * 6144 + ng * 32 + cc];
      }
    }
    __syncthreads();
  }
}

DI void p0_transpose_waves(KP p, float* smem, int bid, int nb, int tid) {
  const int lane = tid & 63, wave = tid >> 6;
  float* t = smem + wave * (64 * 33);
  const int kr = lane >> 3, c4 = (lane & 7) * 4;
  const int j = lane >> 1, hf = lane & 1;
  float4 v[8];
  const float* src = nullptr; u16* dst = nullptr; int K = 1024, N = 0, k0 = 0, n0 = 0;
  auto decode = [&](int it) {
    if (it < 8192) { const int l = it >> 11, r = it & 2047; k0 = (r >> 7) * 64; n0 = (r & 127) * 32; N = 4096; src = p.w_in + (size_t)l * 1024 * 4096; dst = (u16*)(p.ws + WS_WIN) + (size_t)l * 4096 * 1024; }
    else { const int i2 = it - 8192, l = i2 >> 9, r = i2 & 511; k0 = (r >> 5) * 64; n0 = (r & 31) * 32; N = 1024; src = p.w_out + (size_t)l * 1024 * 1024; dst = (u16*)(p.ws + WS_WOUT) + (size_t)l * 1024 * 1024; }
  };
  auto gload = [&]() {
#pragma unroll
    for (int pp = 0; pp < 8; ++pp) v[pp] = *(const float4*)(src + (size_t)(k0 + kr + 8 * pp) * N + n0 + c4);
  };
  int it = bid * 8 + wave;
  const int step = nb * 8;
  if (it < 10240) { decode(it); gload(); }
#pragma unroll 1
  while (it < 10240) {
#pragma unroll
    for (int pp = 0; pp < 8; ++pp) {
      float* tt = t + (kr + 8 * pp) * 33 + c4;
      tt[0] = v[pp].x; tt[1] = v[pp].y; tt[2] = v[pp].z; tt[3] = v[pp].w;
    }
    u16* drow = dst + (size_t)(n0 + j) * K + k0 + 32 * hf;
    const int nxt = it + step;
    if (nxt < 10240) { decode(nxt); gload(); }
    __builtin_amdgcn_fence(__ATOMIC_ACQ_REL, "wavefront");
    __builtin_amdgcn_wave_barrier();
#pragma unroll
    for (int q = 0; q < 4; ++q) {
      const float* tt = t + (32 * hf + 8 * q) * 33 + j;
      u32x4 o;
      o[0] = pack2(tt[0 * 33], tt[1 * 33]); o[1] = pack2(tt[2 * 33], tt[3 * 33]);
      o[2] = pack2(tt[4 * 33], tt[5 * 33]); o[3] = pack2(tt[6 * 33], tt[7 * 33]);
      *(u32x4*)(drow + 8 * q) = o;
    }
    __builtin_amdgcn_fence(__ATOMIC_ACQ_REL, "wavefront");
    __builtin_amdgcn_wave_barrier();
    it = nxt;
  }
}

DI void p0_ws_item(KP p, float* smemf, int item, int tid) {
  const int l = item >> 8, hp = (item >> 4) & 15, kt = item & 15;
  unsigned char* smem = (unsigned char*)smemf;
  unsigned char* SK = smem;
  unsigned char* WQ = smem + 32768;
  const float* skg = p.peer_subkeys + ((size_t)l * 16 + hp) * 128 * 128;
#pragma unroll
  for (int u = 0; u < 4; ++u) {
    const int q = tid + NTHR * u, row = q >> 4, c8 = (q & 15) * 8;
    const float4 a = *(const float4*)(skg + row * 128 + c8), b = *(const float4*)(skg + row * 128 + c8 + 4);
    u32x4 o; o[0] = pack2(a.x, a.y); o[1] = pack2(a.z, a.w); o[2] = pack2(b.x, b.y); o[3] = pack2(b.z, b.w);
    *(u32x4*)(SK + sw128(row, c8)) = o;
  }
  const float* wqg = p.peer_wq + (size_t)l * 1024 * 2048 + (size_t)(kt * 64) * 2048 + hp * 128;
#pragma unroll
  for (int u = 0; u < 2; ++u) {
    const int q = tid + NTHR * u, row = q >> 4, c8 = (q & 15) * 8;
    const float4 a = *(const float4*)(wqg + (size_t)row * 2048 + c8), b = *(const float4*)(wqg + (size_t)row * 2048 + c8 + 4);
    u32x4 o; o[0] = pack2(a.x, a.y); o[1] = pack2(a.z, a.w); o[2] = pack2(b.x, b.y); o[3] = pack2(b.z, b.w);
    *(u32x4*)(WQ + sw128(row, c8)) = o;
  }
  __syncthreads();
  const int lane = tid & 63, wave = tid >> 6, r = lane & 31, h = lane >> 5;
  const int km = wave >> 2, kn = wave & 3;
  f32x16 acc;
#pragma unroll
  for (int e = 0; e < 16; ++e) acc[e] = 0.f;
#pragma unroll
  for (int ks = 0; ks < 8; ++ks) {
    const bf16x8 av = *(const bf16x8*)(WQ + sw128(32 * km + r, 16 * ks + 8 * h));
    const bf16x8 bv = *(const bf16x8*)(SK + sw128(32 * kn + r, 16 * ks + 8 * h));
    acc = __builtin_amdgcn_mfma_f32_32x32x16_bf16(av, bv, acc, 0, 0, 0);
  }
  u16* dst = (u16*)(p.ws + WS_WS) + ((size_t)l * 2048 + hp * 128 + 32 * kn + r) * 1024 + kt * 64 + 32 * km + 4 * h;
#pragma unroll
  for (int g = 0; g < 4; ++g) {
    u32x2 o; o[0] = pack2(acc[4 * g], acc[4 * g + 1]); o[1] = pack2(acc[4 * g + 2], acc[4 * g + 3]);
    *(u32x2*)(dst + 8 * g) = o;
  }
  __syncthreads();
}

DI void p0_quant_rows(const float* src, unsigned char* dst, float* scl, int row0, int tid, float off) {
  const int lane = tid & 63, wave = tid >> 6;
  auto qrow = [&](int row, const float4& x0, const float4& x1, const float4& x2, const float4& x3) {
    float v[16] = {x0.x, x0.y, x0.z, x0.w, x1.x, x1.y, x1.z, x1.w, x2.x, x2.y, x2.z, x2.w, x3.x, x3.y, x3.z, x3.w};
    float am = 0.f;
#pragma unroll
    for (int e = 0; e < 16; ++e) am = fmaxf(am, fabsf(v[e]));
#pragma unroll
    for (int o = 32; o >= 1; o >>= 1) am = fmaxf(am, __shfl_xor(am, o));
    const float sc = am > 0.f ? am * (1.f / 127.f) : 1.f;
    const float inv = 1.f / sc;
    u32x4 o4;
#pragma unroll
    for (int q = 0; q < 4; ++q) {
      unsigned w = 0;
#pragma unroll
      for (int e = 0; e < 4; ++e) {
        const float qv = fminf(fmaxf(rintf(v[q * 4 + e] * inv), -127.f), 127.f) + off;
        w |= (((unsigned)(int)qv) & 0xffu) << (8 * e);
      }
      o4[q] = w;
    }
    *(u32x4*)(dst + (size_t)row * D + lane * 16) = o4;
    if (lane == 0) scl[row] = sc;
  };
#pragma unroll 1
  for (int i = 0; i < 8; i += 2) {
    const int rA = row0 + i * 8 + wave, rB = rA + 8;
    const float* sa = src + (size_t)rA * D + lane * 16;
    const float* sb = src + (size_t)rB * D + lane * 16;
    const float4 a0 = *(const float4*)(sa), a1 = *(const float4*)(sa + 4), a2 = *(const float4*)(sa + 8), a3 = *(const float4*)(sa + 12);
    const float4 b0 = *(const float4*)(sb), b1 = *(const float4*)(sb + 4), b2 = *(const float4*)(sb + 8), b3 = *(const float4*)(sb + 12);
    qrow(rA, a0, a1, a2, a3);
    qrow(rB, b0, b1, b2, b3);
  }
}

DI void p0_quant_waves(KP p, int bid, int nb, int tid) {
  const int lane = tid & 63, wave = tid >> 6;
  auto qrow = [&](int rr, const float4& x0, const float4& x1, const float4& x2, const float4& x3) {
    unsigned char* dst = p.ws + (rr < NEXP ? WS_UB : WS_VB);
    float* scl = (float*)(p.ws + (rr < NEXP ? WS_US : WS_VS));
    const int row = rr & (NEXP - 1);
    float v[16] = {x0.x, x0.y, x0.z, x0.w, x1.x, x1.y, x1.z, x1.w, x2.x, x2.y, x2.z, x2.w, x3.x, x3.y, x3.z, x3.w};
    float am = 0.f;
#pragma unroll
    for (int e = 0; e < 16; ++e) am = fmaxf(am, fabsf(v[e]));
#pragma unroll
    for (int o = 32; o >= 1; o >>= 1) am = fmaxf(am, __shfl_xor(am, o));
    const float sc = am > 0.f ? am * (1.f / 127.f) : 1.f;
    const float inv = 1.f / sc;
    u32x4 o4;
#pragma unroll
    for (int q = 0; q < 4; ++q) {
      unsigned w = 0;
#pragma unroll
      for (int e = 0; e < 4; ++e) {
        const float qv = fminf(fmaxf(rintf(v[q * 4 + e] * inv), -127.f), 127.f);
        w |= (((unsigned)(int)qv) & 0xffu) << (8 * e);
      }
      o4[q] = w;
    }
    *(u32x4*)(dst + (size_t)row * D + lane * 16) = o4;
    if (lane == 0) scl[row] = sc;
  };
  auto srow = [&](int rr) { return (rr < NEXP ? p.peer_u + (size_t)rr * D : p.peer_v + (size_t)(rr - NEXP) * D) + lane * 16; };
  const int step = nb * 8;
  int rA = bid * 8 + wave, rB = rA + step;
  float4 a0, a1, a2, a3, b0, b1, b2, b3;
  if (rA < 2 * NEXP) { const float* sa = srow(rA); a0 = *(const float4*)(sa); a1 = *(const float4*)(sa + 4); a2 = *(const float4*)(sa + 8); a3 = *(const float4*)(sa + 12); }
  if (rB < 2 * NEXP) { const float* sb = srow(rB); b0 = *(const float4*)(sb); b1 = *(const float4*)(sb + 4); b2 = *(const float4*)(sb + 8); b3 = *(const float4*)(sb + 12); }
#pragma unroll 1
  while (rA < 2 * NEXP) {
    qrow(rA, a0, a1, a2, a3);
    const int nA = rA + 2 * step;
    if (nA < 2 * NEXP) { const float* sa = srow(nA); a0 = *(const float4*)(sa); a1 = *(const float4*)(sa + 4); a2 = *(const float4*)(sa + 8); a3 = *(const float4*)(sa + 12); }
    if (rB < 2 * NEXP) qrow(rB, b0, b1, b2, b3);
    const int nB = rB + 2 * step;
    if (nB < 2 * NEXP) { const float* sb = srow(nB); b0 = *(const float4*)(sb); b1 = *(const float4*)(sb + 4); b2 = *(const float4*)(sb + 8); b3 = *(const float4*)(sb + 12); }
    rA = nA; rB = nB;
  }
}

constexpr int P0_N_WS = 1024;

DI void phase_p0a(KP p, float* smem, int bid, int nb, int tid) {
  if (bid == nb - 1) {
    float* lower = (float*)(p.ws + WS_LOWER);
    for (int e = tid; e < 1024; e += NTHR) {
      const float a0 = p.lb_logits[e], a1 = p.lb_logits[1024 + e], a2 = p.lb_logits[2048 + e], a3 = p.lb_logits[3072 + e];
      const float m = fmaxf(fmaxf(a0, a1), fmaxf(a2, a3));
      const float e0 = expf(a0 - m), e1 = expf(a1 - m), e2 = expf(a2 - m), e3 = expf(a3 - m);
      const float inv = 1.f / (e0 + e1 + e2 + e3);
      lower[e] = 0.f; lower[1024 + e] = e1 * inv; lower[2048 + e] = (e1 + e2) * inv; lower[3072 + e] = (e1 + e2 + e3) * inv;
    }
  }
  p0_mod_all(p, smem, bid, nb, tid);
  for (int i = bid; i < P0_N_WS; i += nb) p0_ws_item(p, smem, i, tid);
  p0_transpose_waves(p, smem, bid, nb, tid);
  p0_quant_waves(p, bid, nb, tid);
}

template <bool FIRST = false>
DI void phase_norm(KP p, const float* g, int l, int sh_off, int sc_off, int bid, int nb, int row_end, int tid, bool wq = false) {
  const int lane = tid & 63, wave = tid >> 6;
  const float* xw = (const float*)(p.ws + WS_XW);
  const float* mod = (const float*)(p.ws + WS_MOD) + (size_t)l * 5 * 6144;
  for (int row = bid * 8 + wave; row < row_end; row += nb * 8) {
    const float* xr = FIRST ? (row < NLAT ? p.x + (size_t)row * D : p.ctx + (size_t)(row - NLAT) * D) : xw + (size_t)row * D;
    float v[16];
    float ss = 0.f;
#pragma unroll
    for (int q = 0; q < 4; ++q) {
      const float4 a = *(const float4*)(xr + q * 256 + lane * 4);
      if (FIRST) *(float4*)((float*)(p.ws + WS_XW) + (size_t)row * D + q * 256 + lane * 4) = a;
      v[q * 4 + 0] = a.x; v[q * 4 + 1] = a.y; v[q * 4 + 2] = a.z; v[q * 4 + 3] = a.w;
      ss += a.x * a.x + a.y * a.y + a.z * a.z + a.w * a.w;
    }
    ss = wave_sum(ss);
    const float rs = rsqrtf(ss * (1.f / 1024.f) + EPS);
    const float* mr = mod + (size_t)row_cls(row) * 6144;
#pragma unroll
    for (int q = 0; q < 4; ++q) {
      const int c0 = q * 256 + lane * 4;
      const float4 gg = *(const float4*)(g + c0);
      const float4 sh = *(const float4*)(mr + sh_off + c0);
      const float4 sc = *(const float4*)(mr + sc_off + c0);
      v[q * 4 + 0] = v[q * 4 + 0] * rs * gg.x * (1.f + sc.x) + sh.x; v[q * 4 + 1] = v[q * 4 + 1] * rs * gg.y * (1.f + sc.y) + sh.y;
      v[q * 4 + 2] = v[q * 4 + 2] * rs * gg.z * (1.f + sc.z) + sh.z; v[q * 4 + 3] = v[q * 4 + 3] * rs * gg.w * (1.f + sc.w) + sh.w;
    }
    {
      float am = 0.f;
#pragma unroll
      for (int e = 0; e < 16; ++e) am = fmaxf(am, fabsf(v[e]));
#pragma unroll
      for (int o2 = 32; o2 >= 1; o2 >>= 1) am = fmaxf(am, __shfl_xor(am, o2));
      const float sc = am > 0.f ? am * (1.f / 127.f) : 1.f, inv = 1.f / sc;
      unsigned char* hq = p.ws + WS_HXQ + (size_t)row * D;
#pragma unroll
      for (int q = 0; q < 4; ++q) {
        unsigned w = 0;
#pragma unroll
        for (int e = 0; e < 4; ++e) w |= (((unsigned)(int)rintf(v[q * 4 + e] * inv)) & 0xffu) << (8 * e);
        *(unsigned*)(hq + q * 256 + lane * 4) = w;
      }
      if (lane == 0) ((float*)(p.ws + WS_HXS))[row] = sc;
    }
  }
}

DI void phase_rowq(KP p, size_t src_off, size_t dst_off, size_t scl_off, int nrows, int bid, int nb, int tid) {
  const int lane = tid & 63, wave = tid >> 6;
  const u16* src = (const u16*)(p.ws + src_off);
  for (int row = bid * 8 + wave; row < nrows; row += nb * 8) {
    const u32x4 a = *(const u32x4*)(src + (size_t)row * 1024 + lane * 16), b = *(const u32x4*)(src + (size_t)row * 1024 + lane * 16 + 8);
    float v[16];
#pragma unroll
    for (int e = 0; e < 4; ++e) { v[2 * e] = bflo(a[e]); v[2 * e + 1] = bfhi(a[e]); v[8 + 2 * e] = bflo(b[e]); v[8 + 2 * e + 1] = bfhi(b[e]); }
    float am = 0.f;
#pragma unroll
    for (int e = 0; e < 16; ++e) am = fmaxf(am, fabsf(v[e]));
#pragma unroll
    for (int o2 = 32; o2 >= 1; o2 >>= 1) am = fmaxf(am, __shfl_xor(am, o2));
    const float sc = am > 0.f ? am * (1.f / 127.f) : 1.f, inv = 1.f / sc;
    u32x4 o;
#pragma unroll
    for (int q = 0; q < 4; ++q) {
      unsigned w = 0;
#pragma unroll
      for (int e = 0; e < 4; ++e) w |= (((unsigned)(int)rintf(v[q * 4 + e] * inv)) & 0xffu) << (8 * e);
      o[q] = w;
    }
    *(u32x4*)(p.ws + dst_off + (size_t)row * 1024 + lane * 16) = o;
    if (lane == 0) ((float*)(p.ws + scl_off))[row] = sc;
  }
}

constexpr int GEMM_LDS_STAGE = 256 * 128 + 128 * 128;
enum { EPI_Z = 0, EPI_RES = 1, EPI_TOPK = 2 };

DI unsigned lds_off(int row, int c) { return (unsigned)(row * 128 + ((c ^ ((row >> 1) & 7)) << 4)); }

template <int EPI, int BN, bool DEEP = false>
DI void gemm_tile(KP p, unsigned char* smem, const u16* A, const u16* Bt, int N, int K, int l, int m0, int n0, int tid) {
  constexpr int WN = BN / 64, WM = 8 / WN, IM = 256 / WM / 32, NB = BN / 64;
  constexpr int STAGE = 32768 + BN * 128;
  const int lane = tid & 63, wave = tid >> 6;
  const int wm = wave / WN, wn = wave % WN, r = lane & 31, h = lane >> 5;
  f32x16 acc[IM][2];
#pragma unroll
  for (int i = 0; i < IM; ++i)
#pragma unroll
    for (int j = 0; j < 2; ++j)
#pragma unroll
      for (int e = 0; e < 16; ++e) acc[i][j][e] = 0.f;
  u32x4 ra[4], rb[NB];
  const int nk = K / 64;
  const unsigned voff = (unsigned)(((tid >> 3) * K + (tid & 7) * 8) * 2);
  auto gload = [&](int kt) {
#pragma unroll
    for (int i = 0; i < 4; ++i) {
      const char* base = (const char*)(A + (size_t)(m0 + 64 * i) * K + kt * 64);
      ra[i] = *(const u32x4*)(base + voff);
    }
#pragma unroll
    for (int i = 0; i < NB; ++i) {
      const char* base = (const char*)(Bt + (size_t)(n0 + 64 * i) * K + kt * 64);
      rb[i] = *(const u32x4*)(base + voff);
    }
  };
  auto lstore = [&](int buf) {
    unsigned char* sa = smem + buf * STAGE;
    unsigned char* sb = sa + 32768;
#pragma unroll
    for (int i = 0; i < 4; ++i) {
      const int q = tid + i * NTHR, row = q >> 3, c = q & 7;
      *(u32x4*)(sa + lds_off(row, c)) = ra[i];
    }
#pragma unroll
    for (int i = 0; i < NB; ++i) {
      const int q = tid + i * NTHR, row = q >> 3, c = q & 7;
      *(u32x4*)(sb + lds_off(row, c)) = rb[i];
    }
  };
  auto compute = [&](int kt) {
    const unsigned char* sa = smem + (kt & 1) * STAGE;
    const unsigned char* sb = sa + 32768;
#pragma unroll
    for (int s = 0; s < 4; ++s) {
      bf16x8 fa[IM], fb[2];
#pragma unroll
      for (int i = 0; i < IM; ++i) fa[i] = *(const bf16x8*)(sa + lds_off(wm * (IM * 32) + i * 32 + r, 2 * s + h));
#pragma unroll
      for (int j = 0; j < 2; ++j) fb[j] = *(const bf16x8*)(sb + lds_off(wn * 64 + j * 32 + r, 2 * s + h));
#pragma unroll
      for (int i = 0; i < IM; ++i)
#pragma unroll
        for (int j = 0; j < 2; ++j) acc[i][j] = __builtin_amdgcn_mfma_f32_32x32x16_bf16(fa[i], fb[j], acc[i][j], 0, 0, 0);
      if constexpr (BN == 256) __builtin_amdgcn_sched_barrier(0);
    }
  };
  if constexpr (!DEEP) {
    gload(0);
    lstore(0);
    __syncthreads();
    for (int kt = 0; kt < nk; ++kt) {
      if (kt + 1 < nk) gload(kt + 1);
      compute(kt);
      if (kt + 1 < nk) lstore((kt + 1) & 1);
      __syncthreads();
    }
  } else {
    u32x4 ra2[4], rb2[NB];
    auto gload2 = [&](int kt) {
#pragma unroll
      for (int i = 0; i < 4; ++i) ra2[i] = *(const u32x4*)((const char*)(A + (size_t)(m0 + 64 * i) * K + kt * 64) + voff);
#pragma unroll
      for (int i = 0; i < NB; ++i) rb2[i] = *(const u32x4*)((const char*)(Bt + (size_t)(n0 + 64 * i) * K + kt * 64) + voff);
    };
    auto lstore2 = [&](int buf) {
      unsigned char* sa = smem + buf * STAGE;
      unsigned char* sb = sa + 32768;
#pragma unroll
      for (int i = 0; i < 4; ++i) { const int q = tid + i * NTHR; *(u32x4*)(sa + lds_off(q >> 3, q & 7)) = ra2[i]; }
#pragma unroll
      for (int i = 0; i < NB; ++i) { const int q = tid + i * NTHR; *(u32x4*)(sb + lds_off(q >> 3, q & 7)) = rb2[i]; }
    };
    gload(0);
    gload2(1);
    lstore(0);
    if (2 < nk) gload(2);
    __syncthreads();
    for (int kt = 0; kt < nk; kt += 2) {
      if (kt + 1 < nk) { lstore2(1); if (kt + 3 < nk) gload2(kt + 3); }
      compute(kt);
      __syncthreads();
      if (kt + 2 < nk) { lstore(0); if (kt + 4 < nk) gload(kt + 4); }
      compute(kt + 1);
      __syncthreads();
    }
  }
#pragma unroll 1
  for (int hf = 0; hf < BN / 128; ++hf) {
    const bool mine = (wn >> 1) == hf;
    const int n0h = n0 + hf * 128, lc = (wn & 1) * 64 + r, lr = wm * (IM * 32) + 4 * h;
    if constexpr (EPI == EPI_Z) {
      u16* st = (u16*)smem;
      if (mine) {
        u16* lb = st + lr * 136 + lc;
#pragma unroll
        for (int i = 0; i < IM; ++i)
#pragma unroll
          for (int j = 0; j < 2; ++j)
#pragma unroll
            for (int e = 0; e < 16; ++e) lb[(i * 32 + (e & 3) + 8 * (e >> 2)) * 136 + j * 32] = f2bf(acc[i][j][e]);
      }
      __syncthreads();
      u16* Z = (u16*)(p.ws + WS_Z) + (size_t)m0 * N + n0h;
#pragma unroll 2
      for (int i = 0; i < 8; ++i) {
        const int q = tid + i * NTHR, row = q >> 4, c = q & 15;
        *(u32x4*)(Z + (size_t)row * N + c * 8) = *(const u32x4*)(st + row * 136 + c * 8);
      }
      __syncthreads();
    } else if constexpr (EPI == EPI_RES) {
      float* st = (float*)smem;
      if (mine) {
        float* lb = st + lr * 132 + lc;
#pragma unroll
        for (int i = 0; i < IM; ++i)
#pragma unroll
          for (int j = 0; j < 2; ++j)
#pragma unroll
            for (int e = 0; e < 16; ++e) lb[(i * 32 + (e & 3) + 8 * (e >> 2)) * 132 + j * 32] = acc[i][j][e];
      }
      __syncthreads();
      float* xw = (float*)(p.ws + WS_XW) + (size_t)m0 * D + n0h;
      const float* g1p = (const float*)(p.ws + WS_MOD) + ((size_t)l * 5 + row_cls(m0)) * 6144 + 2048 + n0h;
      const int c = tid & 31;
      const float4 g1 = *(const float4*)(g1p + c * 4);
#pragma unroll 2
      for (int i = 0; i < 16; ++i) {
        const int row = (tid >> 5) + i * 16;
        const float4 a = *(const float4*)(st + row * 132 + c * 4);
        float4 xv = *(const float4*)(xw + (size_t)row * D + c * 4);
        xv.x += g1.x * a.x; xv.y += g1.y * a.y; xv.z += g1.z * a.z; xv.w += g1.w * a.w;
        *(float4*)(xw + (size_t)row * D + c * 4) = xv;
      }
      __syncthreads();
    } else {
      float* st = (float*)smem;
      if (mine) {
        float* lb = st + lr * 129 + lc;
#pragma unroll
        for (int i = 0; i < IM; ++i)
#pragma unroll
          for (int j = 0; j < 2; ++j)
#pragma unroll
            for (int e = 0; e < 16; ++e) lb[(i * 32 + (e & 3) + 8 * (e >> 2)) * 129 + j * 32] = acc[i][j][e];
      }
      __syncthreads();
      if (tid < 256) {
        float t16[16];
#pragma unroll
        for (int i = 0; i < 16; ++i) t16[i] = __uint_as_float(0xff800000u);
        for (int kk = 0; kk < 128; ++kk) {
          const float sv = st[tid * 129 + kk];
          const float x = __uint_as_float((__float_as_uint(sv) & ~0x7fu) | (unsigned)(127 - kk));
#pragma unroll
          for (int i = 15; i >= 1; --i) t16[i] = __builtin_amdgcn_fmed3f(x, t16[i - 1], t16[i]);
          t16[0] = fmaxf(t16[0], x);
        }
        unsigned* tk = (unsigned*)(p.ws + WS_TOPK) + ((size_t)(m0 + tid) * 16 + (n0h >> 7)) * 16;
#pragma unroll
        for (int q = 0; q < 4; ++q) {
          u32x4 o; o[0] = __float_as_uint(t16[q * 4]); o[1] = __float_as_uint(t16[q * 4 + 1]); o[2] = __float_as_uint(t16[q * 4 + 2]); o[3] = __float_as_uint(t16[q * 4 + 3]);
          *(u32x4*)(tk + q * 4) = o;
        }
      }
      __syncthreads();
    }
  }
}

template <int EPI>
DI void gemm_phase(KP p, unsigned char* smem, const u16* A, const u16* Bt, int M, int N, int K, int l, int bid, int nb, int m_tiles_active, int tid) {
  const int ntn = N / 128;
  const int ntiles = m_tiles_active * ntn;
#pragma unroll 1
  for (int tile = bid; tile < ntiles; tile += nb)
    gemm_tile<EPI, 128, true>(p, smem, A, Bt, N, K, l, (tile / ntn) * 256, (tile % ntn) * 128, tid);
}

namespace pg8 {
#define PG8_LAS __attribute__((address_space(3)))
typedef unsigned short bf16_t;
typedef short bf16x8 __attribute__((ext_vector_type(8)));
typedef float f32x4 __attribute__((ext_vector_type(4)));
typedef unsigned u32x4 __attribute__((ext_vector_type(4)));
constexpr int BM = 256, BK = 64, HALF = 128, HTB = HALF * BK * 2  , STAGE_BYTES = 8 * HTB, NXCD = 8, WGM = 8;

__host__ __device__ __forceinline__ int lds_byte(int r, int c) { const int st = (r >> 4) * 2 + (c >> 5), rr = r & 15, cc = c & 31, ob = rr * 64 + cc * 2; return st * 1024 + (ob ^ (((ob >> 9) & 1) << 5)); }
__host__ __device__ __forceinline__ void stage_rc(int b, int& R, int& C) { const int st = b / 1024, sb = b % 1024, swz = sb ^ (((sb >> 9) & 1) << 5); R = (st >> 1) * 16 + swz / 64; C = (st & 1) * 32 + (swz % 64) / 2; }
__host__ __device__ __forceinline__ int perm32(int rho) { const int n = rho >> 4, i = rho & 15; return 8 * (i >> 2) + 4 * n + (i & 3); }

struct Unit { int pm, pn; };
struct Gemm { const bf16_t* A; const bf16_t* Bt; int M, N, K; };

template <class Epi, class Sched>
__device__ __forceinline__ void gemm_phase(PG8_LAS unsigned char* lds, const Gemm g, const Sched& S, const Epi& E, const int tid) {
    const int wid = __builtin_amdgcn_readfirstlane(tid >> 6), lane = tid & 63, wr = wid >> 2, wc = wid & 3, fr = lane & 15, fq = lane >> 4;
    const int K = g.K, nt = K / BK;
    unsigned voffA[2], voffB[2];
#pragma unroll
    for (int i = 0; i < 2; ++i) { int R, C; stage_rc(tid * 16 + i * 8192, R, C); const int Rb = Epi::PERM ? ((R & ~31) + perm32(R & 31)) : R;
        voffA[i] = (unsigned)(R * K + C) * 2u; voffB[i] = (unsigned)(Rb * K + C) * 2u; }
    const size_t kstep = (size_t)(BK * 2);
    const size_t hstep = (size_t)HALF * K * 2;
    const size_t tstep = 2 * hstep;
    const unsigned ldsw = (unsigned)wid * 1024u;
    const int aoff = lds_byte(wr * 64 + fr, fq * 8), boff = lds_byte(wc * 32 + fr, fq * 8);
#define PG8_SA(b, h) (((b) * 2 + (h)) * HTB)
#define PG8_SB(b, h) ((4 + (b) * 2 + (h)) * HTB)
#define PG8_STAGE(bufoff, gbase, voff) do { _Pragma("unroll") for (int _i = 0; _i < 2; ++_i) \
        __builtin_amdgcn_global_load_lds((const unsigned*)((const char*)(gbase) + (voff)[_i]), (PG8_LAS unsigned*)(lds + (bufoff) + ldsw + _i * 8192), 16, 0, 0); } while (0)
#define PG8_LDA(dst, b, h) do { _Pragma("unroll") for (int m = 0; m < 4; ++m) _Pragma("unroll") for (int k = 0; k < 2; ++k) dst[m][k] = *(const PG8_LAS bf16x8*)(lds + PG8_SA(b, h) + aoff + m * 2048 + k * 1024); } while (0)
#define PG8_LDB(dst, b, h) do { _Pragma("unroll") for (int n = 0; n < 2; ++n) _Pragma("unroll") for (int k = 0; k < 2; ++k) dst[n][k] = *(const PG8_LAS bf16x8*)(lds + PG8_SB(b, h) + boff + n * 2048 + k * 1024); } while (0)
#define PG8_MMA(ai, bj, At, Bt) do { __builtin_amdgcn_s_setprio(1); _Pragma("unroll") for (int m = 0; m < 4; ++m) _Pragma("unroll") for (int n = 0; n < 2; ++n) _Pragma("unroll") for (int k = 0; k < 2; ++k) \
        acc[ai][bj][m][n] = __builtin_amdgcn_mfma_f32_16x16x32_bf16(Bt[n][k], At[m][k], acc[ai][bj][m][n], 0, 0, 0); __builtin_amdgcn_s_setprio(0); } while (0)
#define PG8_WAIT_V(n) asm volatile("s_waitcnt vmcnt(" #n ")" ::: "memory")
#define PG8_WAIT_L(n) asm volatile("s_waitcnt lgkmcnt(" #n ")" ::: "memory")
#define PG8_BAR __builtin_amdgcn_s_barrier()
#define PG8_SCHED __builtin_amdgcn_sched_barrier(0)
    Unit cur, nxt; int ui = 0;
    if (!S.next(0, cur)) return;
    f32x4 acc[2][2][4][2];
#pragma unroll
    for (int a = 0; a < 2; ++a)
#pragma unroll
        for (int b = 0; b < 2; ++b)
#pragma unroll
            for (int m = 0; m < 4; ++m)
#pragma unroll
                for (int n = 0; n < 2; ++n) acc[a][b][m][n] = (f32x4){0.f, 0.f, 0.f, 0.f};
    bf16x8 At[4][2], B0[2][2], B1[2][2];
    const char* cA = (const char*)g.A + (size_t)cur.pm * tstep; const char* cB = (const char*)g.Bt + (size_t)cur.pn * tstep;
    S.a_ready(cur);
    PG8_STAGE(PG8_SB(0, 0), cB, voffB); PG8_STAGE(PG8_SA(0, 0), cA, voffA); PG8_STAGE(PG8_SB(0, 1), cB + hstep, voffB); PG8_STAGE(PG8_SA(0, 1), cA + hstep, voffA);
    if (wr == 1) PG8_BAR;
    PG8_WAIT_V(4); PG8_BAR;
    PG8_STAGE(PG8_SB(1, 0), cB + kstep, voffB); PG8_STAGE(PG8_SA(1, 0), cA + kstep, voffA); PG8_STAGE(PG8_SB(1, 1), cB + hstep + kstep, voffB);
    PG8_WAIT_V(6); PG8_BAR;
    for (;;) {
        const bool has_next = S.next(ui + 1, nxt);
        const char* nA = has_next ? (const char*)g.A + (size_t)nxt.pm * tstep : cA; const char* nB = has_next ? (const char*)g.Bt + (size_t)nxt.pn * tstep : cB;
        for (int t = 0; t < nt; t += 2) {
            const bool last = (t == nt - 2);
            const char* a1 = cA + (size_t)(t + 1) * kstep;
            const char* a2 = last ? nA : cA + (size_t)(t + 2) * kstep; const char* b2 = last ? nB : cB + (size_t)(t + 2) * kstep;
            const char* a3 = a2 + kstep; const char* b3 = b2 + kstep;
            if (last && has_next) S.a_ready(nxt);
            PG8_LDB(B0, 0, 0); PG8_SCHED; PG8_LDA(At, 0, 0); PG8_STAGE(PG8_SA(1, 1), a1 + hstep, voffA);
            PG8_WAIT_L(8); PG8_BAR; PG8_WAIT_L(0); PG8_MMA(0, 0, At, B0); PG8_BAR; PG8_SCHED;
            PG8_LDB(B1, 0, 1); PG8_STAGE(PG8_SB(0, 0), b2, voffB);
            PG8_BAR; PG8_WAIT_L(0); PG8_MMA(0, 1, At, B1); PG8_BAR;
            PG8_LDA(At, 0, 1); PG8_STAGE(PG8_SA(0, 0), a2, voffA);
            PG8_BAR; PG8_WAIT_L(0); PG8_MMA(1, 0, At, B0); PG8_BAR; PG8_SCHED;
            PG8_STAGE(PG8_SB(0, 1), b2 + hstep, voffB);
            PG8_WAIT_V(6); PG8_BAR; PG8_MMA(1, 1, At, B1); PG8_BAR;
            PG8_LDB(B0, 1, 0); PG8_SCHED; PG8_LDA(At, 1, 0); PG8_STAGE(PG8_SA(0, 1), a2 + hstep, voffA);
            PG8_WAIT_L(8); PG8_BAR; PG8_WAIT_L(0); PG8_MMA(0, 0, At, B0); PG8_BAR; PG8_SCHED;
            PG8_LDB(B1, 1, 1); PG8_STAGE(PG8_SB(1, 0), b3, voffB);
            PG8_BAR; PG8_WAIT_L(0); PG8_MMA(0, 1, At, B1); PG8_BAR;
            PG8_LDA(At, 1, 1); PG8_STAGE(PG8_SA(1, 0), a3, voffA);
            PG8_BAR; PG8_WAIT_L(0); PG8_MMA(1, 0, At, B0); PG8_BAR; PG8_SCHED;
            PG8_STAGE(PG8_SB(1, 1), b3 + hstep, voffB);
            PG8_WAIT_V(6); PG8_BAR; PG8_MMA(1, 1, At, B1); PG8_BAR;
        }
        if constexpr (!Epi::AFTER_DRAIN) { E(acc, cur, wr, wc, fr, fq); S.done(cur); }
        if (!has_next) break;
#pragma unroll
        for (int a = 0; a < 2; ++a)
#pragma unroll
            for (int b = 0; b < 2; ++b)
#pragma unroll
                for (int m = 0; m < 4; ++m)
#pragma unroll
                    for (int n = 0; n < 2; ++n) acc[a][b][m][n] = (f32x4){0.f, 0.f, 0.f, 0.f};
        cur = nxt; cA = nA; cB = nB; ++ui;
    }
    PG8_WAIT_V(0);
    if (wr == 0) PG8_BAR;
    PG8_BAR;
    if constexpr (Epi::AFTER_DRAIN) { E.fused(acc, cur, wr, wc, fr, fq, lds, wid, lane); S.done(cur); }
#undef PG8_SA
#undef PG8_SB
#undef PG8_STAGE
#undef PG8_LDA
#undef PG8_LDB
#undef PG8_MMA
#undef PG8_WAIT_V
#undef PG8_WAIT_L
#undef PG8_BAR
#undef PG8_SCHED
}

typedef int i32x4 __attribute__((ext_vector_type(4)));
template <class Epi, class Sched>
__device__ __forceinline__ void gemm_phase_i8(PG8_LAS unsigned char* lds, const Gemm g, const Sched& S, const Epi& E, const int tid) {
    const int wid = __builtin_amdgcn_readfirstlane(tid >> 6), lane = tid & 63, wr = wid >> 2, wc = wid & 3, fr = lane & 15, fq = lane >> 4;
    const int K = g.K  , nt = K / (2 * BK);
    unsigned voffA[2], voffB[2];
#pragma unroll
    for (int i = 0; i < 2; ++i) { int R, C; stage_rc(tid * 16 + i * 8192, R, C); const int Rb = Epi::PERM ? ((R & ~31) + perm32(R & 31)) : R;
        voffA[i] = (unsigned)(R * K + 2 * C); voffB[i] = (unsigned)(Rb * K + 2 * C); }
    const size_t kstep = (size_t)(BK * 2);
    const size_t hstep = (size_t)HALF * K;
    const size_t tstep = 2 * hstep;
    const unsigned ldsw = (unsigned)wid * 1024u;
    const int aoff = lds_byte(wr * 64 + fr, fq * 8), boff = lds_byte(wc * 32 + fr, fq * 8);
#define PG8_SA(b, h) (((b) * 2 + (h)) * HTB)
#define PG8_SB(b, h) ((4 + (b) * 2 + (h)) * HTB)
#define PG8_STAGE(bufoff, gbase, voff) do { _Pragma("unroll") for (int _i = 0; _i < 2; ++_i) \
        __builtin_amdgcn_global_load_lds((const unsigned*)((const char*)(gbase) + (voff)[_i]), (PG8_LAS unsigned*)(lds + (bufoff) + ldsw + _i * 8192), 16, 0, 0); } while (0)
#define PG8_LDA(dst, b, h) do { _Pragma("unroll") for (int m = 0; m < 4; ++m) _Pragma("unroll") for (int k = 0; k < 2; ++k) dst[m][k] = *(const PG8_LAS bf16x8*)(lds + PG8_SA(b, h) + aoff + m * 2048 + k * 1024); } while (0)
#define PG8_LDB(dst, b, h) do { _Pragma("unroll") for (int n = 0; n < 2; ++n) _Pragma("unroll") for (int k = 0; k < 2; ++k) dst[n][k] = *(const PG8_LAS bf16x8*)(lds + PG8_SB(b, h) + boff + n * 2048 + k * 1024); } while (0)
#define PG8_MMA(ai, bj, At, Bt) do { __builtin_amdgcn_s_setprio(1); _Pragma("unroll") for (int m = 0; m < 4; ++m) _Pragma("unroll") for (int n = 0; n < 2; ++n) _Pragma("unroll") for (int k = 0; k < 2; ++k) \
        acc[ai][bj][m][n] = __builtin_amdgcn_mfma_i32_16x16x64_i8(__builtin_bit_cast(i32x4, Bt[n][k]), __builtin_bit_cast(i32x4, At[m][k]), acc[ai][bj][m][n], 0, 0, 0); __builtin_amdgcn_s_setprio(0); } while (0)
#define PG8_WAIT_V(n) asm volatile("s_waitcnt vmcnt(" #n ")" ::: "memory")
#define PG8_WAIT_L(n) asm volatile("s_waitcnt lgkmcnt(" #n ")" ::: "memory")
#define PG8_BAR __builtin_amdgcn_s_barrier()
#define PG8_SCHED __builtin_amdgcn_sched_barrier(0)
    Unit cur, nxt; int ui = 0;
    if (!S.next(0, cur)) return;
    i32x4 acc[2][2][4][2];
#pragma unroll
    for (int a = 0; a < 2; ++a)
#pragma unroll
        for (int b = 0; b < 2; ++b)
#pragma unroll
            for (int m = 0; m < 4; ++m)
#pragma unroll
                for (int n = 0; n < 2; ++n) acc[a][b][m][n] = (i32x4){0, 0, 0, 0};
    bf16x8 At[4][2], B0[2][2], B1[2][2];
    const char* cA = (const char*)g.A + (size_t)cur.pm * tstep; const char* cB = (const char*)g.Bt + (size_t)cur.pn * tstep;
    S.a_ready(cur);
    PG8_STAGE(PG8_SB(0, 0), cB, voffB); PG8_STAGE(PG8_SA(0, 0), cA, voffA); PG8_STAGE(PG8_SB(0, 1), cB + hstep, voffB); PG8_STAGE(PG8_SA(0, 1), cA + hstep, voffA);
    if (wr == 1) PG8_BAR;
    PG8_WAIT_V(4); PG8_BAR;
    PG8_STAGE(PG8_SB(1, 0), cB + kstep, voffB); PG8_STAGE(PG8_SA(1, 0), cA + kstep, voffA); PG8_STAGE(PG8_SB(1, 1), cB + hstep + kstep, voffB);
    PG8_WAIT_V(6); PG8_BAR;
    for (;;) {
        const bool has_next = S.next(ui + 1, nxt);
        const char* nA = has_next ? (const char*)g.A + (size_t)nxt.pm * tstep : cA; const char* nB = has_next ? (const char*)g.Bt + (size_t)nxt.pn * tstep : cB;
        for (int t = 0; t < nt; t += 2) {
            const bool last = (t == nt - 2);
            const char* a1 = cA + (size_t)(t + 1) * kstep;
            const char* a2 = last ? nA : cA + (size_t)(t + 2) * kstep; const char* b2 = last ? nB : cB + (size_t)(t + 2) * kstep;
            const char* a3 = a2 + kstep; const char* b3 = b2 + kstep;
            if (last && has_next) S.a_ready(nxt);
            PG8_LDB(B0, 0, 0); PG8_SCHED; PG8_LDA(At, 0, 0); PG8_STAGE(PG8_SA(1, 1), a1 + hstep, voffA);
            PG8_WAIT_L(8); PG8_BAR; PG8_WAIT_L(0); PG8_MMA(0, 0, At, B0); PG8_BAR; PG8_SCHED;
            PG8_LDB(B1, 0, 1); PG8_STAGE(PG8_SB(0, 0), b2, voffB);
            PG8_BAR; PG8_WAIT_L(0); PG8_MMA(0, 1, At, B1); PG8_BAR;
            PG8_LDA(At, 0, 1); PG8_STAGE(PG8_SA(0, 0), a2, voffA);
            PG8_BAR; PG8_WAIT_L(0); PG8_MMA(1, 0, At, B0); PG8_BAR; PG8_SCHED;
            PG8_STAGE(PG8_SB(0, 1), b2 + hstep, voffB);
            PG8_WAIT_V(6); PG8_BAR; PG8_MMA(1, 1, At, B1); PG8_BAR;
            PG8_LDB(B0, 1, 0); PG8_SCHED; PG8_LDA(At, 1, 0); PG8_STAGE(PG8_SA(0, 1), a2 + hstep, voffA);
            PG8_WAIT_L(8); PG8_BAR; PG8_WAIT_L(0); PG8_MMA(0, 0, At, B0); PG8_BAR; PG8_SCHED;
            PG8_LDB(B1, 1, 1); PG8_STAGE(PG8_SB(1, 0), b3, voffB);
            PG8_BAR; PG8_WAIT_L(0); PG8_MMA(0, 1, At, B1); PG8_BAR;
            PG8_LDA(At, 1, 1); PG8_STAGE(PG8_SA(1, 0), a3, voffA);
            PG8_BAR; PG8_WAIT_L(0); PG8_MMA(1, 0, At, B0); PG8_BAR; PG8_SCHED;
            PG8_STAGE(PG8_SB(1, 1), b3 + hstep, voffB);
            PG8_WAIT_V(6); PG8_BAR; PG8_MMA(1, 1, At, B1); PG8_BAR;
        }
        if constexpr (!Epi::AFTER_DRAIN) { E(acc, cur, wr, wc, fr, fq); S.done(cur); }
        if (!has_next) break;
#pragma unroll
        for (int a = 0; a < 2; ++a)
#pragma unroll
            for (int b = 0; b < 2; ++b)
#pragma unroll
                for (int m = 0; m < 4; ++m)
#pragma unroll
                    for (int n = 0; n < 2; ++n) acc[a][b][m][n] = (i32x4){0, 0, 0, 0};
        cur = nxt; cA = nA; cB = nB; ++ui;
    }
    PG8_WAIT_V(0);
    if (wr == 0) PG8_BAR;
    PG8_BAR;
    if constexpr (Epi::AFTER_DRAIN) { E.fused(acc, cur, wr, wc, fr, fq, lds, wid, lane); S.done(cur); }
#undef PG8_SA
#undef PG8_SB
#undef PG8_STAGE
#undef PG8_LDA
#undef PG8_LDB
#undef PG8_MMA
#undef PG8_WAIT_V
#undef PG8_WAIT_L
#undef PG8_BAR
#undef PG8_SCHED
}

struct LinOrder {
  int nN, nunits, G, c;
  __device__ __forceinline__ bool next(int i, Unit& u) const { const int L = i * G + c; if (L >= nunits) return false; u.pm = L / nN; u.pn = L % nN; return true; }
  __device__ __forceinline__ void a_ready(const Unit&) const {}
  __device__ __forceinline__ void done(const Unit&) const {}
};
struct OneUnit {
  Unit u0;
  __device__ __forceinline__ bool next(int i, Unit& u) const { if (i) return false; u = u0; return true; }
  __device__ __forceinline__ void a_ready(const Unit&) const {}
  __device__ __forceinline__ void done(const Unit&) const {}
};
struct EpiZ {
  static constexpr bool PERM = true, AFTER_DRAIN = false;
  bf16_t* O; int ldc;
  __device__ __forceinline__ void operator()(const f32x4 (&acc)[2][2][4][2], const Unit& u, int wr, int wc, int fr, int fq) const {
    const int row0 = u.pm * BM + wr * 64 + fr, col0 = u.pn * BM + wc * 32 + 8 * fq;
#pragma unroll
    for (int ai = 0; ai < 2; ++ai)
#pragma unroll
      for (int m = 0; m < 4; ++m) { bf16_t* rowp = O + (size_t)(row0 + ai * HALF + m * 16) * ldc + col0;
#pragma unroll
        for (int bj = 0; bj < 2; ++bj) { const f32x4 v0 = acc[ai][bj][m][0], v1 = acc[ai][bj][m][1];
          u32x4 w; w.x = ::pack2(v0[0], v0[1]); w.y = ::pack2(v0[2], v0[3]); w.z = ::pack2(v1[0], v1[1]); w.w = ::pack2(v1[2], v1[3]);
          *(u32x4*)(rowp + bj * HALF) = w; } }
  }
};
struct EpiRes {
  static constexpr bool PERM = false, AFTER_DRAIN = false;
  float* xw; const float* modl;
  __device__ __forceinline__ void operator()(const f32x4 (&acc)[2][2][4][2], const Unit& u, int wr, int wc, int fr, int fq) const {
    const int row0 = u.pm * BM + wr * 64 + fr, col0 = u.pn * BM + wc * 32 + 4 * fq;
    const float* g1p = modl + (size_t)::row_cls(u.pm * BM) * 6144 + 2048 + col0;
    f32x4 gv[2][2];
#pragma unroll
    for (int bj = 0; bj < 2; ++bj)
#pragma unroll
      for (int n = 0; n < 2; ++n) gv[bj][n] = *(const f32x4*)(g1p + bj * HALF + n * 16);
#pragma unroll
    for (int ai = 0; ai < 2; ++ai)
#pragma unroll
      for (int m = 0; m < 4; ++m) { float* rowp = xw + (size_t)(row0 + ai * HALF + m * 16) * 1024 + col0;
#pragma unroll
        for (int bj = 0; bj < 2; ++bj)
#pragma unroll
          for (int n = 0; n < 2; ++n) { f32x4 xv = *(const f32x4*)(rowp + bj * HALF + n * 16); xv += gv[bj][n] * acc[ai][bj][m][n]; *(f32x4*)(rowp + bj * HALF + n * 16) = xv; } }
  }
};
struct EpiTopk {
  static constexpr bool PERM = false, AFTER_DRAIN = true;
  unsigned* topk;
  __device__ __forceinline__ void operator()(const f32x4 (&)[2][2][4][2], const Unit&, int, int, int, int) const {}
  __device__ __forceinline__ void fused(const f32x4 (&acc)[2][2][4][2], const Unit& u, int wr, int wc, int fr, int fq, PG8_LAS unsigned char* lds, int wid, int lane) const {
    PG8_LAS float* st = (PG8_LAS float*)lds;
    const int tid = wid * 64 + lane;
#pragma unroll 1
    for (int bj = 0; bj < 2; ++bj) {
#pragma unroll
      for (int ai = 0; ai < 2; ++ai)
#pragma unroll
        for (int m = 0; m < 4; ++m)
#pragma unroll
          for (int n = 0; n < 2; ++n) {
            PG8_LAS float* q = st + (ai * HALF + wr * 64 + m * 16 + fr) * 129 + wc * 32 + n * 16 + 4 * fq;
            const f32x4 v = bj == 0 ? acc[ai][0][m][n] : acc[ai][1][m][n];
            q[0] = v[0]; q[1] = v[1]; q[2] = v[2]; q[3] = v[3];
          }
      asm volatile("s_waitcnt lgkmcnt(0)" ::: "memory"); __builtin_amdgcn_s_barrier(); asm volatile("" ::: "memory");
      if (tid < 256) {
        float t16[16];
#pragma unroll
        for (int i = 0; i < 16; ++i) t16[i] = __uint_as_float(0xff800000u);
        for (int kk = 0; kk < 128; ++kk) {
          const float sv = st[tid * 129 + kk];
          const float x = __uint_as_float((__float_as_uint(sv) & ~0x7fu) | (unsigned)(127 - kk));
#pragma unroll
          for (int i = 15; i >= 1; --i) t16[i] = __builtin_amdgcn_fmed3f(x, t16[i - 1], t16[i]);
          t16[0] = fmaxf(t16[0], x);
        }
        unsigned* tk = topk + ((size_t)(u.pm * BM + tid) * 16 + (u.pn * 2 + bj)) * 16;
#pragma unroll
        for (int q = 0; q < 4; ++q) {
          u32x4 o; o.x = __float_as_uint(t16[q * 4]); o.y = __float_as_uint(t16[q * 4 + 1]); o.z = __float_as_uint(t16[q * 4 + 2]); o.w = __float_as_uint(t16[q * 4 + 3]);
          *(u32x4*)(tk + q * 4) = o;
        }
      }
      asm volatile("s_waitcnt lgkmcnt(0)" ::: "memory"); __builtin_amdgcn_s_barrier(); asm volatile("" ::: "memory");
    }
  }
};
struct EpiZI8 {
  static constexpr bool PERM = true, AFTER_DRAIN = false;
  bf16_t* O; int ldc; const float* rsc; const float* csc;
  __device__ __forceinline__ void operator()(const i32x4 (&acc)[2][2][4][2], const Unit& u, int wr, int wc, int fr, int fq) const {
    const int row0 = u.pm * BM + wr * 64 + fr, col0 = u.pn * BM + wc * 32 + 8 * fq;
    f32x4 cs[2][2];
#pragma unroll
    for (int bj = 0; bj < 2; ++bj)
#pragma unroll
      for (int n = 0; n < 2; ++n) cs[bj][n] = *(const f32x4*)(csc + col0 + bj * HALF + 4 * n);
#pragma unroll
    for (int ai = 0; ai < 2; ++ai)
#pragma unroll
      for (int m = 0; m < 4; ++m) { const int row = row0 + ai * HALF + m * 16; const float rs = rsc[row]; bf16_t* rowp = O + (size_t)row * ldc + col0;
#pragma unroll
        for (int bj = 0; bj < 2; ++bj) { const i32x4 a0 = acc[ai][bj][m][0], a1 = acc[ai][bj][m][1];
          u32x4 w;
          w.x = ::pack2((float)a0[0] * rs * cs[bj][0][0], (float)a0[1] * rs * cs[bj][0][1]); w.y = ::pack2((float)a0[2] * rs * cs[bj][0][2], (float)a0[3] * rs * cs[bj][0][3]);
          w.z = ::pack2((float)a1[0] * rs * cs[bj][1][0], (float)a1[1] * rs * cs[bj][1][1]); w.w = ::pack2((float)a1[2] * rs * cs[bj][1][2], (float)a1[3] * rs * cs[bj][1][3]);
          *(u32x4*)(rowp + bj * HALF) = w; } }
  }
};
struct EpiTopkI8 {
  static constexpr bool PERM = false, AFTER_DRAIN = true;
  unsigned* topk; const float* rsc; const float* csc;
  __device__ __forceinline__ void operator()(const i32x4 (&)[2][2][4][2], const Unit&, int, int, int, int) const {}
  __device__ __forceinline__ void fused(const i32x4 (&acc)[2][2][4][2], const Unit& u, int wr, int wc, int fr, int fq, PG8_LAS unsigned char* lds, int wid, int lane) const {
    PG8_LAS float* st = (PG8_LAS float*)lds;
    const int tid = wid * 64 + lane;
    float rs[2][4];
#pragma unroll
    for (int ai = 0; ai < 2; ++ai)
#pragma unroll
      for (int m = 0; m < 4; ++m) rs[ai][m] = rsc[u.pm * BM + ai * HALF + wr * 64 + m * 16 + fr];
#pragma unroll 1
    for (int bj = 0; bj < 2; ++bj) {
      f32x4 cs[2];
#pragma unroll
      for (int n = 0; n < 2; ++n) cs[n] = *(const f32x4*)(csc + u.pn * BM + bj * HALF + wc * 32 + n * 16 + 4 * fq);
#pragma unroll
      for (int ai = 0; ai < 2; ++ai)
#pragma unroll
        for (int m = 0; m < 4; ++m)
#pragma unroll
          for (int n = 0; n < 2; ++n) {
            PG8_LAS float* q = st + (ai * HALF + wr * 64 + m * 16 + fr) * 129 + wc * 32 + n * 16 + 4 * fq;
            const i32x4 v = bj == 0 ? acc[ai][0][m][n] : acc[ai][1][m][n];
            q[0] = (float)v[0] * rs[ai][m] * cs[n][0]; q[1] = (float)v[1] * rs[ai][m] * cs[n][1]; q[2] = (float)v[2] * rs[ai][m] * cs[n][2]; q[3] = (float)v[3] * rs[ai][m] * cs[n][3];
          }
      asm volatile("s_waitcnt lgkmcnt(0)" ::: "memory"); __builtin_amdgcn_s_barrier(); asm volatile("" ::: "memory");
      if (tid < 256) {
        float t16[16];
#pragma unroll
        for (int i = 0; i < 16; ++i) t16[i] = __uint_as_float(0xff800000u);
        for (int kk = 0; kk < 128; ++kk) {
          const float sv = st[tid * 129 + kk];
          const float x = __uint_as_float((__float_as_uint(sv) & ~0x7fu) | (unsigned)(127 - kk));
#pragma unroll
          for (int i = 15; i >= 1; --i) t16[i] = __builtin_amdgcn_fmed3f(x, t16[i - 1], t16[i]);
          t16[0] = fmaxf(t16[0], x);
        }
        unsigned* tk = topk + ((size_t)(u.pm * BM + tid) * 16 + (u.pn * 2 + bj)) * 16;
#pragma unroll
        for (int q = 0; q < 4; ++q) {
          u32x4 o; o.x = __float_as_uint(t16[q * 4]); o.y = __float_as_uint(t16[q * 4 + 1]); o.z = __float_as_uint(t16[q * 4 + 2]); o.w = __float_as_uint(t16[q * 4 + 3]);
          *(u32x4*)(tk + q * 4) = o;
        }
      }
      asm volatile("s_waitcnt lgkmcnt(0)" ::: "memory"); __builtin_amdgcn_s_barrier(); asm volatile("" ::: "memory");
    }
  }
};
}

enum { G8_Z = 0, G8_RES = 1, G8_TOPK = 2 };
template <int EPI>
DI void gemm8_phase(KP p, unsigned char* smem, const u16* A, const u16* Bt, int N, int K, int l, int bid, int nb, int m_tiles_active, int tid) {
  pg8::Gemm g{A, Bt, m_tiles_active * 256, N, K};
  const int nN = N / 256, nunits = m_tiles_active * nN;
  PG8_LAS unsigned char* lds = (PG8_LAS unsigned char*)smem;
  if constexpr (EPI == G8_Z) {
    pg8::LinOrder S{nN, nunits, nb, bid};
    pg8::Gemm g8{(const pg8::bf16_t*)(p.ws + WS_HXQ), (const pg8::bf16_t*)(p.ws + WS_WINQ + (size_t)l * 4096 * 1024), m_tiles_active * 256, N, K};
    pg8::EpiZI8 E{(pg8::bf16_t*)(p.ws + WS_Z), N, (const float*)(p.ws + WS_HXS), (const float*)(p.ws + WS_WINS) + (size_t)l * 4096};
    pg8::gemm_phase_i8<pg8::EpiZI8, pg8::LinOrder>(lds, g8, S, E, tid);
  } else if constexpr (EPI == G8_RES) {
    pg8::LinOrder S{nN, nunits, nb, bid};
    pg8::EpiRes E{(float*)(p.ws + WS_XW), (const float*)(p.ws + WS_MOD) + (size_t)l * 5 * 6144};
    pg8::gemm_phase<pg8::EpiRes, pg8::LinOrder>(lds, g, S, E, tid);
  } else {
    pg8::Gemm g8{(const pg8::bf16_t*)(p.ws + WS_HXQ), (const pg8::bf16_t*)(p.ws + WS_WSQ + (size_t)l * 2048 * 1024), m_tiles_active * 256, N, K};
    pg8::EpiTopkI8 E{(unsigned*)(p.ws + WS_TOPK), (const float*)(p.ws + WS_HXS), (const float*)(p.ws + WS_WSS) + (size_t)l * 2048};
#pragma unroll 1
    for (int L = bid; L < nunits; L += nb) {
      pg8::OneUnit S{pg8::Unit{L / nN, L % nN}};
      pg8::gemm_phase_i8<pg8::EpiTopkI8, pg8::OneUnit>(lds, g8, S, E, tid);
    }
  }
  __syncthreads();
  if constexpr (EPI == G8_RES || EPI == G8_TOPK) {
    const int rem = nunits % nb;
    if (l + 1 < DEPTH && rem != 0 && bid >= rem) {
      const float* src = (EPI == G8_RES ? p.peer_u : p.peer_v);
      unsigned char* dst = p.ws + (EPI == G8_RES ? WS_UB : WS_VB);
      float* scl = (float*)(p.ws + (EPI == G8_RES ? WS_US : WS_VS));
#pragma unroll 1
      for (int it = bid - rem; it < 256; it += nb - rem) p0_quant_rows(src, dst, scl, (l + 1) * NEXP + it * 64, tid, 0.f);
    }
  }
}

constexpr float LOG2E = 1.4426950408889634f;
DI int seg_row0(int b, int j) { return j < 2 ? NLAT + b * CTXL + 128 * j : b * SEQ + 128 * (j - 2); }
DI int pi_bwd(int j) { return j < 2 ? 1 - j : 35 - j; }
DI float ex2(float x) { return __builtin_amdgcn_exp2f(x); }
DI unsigned sw32(int row, int col) { return (unsigned)(row * 64 + ((((col >> 3) ^ ((row >> 2) & 3))) << 4) + (col & 7) * 2); }
DI bf16x8 pack8(float a0, float a1, float a2, float a3, float a4, float a5, float a6, float a7) {
  u32x4 p; p[0] = pack2(a0, a1); p[1] = pack2(a2, a3); p[2] = pack2(a4, a5); p[3] = pack2(a6, a7);
  return __builtin_bit_cast(bf16x8, p);
}
DI bf16x8 cat8(u32x2 lo, u32x2 hi) { u32x4 p; p[0] = lo[0]; p[1] = lo[1]; p[2] = hi[0]; p[3] = hi[1]; return __builtin_bit_cast(bf16x8, p); }

DI void rec_pass1(KP p, unsigned char* smem, int l, int item, int tid) {
  const int j = item % 34, bh = item / 34, b = bh >> 2, hd = bh & 3;
  const int R0 = seg_row0(b, j);
  const int lane = tid & 63, wave = tid >> 6, r = lane & 31, h = lane >> 5;
  unsigned char* KOT = smem;
  unsigned char* VT = smem + 65536;
  float* TX = (float*)(smem + 98304);
  const u16* Z = (const u16*)(p.ws + WS_Z);
  const int k = tid & 127, qd = tid >> 7;
  unsigned char* STG = smem + 100352;
  u32x4 pre[4];
  auto gstage = [&](int colbase) {
#pragma unroll
    for (int u = 0; u < 4; ++u) { const int q = tid + NTHR * u; pre[u] = *(const u32x4*)(Z + (size_t)(R0 + (q >> 4)) * INC + colbase + (q & 15) * 8); }
  };
  auto wstage = [&]() {
#pragma unroll
    for (int u = 0; u < 4; ++u) { const int q = tid + NTHR * u; *(u32x4*)(STG + q * 16) = pre[u]; }
  };
  gstage(hd * 128);
  wstage();
  __syncthreads();
  gstage(512 + hd * 128);
  {
    u16 vv[32];
#pragma unroll
    for (int ii = 0; ii < 32; ++ii) vv[ii] = *(const u16*)(STG + (32 * qd + ii) * 256 + k * 2);
#pragma unroll
    for (int c4 = 0; c4 < 4; ++c4) {
      u32x4 o;
#pragma unroll
      for (int e = 0; e < 4; ++e) o[e] = (unsigned)vv[c4 * 8 + 2 * e] | ((unsigned)vv[c4 * 8 + 2 * e + 1] << 16);
      *(u32x4*)(VT + sw128(k, 32 * qd + 8 * c4)) = o;
    }
  }
  __syncthreads();
#pragma unroll 1
  for (int d = 0; d < 2; ++d) {
    wstage();
    __syncthreads();
    if (d == 0) gstage(1024 + hd * 128);
    const float lb = ((const float*)(p.ws + WS_LOWER))[((size_t)l * 2 + d) * 512 + hd * 128 + k];
    float lf[32], kk[32];
    float tot = 0.f;
#pragma unroll
    for (int ii = 0; ii < 32; ++ii) {
      const float z = bf2f(*(const u16*)(STG + (32 * qd + ii) * 256 + k * 2));
      const float sg = __builtin_amdgcn_rcpf(1.f + ex2(-z * LOG2E));
      const float f = fmaxf(lb + (1.f - lb) * sg, 1e-20f);
      lf[ii] = __builtin_amdgcn_logf(f);
      kk[ii] = (1.f - lb) * (1.f - sg);
      tot += lf[ii];
    }
    TX[qd * 128 + k] = tot;
    __syncthreads();
    const float t0 = TX[k], t1 = TX[128 + k], t2 = TX[256 + k], t3 = TX[384 + k];
    float run;
    if (d == 0) run = (qd == 0 ? t1 + t2 + t3 : qd == 1 ? t2 + t3 : qd == 2 ? t3 : 0.f);
    else run = (qd == 0 ? 0.f : qd == 1 ? t0 : qd == 2 ? t0 + t1 : t0 + t1 + t2);
    float ko[32];
    if (d == 0) {
#pragma unroll
      for (int ii = 31; ii >= 0; --ii) { ko[ii] = kk[ii] * ex2(run); run += lf[ii]; }
    } else {
#pragma unroll
      for (int ii = 0; ii < 32; ++ii) { ko[ii] = kk[ii] * ex2(run); run += lf[ii]; }
    }
#pragma unroll
    for (int c4 = 0; c4 < 4; ++c4) {
      u32x4 o;
#pragma unroll
      for (int e = 0; e < 4; ++e) o[e] = pack2(ko[c4 * 8 + 2 * e], ko[c4 * 8 + 2 * e + 1]);
      *(u32x4*)(KOT + d * 32768 + sw128(k, 32 * qd + 8 * c4)) = o;
    }
    if (qd == 0) {
      const int pi = d ? pi_bwd(j) : j;
      ((float*)(p.ws + WS_DT))[((size_t)(bh * 2 + d) * 34 + pi) * 128 + k] = ex2(t0 + t1 + t2 + t3);
    }
    __syncthreads();
  }
  {
    const int d = wave >> 2, w4 = wave & 3;
    f32x16 acc[4];
#pragma unroll
    for (int mt = 0; mt < 4; ++mt)
#pragma unroll
      for (int e = 0; e < 16; ++e) acc[mt][e] = 0.f;
#pragma unroll
    for (int ks = 0; ks < 8; ++ks) {
      const bf16x8 bv = *(const bf16x8*)(VT + sw128(32 * w4 + r, 16 * ks + 8 * h));
#pragma unroll
      for (int mt = 0; mt < 4; ++mt) {
        const bf16x8 av = *(const bf16x8*)(KOT + d * 32768 + sw128(32 * mt + r, 16 * ks + 8 * h));
        acc[mt] = __builtin_amdgcn_mfma_f32_32x32x16_bf16(av, bv, acc[mt], 0, 0, 0);
      }
    }
    const int pi = d ? pi_bwd(j) : j;
    u16* sl = (u16*)(p.ws + WS_SLOC) + ((size_t)(bh * 2 + d) * 34 + pi) * 16384;
#pragma unroll
    for (int mt = 0; mt < 4; ++mt)
#pragma unroll
      for (int g = 0; g < 4; ++g) {
        u32x2 o; o[0] = pack2(acc[mt][4 * g], acc[mt][4 * g + 1]); o[1] = pack2(acc[mt][4 * g + 2], acc[mt][4 * g + 3]);
        *(u32x2*)(sl + ((((w4 * 4 + mt) * 4 + g) * 64 + lane) * 4)) = o;
      }
  }
  __syncthreads();
}

DI void rec_pass2(KP p, int bid, int nb, int tid) {
  const u16* SL = (const u16*)(p.ws + WS_SLOC);
  u16* SS = (u16*)(p.ws + WS_SST);
  const float* DT = (const float*)(p.ws + WS_DT);
  for (int gid = bid * NTHR + tid; gid < 32 * 4096; gid += nb * NTHR) {
    const int seq = gid >> 12, grp = gid & 4095;
    const int lane = grp & 63, g = (grp >> 6) & 3, mt = (grp >> 8) & 3;
    const int k0 = 32 * mt + 8 * g + 4 * (lane >> 5);
    const u16* sl = SL + (size_t)seq * 34 * 16384 + grp * 4;
    u16* ss = SS + (size_t)seq * 34 * 16384 + grp * 4;
    const float* dt = DT + (size_t)seq * 34 * 128 + k0;
    float s0 = 0.f, s1 = 0.f, s2 = 0.f, s3 = 0.f;
#pragma unroll 3
    for (int pi = 0; pi < 33; ++pi) {
      const u32x2 w = *(const u32x2*)(sl + (size_t)pi * 16384);
      const float4 dd = *(const float4*)(dt + pi * 128);
      s0 = dd.x * s0 + bflo(w[0]); s1 = dd.y * s1 + bfhi(w[0]); s2 = dd.z * s2 + bflo(w[1]); s3 = dd.w * s3 + bfhi(w[1]);
      u32x2 o; o[0] = pack2(s0, s1); o[1] = pack2(s2, s3);
      *(u32x2*)(ss + (size_t)(pi + 1) * 16384) = o;
    }
  }
}

DI void rec_pass3(KP p, unsigned char* smem, int l, int item, int tid) {
  const int j = item % 34, bh = item / 34, b = bh >> 2, hd = bh & 3;
  const int R0 = seg_row0(b, j);
  const int lane = tid & 63, wave = tid >> 6, r = lane & 31, h = lane >> 5;
  const int d = tid >> 8, tt = tid & 255, w4 = wave & 3;
  unsigned char* base = smem + d * 67584;
  unsigned char* SZ = base, *SQ = base + 8192, *SV = base + 16384;
  unsigned char* QT = base + 24576, *KT = base + 32768, *QI = base + 40960, *KOT = base + 49152, *VT = base + 57344;
  float* DTc = (float*)(base + 65536);
  float* TX = (float*)(base + 66048);
  const u16* Z = (const u16*)(p.ws + WS_Z);
  float* O = (float*)(p.ws + (d ? WS_OB : WS_OF));
  const int pi = d ? pi_bwd(j) : j;
  f32x16 S[4];
  if (pi == 0) {
#pragma unroll
    for (int mt = 0; mt < 4; ++mt)
#pragma unroll
      for (int e = 0; e < 16; ++e) S[mt][e] = 0.f;
  } else {
    const u16* ss = (const u16*)(p.ws + WS_SST) + ((size_t)(bh * 2 + d) * 34 + pi) * 16384;
#pragma unroll
    for (int mt = 0; mt < 4; ++mt)
#pragma unroll
      for (int g = 0; g < 4; ++g) {
        const u32x2 w = *(const u32x2*)(ss + ((((w4 * 4 + mt) * 4 + g) * 64 + lane) * 4));
        S[mt][4 * g] = bflo(w[0]); S[mt][4 * g + 1] = bfhi(w[0]); S[mt][4 * g + 2] = bflo(w[1]); S[mt][4 * g + 3] = bfhi(w[1]);
      }
  }
  const int k = tt & 127, half = tt >> 7;
  const float lb = ((const float*)(p.ws + WS_LOWER))[((size_t)l * 2 + d) * 512 + hd * 128 + k];
  const int zg_col = (d ? 1024 : 512) + hd * 128, q_col = 1536 + hd * 128, v_col = hd * 128;
  u32x4 pz[2], pq[2], pv[2];
  auto gl = [&](int c) {
#pragma unroll
    for (int u = 0; u < 2; ++u) {
      const int q = tt + 256 * u, i = q >> 4, c16 = q & 15;
      const int n = d ? (127 - 32 * c - i) : (32 * c + i);
      const u16* zr = Z + (size_t)(R0 + n) * INC + c16 * 8;
      pz[u] = *(const u32x4*)(zr + zg_col); pq[u] = *(const u32x4*)(zr + q_col); pv[u] = *(const u32x4*)(zr + v_col);
    }
  };
  gl(0);
#pragma unroll 1
  for (int c = 0; c < 4; ++c) {
#pragma unroll
    for (int u = 0; u < 2; ++u) {
      const int q = tt + 256 * u;
      *(u32x4*)(SZ + q * 16) = pz[u]; *(u32x4*)(SQ + q * 16) = pq[u]; *(u32x4*)(SV + q * 16) = pv[u];
    }
    __syncthreads();
    if (c + 1 < 4) gl(c + 1);
    {
      float cc = 0.f;
#pragma unroll
      for (int ii = 0; ii < 16; ++ii) {
        const int i = 16 * half + ii;
        const float z = bf2f(*(const u16*)(SZ + i * 256 + k * 2));
        const float sg = __builtin_amdgcn_rcpf(1.f + ex2(-z * LOG2E));
        const float f = fmaxf(lb + (1.f - lb) * sg, 1e-20f);
        cc += __builtin_amdgcn_logf(f);
      }
      TX[half * 128 + k] = cc;
    }
    __syncthreads();
    {
      const float T0 = TX[k], T1 = TX[128 + k];
      const float e0 = ex2(T0), e1 = ex2(T1);
      float ko[16];
      float cc = 0.f;
#pragma unroll
      for (int ii = 0; ii < 16; ++ii) {
        const int i = 16 * half + ii;
        const float z = bf2f(*(const u16*)(SZ + i * 256 + k * 2));
        const float sg = __builtin_amdgcn_rcpf(1.f + ex2(-z * LOG2E));
        const float f = fmaxf(lb + (1.f - lb) * sg, 1e-20f);
        cc += __builtin_amdgcn_logf(f);
        const float kk = (1.f - lb) * (1.f - sg);
        const float qq = bf2f(*(const u16*)(SQ + i * 256 + k * 2));
        float qt, qi, kt;
        if (half == 0) {
          qt = qq * ex2(fminf(cc - T0, 120.f)); qi = qq * ex2(cc);
          kt = kk * ex2(T0 - cc); ko[ii] = kt * e1;
        } else {
          qt = qq * ex2(cc); qi = qt * e0;
          kt = kk * ex2(fminf(-cc, 120.f)); ko[ii] = kk * ex2(T1 - cc);
        }
        *(u16*)(QT + sw128(i, k)) = f2bf(qt); *(u16*)(KT + sw128(i, k)) = f2bf(kt); *(u16*)(QI + sw128(i, k)) = f2bf(qi);
      }
      if (half == 0) DTc[k] = e0 * e1;
      u32x4 o0, o1;
#pragma unroll
      for (int e = 0; e < 4; ++e) { o0[e] = pack2(ko[2 * e], ko[2 * e + 1]); o1[e] = pack2(ko[8 + 2 * e], ko[8 + 2 * e + 1]); }
      *(u32x4*)(KOT + sw32(k, 16 * half)) = o0; *(u32x4*)(KOT + sw32(k, 16 * half + 8)) = o1;
      u32x4 v0, v1;
#pragma unroll
      for (int e = 0; e < 4; ++e) {
        v0[e] = (unsigned)*(const u16*)(SV + (16 * half + 2 * e) * 256 + k * 2) | ((unsigned)*(const u16*)(SV + (16 * half + 2 * e + 1) * 256 + k * 2) << 16);
        v1[e] = (unsigned)*(const u16*)(SV + (16 * half + 8 + 2 * e) * 256 + k * 2) | ((unsigned)*(const u16*)(SV + (16 * half + 8 + 2 * e + 1) * 256 + k * 2) << 16);
      }
      *(u32x4*)(VT + sw32(k, 16 * half)) = v0; *(u32x4*)(VT + sw32(k, 16 * half + 8)) = v1;
    }
    __syncthreads();
    {
      f32x16 X;
#pragma unroll
      for (int e = 0; e < 16; ++e) X[e] = 0.f;
#pragma unroll 2
      for (int ks = 0; ks < 8; ++ks) {
        const bf16x8 a = *(const bf16x8*)(KT + sw128(r, 16 * ks + 8 * h));
        const bf16x8 bq = *(const bf16x8*)(QT + sw128(r, 16 * ks + 8 * h));
        X = __builtin_amdgcn_mfma_f32_32x32x16_bf16(a, bq, X, 0, 0, 0);
      }
#pragma unroll
      for (int e = 0; e < 16; ++e) { const int sidx = (e & 3) + 8 * (e >> 2) + 4 * h; if (sidx > r) X[e] = 0.f; }
      f32x16 o;
#pragma unroll
      for (int e = 0; e < 16; ++e) o[e] = 0.f;
#pragma unroll
      for (int s2 = 0; s2 < 2; ++s2) {
        const bf16x8 xa = pack8(X[8 * s2], X[8 * s2 + 1], X[8 * s2 + 2], X[8 * s2 + 3], X[8 * s2 + 4], X[8 * s2 + 5], X[8 * s2 + 6], X[8 * s2 + 7]);
        const u32x2 lo = *(const u32x2*)(VT + sw32(32 * w4 + r, 16 * s2 + 4 * h));
        const u32x2 hi = *(const u32x2*)(VT + sw32(32 * w4 + r, 16 * s2 + 8 + 4 * h));
        o = __builtin_amdgcn_mfma_f32_32x32x16_bf16(xa, cat8(lo, hi), o, 0, 0, 0);
      }
#pragma unroll
      for (int mt = 0; mt < 4; ++mt)
#pragma unroll
        for (int s2 = 0; s2 < 2; ++s2) {
          const bf16x8 sb = pack8(S[mt][8 * s2], S[mt][8 * s2 + 1], S[mt][8 * s2 + 2], S[mt][8 * s2 + 3], S[mt][8 * s2 + 4], S[mt][8 * s2 + 5], S[mt][8 * s2 + 6], S[mt][8 * s2 + 7]);
          const u32x2 lo = *(const u32x2*)(QI + sw128(r, 32 * mt + 16 * s2 + 4 * h));
          const u32x2 hi = *(const u32x2*)(QI + sw128(r, 32 * mt + 16 * s2 + 8 + 4 * h));
          o = __builtin_amdgcn_mfma_f32_32x32x16_bf16(cat8(lo, hi), sb, o, 0, 0, 0);
          if (s2 == 1) __builtin_amdgcn_sched_barrier(0);
        }
#pragma unroll
      for (int mt = 0; mt < 4; ++mt)
#pragma unroll
        for (int g = 0; g < 4; ++g) {
          const float4 dd = *(const float4*)(DTc + 32 * mt + 8 * g + 4 * h);
          S[mt][4 * g] *= dd.x; S[mt][4 * g + 1] *= dd.y; S[mt][4 * g + 2] *= dd.z; S[mt][4 * g + 3] *= dd.w;
        }
#pragma unroll
      for (int s2 = 0; s2 < 2; ++s2) {
        const bf16x8 bv = *(const bf16x8*)(VT + sw32(32 * w4 + r, 16 * s2 + 8 * h));
#pragma unroll
        for (int mt = 0; mt < 4; ++mt) {
          const bf16x8 av = *(const bf16x8*)(KOT + sw32(32 * mt + r, 16 * s2 + 8 * h));
          S[mt] = __builtin_amdgcn_mfma_f32_32x32x16_bf16(av, bv, S[mt], 0, 0, 0);
        }
      }
#pragma unroll
      for (int e = 0; e < 16; ++e) {
        const int i = (e & 3) + 8 * (e >> 2) + 4 * h;
        const int n = d ? (127 - 32 * c - i) : (32 * c + i);
        O[(size_t)(R0 + n) * 512 + hd * 128 + 32 * w4 + r] = o[e];
      }
    }
  }
  __syncthreads();
}

DI void conv_rows8(KP p, int l, int row0, int tid) {
  const int lane = tid & 63, row = row0 + (tid >> 6);
  const int ch = lane * 8;
  const u16* Z = (const u16*)(p.ws + WS_Z);
  u16* cat = (u16*)(p.ws + WS_CAT);
  const float* cw = p.conv_w + (size_t)l * 3 * 512 + ch;
  int rm, rp; bool hm, hp_;
  if (row < NLAT) {
    const int t = row & 4095, gr = t >> 6, gc = t & 63;
    if (ch < 256) { hm = gc > 0; hp_ = gc < 63; rm = row - 1; rp = row + 1; }
    else { hm = gr > 0; hp_ = gr < 63; rm = row - 64; rp = row + 64; }
  } else {
    const int t = (row - NLAT) & 255;
    hm = t > 0; hp_ = t < 255; rm = row - 1; rp = row + 1;
  }
  if (!hm) rm = row;
  if (!hp_) rp = row;
  const u32x4 c0 = *(const u32x4*)(Z + (size_t)row * INC + 2560 + ch), h0 = *(const u32x4*)(Z + (size_t)row * INC + 3584 + ch);
  const u32x4 cm = *(const u32x4*)(Z + (size_t)rm * INC + 2560 + ch), hmv = *(const u32x4*)(Z + (size_t)rm * INC + 3584 + ch);
  const u32x4 cp = *(const u32x4*)(Z + (size_t)rp * INC + 2560 + ch), hpv = *(const u32x4*)(Z + (size_t)rp * INC + 3584 + ch);
  const u32x4 bgv = *(const u32x4*)(Z + (size_t)row * INC + 3072 + ch);
  const float4 w0a = *(const float4*)cw, w0b = *(const float4*)(cw + 4);
  const float4 w1a = *(const float4*)(cw + 512), w1b = *(const float4*)(cw + 516);
  const float4 w2a = *(const float4*)(cw + 1024), w2b = *(const float4*)(cw + 1028);
  const float w0[8] = {w0a.x, w0a.y, w0a.z, w0a.w, w0b.x, w0b.y, w0b.z, w0b.w};
  const float w1[8] = {w1a.x, w1a.y, w1a.z, w1a.w, w1b.x, w1b.y, w1b.z, w1b.w};
  const float w2[8] = {w2a.x, w2a.y, w2a.z, w2a.w, w2b.x, w2b.y, w2b.z, w2b.w};
  const float fm = hm ? 1.f : 0.f, fp = hp_ ? 1.f : 0.f;
  u32x4 o;
#pragma unroll
  for (int e = 0; e < 4; ++e) {
    float r2[2];
#pragma unroll
    for (int hh = 0; hh < 2; ++hh) {
      const float uc = (hh ? bfhi(c0[e]) : bflo(c0[e])) * (hh ? bfhi(h0[e]) : bflo(h0[e]));
      const float um = (hh ? bfhi(cm[e]) : bflo(cm[e])) * (hh ? bfhi(hmv[e]) : bflo(hmv[e]));
      const float up = (hh ? bfhi(cp[e]) : bflo(cp[e])) * (hh ? bfhi(hpv[e]) : bflo(hpv[e]));
      const float bg = hh ? bfhi(bgv[e]) : bflo(bgv[e]);
      r2[hh] = bg * (w1[2 * e + hh] * uc + fm * w0[2 * e + hh] * um + fp * w2[2 * e + hh] * up);
    }
    o[e] = pack2(r2[0], r2[1]);
  }
  *(u32x4*)(cat + (size_t)row * D + 512 + ch) = o;
}

DI void phase_rec1(KP p, unsigned char* smem, int l, int bid, int nb, int tid) {
  const int nitems = 544 + NTOK / 8;
  for (int it = bid; it < nitems; it += nb) {
    if (it < 544) rec_pass1(p, smem, l, it, tid);
    else conv_rows8(p, l, (it - 544) * 8, tid);
  }
}
DI void phase_rec3(KP p, unsigned char* smem, int l, int bid, int nb, int tid) {
  for (int it = bid; it < 544; it += nb) {
    if (l == DEPTH - 1 && (it % 34) < 2) continue;
    rec_pass3(p, smem, l, it, tid);
  }
}

DI void phase_recpost(KP p, int l, int bid, int nb, int tid) {
  const int lane = tid & 63, wave = tid >> 6;
  const float* OF = (const float*)(p.ws + WS_OF);
  const float* OB = (const float*)(p.ws + WS_OB);
  const u16* Z = (const u16*)(p.ws + WS_Z);
  u16* cat = (u16*)(p.ws + WS_CAT);
  for (int row = bid * 8 + wave; row < NTOK; row += nb * 8) {
    const float4 a0 = *(const float4*)(OF + (size_t)row * 512 + lane * 8), a1 = *(const float4*)(OF + (size_t)row * 512 + lane * 8 + 4);
    const float4 b0 = *(const float4*)(OB + (size_t)row * 512 + lane * 8), b1 = *(const float4*)(OB + (size_t)row * 512 + lane * 8 + 4);
    float o[8] = {a0.x + b0.x, a0.y + b0.y, a0.z + b0.z, a0.w + b0.w, a1.x + b1.x, a1.y + b1.y, a1.z + b1.z, a1.w + b1.w};
    float ss = 0.f;
#pragma unroll
    for (int e = 0; e < 8; ++e) ss += o[e] * o[e];
    ss += __shfl_xor(ss, 1); ss += __shfl_xor(ss, 2); ss += __shfl_xor(ss, 4); ss += __shfl_xor(ss, 8);
    const float rs = rsqrtf(ss * (1.f / 128.f) + EPS);
    const u32x4 gw = *(const u32x4*)(Z + (size_t)row * INC + 2048 + lane * 8);
    u32x4 ow;
#pragma unroll
    for (int e = 0; e < 4; ++e) {
      const float g0 = bflo(gw[e]), g1 = bfhi(gw[e]);
      ow[e] = pack2(o[2 * e] * rs * siluf_(g0), o[2 * e + 1] * rs * siluf_(g1));
    }
    *(u32x4*)(cat + (size_t)row * D + lane * 8) = ow;
  }
}

DI float gelu_erf(float x) { return 0.5f * x * (1.f + erff(x * 0.70710678118654752f)); }

using i32x4 = __attribute__((ext_vector_type(4))) int;
constexpr int PM_CF = 0, PM_WG = 32768, PM_HQ = 65536, PM_CM = 65536, PM_IB = 65536, PM_MISC = 133120;
DI unsigned pm_perm(unsigned hi, unsigned lo, unsigned sel) { return __builtin_amdgcn_perm(hi, lo, sel); }

DI void peer_mfma_pass(KP p, unsigned char* smem, int l, int row0, int ntok, int tid) {
  const int lane = tid & 63, wave = __builtin_amdgcn_readfirstlane(tid >> 6);
  const int ngroups = (ntok + 15) >> 4;
  const int nwg = ngroups >= 4 ? 2 : 8;
  const int tg = ngroups >= 4 ? (wave >> 1) : 0, ch = ngroups >= 4 ? (wave & 1) : wave;
  float* CF = (float*)(smem + PM_CF);
  unsigned* WG = (unsigned*)(smem + PM_WG);
  unsigned char* HQ = smem + PM_HQ;
  unsigned short* CM = (unsigned short*)(smem + PM_CM);
  unsigned* CNT = (unsigned*)(smem + PM_MISC);
  float* HS = (float*)(smem + PM_MISC) + 128;
  unsigned* CMAX = (unsigned*)(smem + PM_MISC) + 192;
  float* SS = (float*)(smem + PM_MISC) + 256;
  const unsigned char* UB = p.ws + WS_UB + (size_t)l * NEXP * D;
  const unsigned char* VB = p.ws + WS_VB + (size_t)l * NEXP * D;
  const float* US = (const float*)(p.ws + WS_US) + (size_t)l * NEXP;
  const float* VS = (const float*)(p.ws + WS_VS) + (size_t)l * NEXP;
  const float* mod = (const float*)(p.ws + WS_MOD);
#ifdef PROBE_ABC
#pragma unroll 1
  for (int arep = 0; arep < 2; ++arep) {
#endif
  if (tid < 128) CNT[tid] = 0u;
  if (tid < 64) { CMAX[tid] = 0u; SS[tid] = 0.f; }
  __syncthreads();
  unsigned ent[16], slot[16];
  const bool actA = tid < ntok * 8;
  if (actA) {
    const int t = tid >> 3, head = tid & 7;
    unsigned char* IB = smem + PM_IB + tid * 32;
    const unsigned* t1 = (const unsigned*)(p.ws + WS_TOPK) + ((size_t)(row0 + t) * 16 + head * 2) * 16;
    float s1[16], s2[16];
#pragma unroll
    for (int q = 0; q < 4; ++q) {
      const u32x4 a = *(const u32x4*)(t1 + q * 4), b = *(const u32x4*)(t1 + 16 + q * 4);
#pragma unroll
      for (int e = 0; e < 4; ++e) {
        s1[q * 4 + e] = __uint_as_float(a[e]); s2[q * 4 + e] = __uint_as_float(b[e]);
        IB[q * 4 + e] = (unsigned char)(127u - (a[e] & 127u));
        IB[16 + q * 4 + e] = (unsigned char)(127u - (b[e] & 127u));
      }
    }
    float t16[16];
#pragma unroll
    for (int i = 0; i < 16; ++i) t16[i] = __uint_as_float(0xff800000u);
#pragma unroll
    for (int i = 0; i < 16; ++i)
#pragma unroll
      for (int j = 0; j < 16; ++j)
        if ((i + 1) * (j + 1) <= 16) {
          const float sm = s1[i] + s2[j];
          const float x = __uint_as_float((__float_as_uint(sm) & ~0xffu) | (unsigned)(255 - (i * 16 + j)));
#pragma unroll
          for (int q = 15; q >= 1; --q) t16[q] = __builtin_amdgcn_fmed3f(x, t16[q - 1], t16[q]);
          t16[0] = fmaxf(t16[0], x);
        }
    float den = 0.f;
#pragma unroll
    for (int i = 0; i < 16; ++i) den += __expf(t16[i] - t16[0]);
    const float inv = 16383.f / den;
    const unsigned mtag = (unsigned)(t & 15) << 14;
    unsigned* cg = CNT + (t >> 4) * 32;
#pragma unroll
    for (int i = 0; i < 16; ++i) {
      const unsigned ci = 255u - (__float_as_uint(t16[i]) & 255u);
      const unsigned i1 = IB[ci >> 4], i2 = IB[16 + (ci & 15)];
      const unsigned gq = (unsigned)(int)rintf(__expf(t16[i] - t16[0]) * inv);
      const unsigned en = ((i1 * 128u + i2) << 18) | mtag | gq;
      ent[i] = en;
      slot[i] = atomicAdd(&cg[en >> 27], 1u);
    }
  }
  __syncthreads();
  if (tid < 128) {
    const unsigned c = CNT[tid];
    unsigned inc = c;
#pragma unroll
    for (int o = 1; o < 32; o <<= 1) { const unsigned v = __shfl_up(inc, o); if ((lane & 31) >= o) inc += v; }
    CNT[tid] = inc - c;
  }
  __syncthreads();
  if (actA) {
    const int t = tid >> 3;
    unsigned* wg = WG + (t >> 4) * 2048;
    const unsigned* cg = CNT + (t >> 4) * 32;
#pragma unroll
    for (int i = 0; i < 16; ++i) wg[cg[ent[i] >> 27] + slot[i]] = ent[i];
  }
  __syncthreads();
#pragma unroll 1
  for (int i = 0; i < 8; ++i) {
    const int t = wave * 8 + i;
    if (t < ntok) {
      const u32x4 pk = *(const u32x4*)(p.ws + WS_HXQ + (size_t)(row0 + t) * D + lane * 16);
      const float sc = ((const float*)(p.ws + WS_HXS))[row0 + t];
      *(u32x4*)(HQ + t * 1024 + lane * 16) = pk;
      if (lane == 0) HS[t] = sc;
    }
  }
  __syncthreads();
#ifdef PROBE_ABC
  }
#endif
  const bool gact = tg < ngroups;
  const int nt_g = gact ? ((ntok - tg * 16) < 16 ? (ntok - tg * 16) : 16) : 0;
  const int nent = nt_g * 128;
  const unsigned* wg = WG + tg * 2048;
  float* cfg = CF + tg * 2048;
  const int mrow = lane & 15, kq = lane >> 4;
  i32x4 areg[16];
  if (gact) {
    const int tsrc = (mrow < nt_g) ? (tg * 16 + mrow) : (tg * 16);
#pragma unroll
    for (int s2 = 0; s2 < 16; ++s2) areg[s2] = *(const i32x4*)(HQ + tsrc * 1024 + 64 * s2 + 16 * kq);
  }
  __syncthreads();
#ifdef PROBE_U2
#pragma unroll 1
  for (int urep = 0; urep < 2; ++urep)
#endif
  if (gact) {
#ifdef PROBE_U2
    const unsigned uemask = urep == 0 ? PROBE_EMASK : 0xffffffffu;
#else
    const unsigned uemask = 0xffffffffu;
#endif
    unsigned char* ust = smem + PM_HQ + wave * 8320;
    const int nch = nent >> 4;
    u32x4 rr[8];
    auto gl8 = [&](int k0) {
#pragma unroll
      for (int j = 0; j < 8; ++j) {
        const unsigned en = (unsigned)__builtin_amdgcn_readfirstlane((int)wg[k0 + j]) & uemask;
        rr[j] = *(const u32x4*)(UB + (size_t)(en >> 18) * D + lane * 16);
      }
    };
    if (ch < nch) gl8(16 * ch);
#pragma unroll 1
    for (int c = ch; c < nch; c += nwg) {
      const unsigned en_cur = wg[16 * c + mrow];
      const unsigned e = en_cur >> 18;
      const float us = US[e], vs = VS[e];
      i32x4 d0 = {0, 0, 0, 0}, d1 = {0, 0, 0, 0};
#pragma unroll
      for (int j = 0; j < 8; ++j) *(u32x4*)(ust + j * 1040 + lane * 16) = rr[j];
      gl8(16 * c + 8);
#pragma unroll
      for (int s2 = 0; s2 < 16; ++s2) {
        const i32x4 b = *(const i32x4*)(ust + (mrow & 7) * 1040 + 64 * s2 + 16 * kq);
        d0 = __builtin_amdgcn_mfma_i32_16x16x64_i8(areg[s2], b, d0, 0, 0, 0);
        if ((s2 & 3) == 3) __builtin_amdgcn_sched_barrier(0);
      }
#pragma unroll
      for (int j = 0; j < 8; ++j) *(u32x4*)(ust + j * 1040 + lane * 16) = rr[j];
      if (c + nwg < nch) gl8(16 * (c + nwg));
#pragma unroll
      for (int s2 = 0; s2 < 16; ++s2) {
        const i32x4 b = *(const i32x4*)(ust + (mrow & 7) * 1040 + 64 * s2 + 16 * kq);
        d1 = __builtin_amdgcn_mfma_i32_16x16x64_i8(areg[s2], b, d1, 0, 0, 0);
        if ((s2 & 3) == 3) __builtin_amdgcn_sched_barrier(0);
      }
      const int mp = (int)((en_cur >> 14) & 15u);
      if ((mp >> 2) == kq) {
        const int r = mp & 3;
        const i32x4 dd = mrow < 8 ? d0 : d1;
        const int dv = r == 0 ? dd[0] : r == 1 ? dd[1] : r == 2 ? dd[2] : dd[3];
        const float dot = us * HS[tg * 16 + mp] * (float)dv;
        const float cf = (float)(en_cur & 0x3fffu) * (1.f / 16383.f) * gelu_erf(dot) * vs;
        cfg[16 * c + mrow] = cf;
        atomicMax(&CMAX[tg * 16 + mp], __float_as_uint(fabsf(cf)));
      }
    }
  }
  __syncthreads();
  for (int k = tid; k < ngroups * 2048; k += NTHR) {
    const int g2 = k >> 11;
    const int ntg = (ntok - g2 * 16) < 16 ? (ntok - g2 * 16) : 16;
    if ((k & 2047) < ntg * 128) {
      const unsigned en = WG[k];
      const unsigned m = (en >> 14) & 15u;
      const float cmx = __uint_as_float(CMAX[g2 * 16 + m]);
      const float q = cmx > 0.f ? rintf(CF[k] * (127.f / cmx)) : 0.f;
      CM[k] = (unsigned short)((m << 8) | (((unsigned)(int)q) & 0xffu));
    }
  }
  __syncthreads();
  if (gact) {
    const int i16 = lane & 15, kq = lane >> 4;
    const unsigned short* cmg = CM + tg * 2048;
    const int nch = nent >> 5;
    float csc[4];
#pragma unroll
    for (int r = 0; r < 4; ++r) csc[r] = __uint_as_float(CMAX[tg * 16 + 4 * kq + r]) * (1.f / 127.f);
#pragma unroll 1
    for (int cbp = 0; cbp < 8 / nwg; ++cbp) {
      const int colb = (1024 / nwg) * ch + 128 * cbp + 8 * i16;
      i32x4 acc[8];
#ifdef PROBE_V2
#pragma unroll 1
      for (int vrep = 0; vrep < 2; ++vrep) {
      const unsigned vemask = vrep == 0 ? PROBE_EMASK : 0xffffffffu;
#else
      const unsigned vemask = 0xffffffffu;
#endif
#pragma unroll
      for (int c = 0; c < 8; ++c) acc[c] = (i32x4){0, 0, 0, 0};
      u32x2 x[8];
      if (nch > 0) {
        const u32x4 w0 = *(const u32x4*)(wg + 8 * kq), w1 = *(const u32x4*)(wg + 8 * kq + 4);
#pragma unroll
        for (int j = 0; j < 4; ++j) {
          x[j] = *(const u32x2*)(VB + (size_t)((w0[j] & vemask) >> 18) * D + colb);
          x[4 + j] = *(const u32x2*)(VB + (size_t)((w1[j] & vemask) >> 18) * D + colb);
        }
      }
#pragma unroll 1
      for (int c = 0; c < nch; ++c) {
        unsigned ylo[8], yhi[8];
#pragma unroll
        for (int w = 0; w < 2; ++w) {
          {
            const unsigned t0 = pm_perm(x[1][w], x[0][w], 0x05010400u), t1 = pm_perm(x[1][w], x[0][w], 0x07030602u);
            const unsigned t2 = pm_perm(x[3][w], x[2][w], 0x05010400u), t3 = pm_perm(x[3][w], x[2][w], 0x07030602u);
            ylo[4 * w + 0] = pm_perm(t2, t0, 0x05040100u); ylo[4 * w + 1] = pm_perm(t2, t0, 0x07060302u);
            ylo[4 * w + 2] = pm_perm(t3, t1, 0x05040100u); ylo[4 * w + 3] = pm_perm(t3, t1, 0x07060302u);
          }
          {
            const unsigned t0 = pm_perm(x[5][w], x[4][w], 0x05010400u), t1 = pm_perm(x[5][w], x[4][w], 0x07030602u);
            const unsigned t2 = pm_perm(x[7][w], x[6][w], 0x05010400u), t3 = pm_perm(x[7][w], x[6][w], 0x07030602u);
            yhi[4 * w + 0] = pm_perm(t2, t0, 0x05040100u); yhi[4 * w + 1] = pm_perm(t2, t0, 0x07060302u);
            yhi[4 * w + 2] = pm_perm(t3, t1, 0x05040100u); yhi[4 * w + 3] = pm_perm(t3, t1, 0x07060302u);
          }
        }
        const u32x4 cmv = *(const u32x4*)(cmg + 32 * c + 8 * kq);
        unsigned alo = 0, ahi = 0;
#pragma unroll
        for (int j = 0; j < 8; ++j) {
          const unsigned hw = (cmv[j >> 1] >> (16 * (j & 1))) & 0xffffu;
          const unsigned bv = ((hw >> 8) == (unsigned)i16) ? (hw & 0xffu) : 0u;
          if (j < 4) alo |= bv << (8 * j); else ahi |= bv << (8 * (j - 4));
        }
        if (c + 1 < nch) {
          const u32x4 w0 = *(const u32x4*)(wg + 32 * (c + 1) + 8 * kq), w1 = *(const u32x4*)(wg + 32 * (c + 1) + 8 * kq + 4);
#pragma unroll
          for (int j = 0; j < 4; ++j) {
            x[j] = *(const u32x2*)(VB + (size_t)((w0[j] & vemask) >> 18) * D + colb);
            x[4 + j] = *(const u32x2*)(VB + (size_t)((w1[j] & vemask) >> 18) * D + colb);
          }
        }
        const i32x4 av = {(int)alo, (int)ahi, 0, 0};
#pragma unroll
        for (int cc = 0; cc < 8; ++cc) {
          const i32x4 bv = {(int)ylo[cc], (int)yhi[cc], 0, 0};
          acc[cc] = __builtin_amdgcn_mfma_i32_16x16x64_i8(av, bv, acc[cc], 0, 0, 0);
        }
      }
#ifdef PROBE_V2
      }
#endif
#pragma unroll
      for (int r = 0; r < 4; ++r) {
        const int m = 4 * kq + r;
        if (m < nt_g) {
          const int row = row0 + tg * 16 + m;
          const float* g2p = mod + ((size_t)l * 5 + row_cls(row)) * 6144 + 5120 + colb;
          float* xr = (float*)(p.ws + WS_XW) + (size_t)row * D + colb;
#pragma unroll
          for (int q = 0; q < 2; ++q) {
            float4 xv = *(const float4*)(xr + q * 4);
            const float4 gv = *(const float4*)(g2p + q * 4);
            xv.x += gv.x * csc[r] * (float)acc[q * 4 + 0][r]; xv.y += gv.y * csc[r] * (float)acc[q * 4 + 1][r];
            xv.z += gv.z * csc[r] * (float)acc[q * 4 + 2][r]; xv.w += gv.w * csc[r] * (float)acc[q * 4 + 3][r];
            *(float4*)(xr + q * 4) = xv;
          }
        }
      }
    }
  }
  asm volatile("s_waitcnt vmcnt(0)" ::: "memory");
  __syncthreads();
  __builtin_amdgcn_fence(__ATOMIC_ACQUIRE, "agent");
  asm volatile("s_waitcnt vmcnt(0)" ::: "memory");
#ifdef PROBE_E2
#pragma unroll 1
  for (int erep = 0; erep < 2; ++erep)
#endif
#pragma unroll 1
  for (int i = 0; i < 8; ++i) {
    const int t = wave * 8 + i;
    if (t < ntok) {
      const int row = row0 + t;
      const int cls = row_cls(row);
      const float* xr = (const float*)(p.ws + WS_XW) + (size_t)row * D + lane * 16;
      float xn[16];
      float ssq = 0.f;
#pragma unroll
      for (int q = 0; q < 4; ++q) {
        const float4 a = *(const float4*)(xr + q * 4); xn[q * 4] = a.x; xn[q * 4 + 1] = a.y; xn[q * 4 + 2] = a.z; xn[q * 4 + 3] = a.w;
        ssq += a.x * a.x + a.y * a.y + a.z * a.z + a.w * a.w;
      }
      ssq = wave_sum(ssq);
      const float rs = rsqrtf(ssq * (1.f / 1024.f) + EPS);
      if (l < DEPTH - 1) {
        const float* ng = p.norm1_g + (size_t)(l + 1) * D + lane * 16;
        const float* mr = mod + ((size_t)(l + 1) * 5 + cls) * 6144 + lane * 16;
        float y[16];
#pragma unroll
        for (int q = 0; q < 4; ++q) {
          const float4 n4 = *(const float4*)(ng + q * 4), sc4 = *(const float4*)(mr + 1024 + q * 4), sh4 = *(const float4*)(mr + q * 4);
          y[q * 4 + 0] = xn[q * 4 + 0] * rs * n4.x * (1.f + sc4.x) + sh4.x; y[q * 4 + 1] = xn[q * 4 + 1] * rs * n4.y * (1.f + sc4.y) + sh4.y;
          y[q * 4 + 2] = xn[q * 4 + 2] * rs * n4.z * (1.f + sc4.z) + sh4.z; y[q * 4 + 3] = xn[q * 4 + 3] * rs * n4.w * (1.f + sc4.w) + sh4.w;
        }
        {
          float am = 0.f;
#pragma unroll
          for (int e = 0; e < 16; ++e) am = fmaxf(am, fabsf(y[e]));
#pragma unroll
          for (int o2 = 32; o2 >= 1; o2 >>= 1) am = fmaxf(am, __shfl_xor(am, o2));
          const float qs = am > 0.f ? am * (1.f / 127.f) : 1.f, qi = 1.f / qs;
          u32x4 oq;
#pragma unroll
          for (int q = 0; q < 4; ++q) {
            unsigned w = 0;
#pragma unroll
            for (int e = 0; e < 4; ++e) w |= (((unsigned)(int)rintf(y[q * 4 + e] * qi)) & 0xffu) << (8 * e);
            oq[q] = w;
          }
          *(u32x4*)(p.ws + WS_HXQ + (size_t)row * D + lane * 16) = oq;
          if (lane == 0) ((float*)(p.ws + WS_HXS))[row] = qs;
        }
      } else {
        const float* fg = p.final_g + lane * 16;
        float* orow = p.out + (size_t)row * D + lane * 16;
#pragma unroll
        for (int q = 0; q < 4; ++q) {
          const float4 f4 = *(const float4*)(fg + q * 4);
          *(float4*)(orow + q * 4) = make_float4(xn[q * 4] * rs * f4.x, xn[q * 4 + 1] * rs * f4.y, xn[q * 4 + 2] * rs * f4.z, xn[q * 4 + 3] * rs * f4.w);
        }
      }
    }
  }
  __syncthreads();
}

DI void phase_peer_mfma(KP p, unsigned char* smem, int l, int bid, int nb, int tid) {
  const int npass = (l < DEPTH - 1) ? 2 : 1;
#pragma unroll 1
  for (int ps = 0; ps < npass; ++ps) {
    const int nt = ps == 0 ? 64 : 4;
    const int base = ps == 0 ? 0 : NLAT, lim = ps == 0 ? NLAT : NTOK;
#pragma unroll 1
    for (int r0 = base + bid * nt; r0 < lim; r0 += nb * nt) peer_mfma_pass(p, smem, l, r0, nt, tid);
  }
}

constexpr int PH_PER_LAYER = 9;
constexpr int N_PHASES = 2 + DEPTH * PH_PER_LAYER;
constexpr int SMEM_BYTES = 256 * 132 * 4;

#ifndef ONLYMASK
#define ONLYMASK 0xffff
#endif
#define PHON(x) ((ONLYMASK >> (x)) & 1)
DI void run_phase(KP p, unsigned char* smem, int ph, int bid, int nb, int tid) {
  if (ph == 0) { if (PHON(10)) phase_p0a(p, (float*)smem, bid, nb, tid); return; }
  if (ph == 1) { if (PHON(4)) { phase_norm<true>(p, p.norm1_g, 0, 0, 1024, bid, nb, NTOK, tid, true); phase_rowq(p, WS_WS, WS_WSQ, WS_WSS, 4 * 2048, bid, nb, tid); phase_rowq(p, WS_WIN, WS_WINQ, WS_WINS, 4 * 4096, bid, nb, tid); } return; }
  const int l = (ph - 2) / PH_PER_LAYER, s = (ph - 2) % PH_PER_LAYER;
  const bool last = (l == DEPTH - 1);
  switch (s) {
    case 0: if (PHON(0)) gemm8_phase<G8_Z>(p, smem, (const u16*)(p.ws + WS_HX), (const u16*)(p.ws + WS_WIN) + (size_t)l * 4096 * 1024, 4096, 1024, l, bid, nb, NTOK / 256, tid); break;
    case 1: if (PHON(7)) phase_rec1(p, smem, l, bid, nb, tid); break;
    case 2: if (PHON(8)) rec_pass2(p, bid, nb, tid); break;
    case 3: if (PHON(9)) phase_rec3(p, smem, l, bid, nb, tid); break;
    case 4: if (PHON(2)) phase_recpost(p, l, bid, nb, tid); break;
    case 5: if (PHON(3)) gemm8_phase<G8_RES>(p, smem, (const u16*)(p.ws + WS_CAT), (const u16*)(p.ws + WS_WOUT) + (size_t)l * 1024 * 1024, 1024, 1024, l, bid, nb, last ? NLAT / 256 : NTOK / 256, tid); break;
    case 6: if (PHON(4)) phase_norm(p, p.norm2_g + (size_t)l * D, l, 3072, 4096, bid, nb, last ? NLAT : NTOK, tid, true); break;
    case 7: if (PHON(5)) gemm8_phase<G8_TOPK>(p, smem, (const u16*)(p.ws + WS_HX), (const u16*)(p.ws + WS_WS) + (size_t)l * 2048 * 1024, 2048, 1024, l, bid, nb, last ? NLAT / 256 : NTOK / 256, tid); break;
    case 8: if (PHON(6)) phase_peer_mfma(p, smem, l, bid, nb, tid); break;
  }
}


#define XB_TMO      128
#define XB_XCNT(j)  (256  + 64 * (j))
#define XB_XSUB(j)  (1280 + 64 * (j))
#define XB_XGEN(j)  (2304 + 64 * (j))
#define XB_TOP      3328
#define XB_TOPGEN   3392
#define XCD_BAR_WORDS 3456
#define XB_SPIN_CAP (1u << 22)
#define LAS __attribute__((address_space(3)))
DI unsigned xb_ld(unsigned* p)              { return __hip_atomic_load(p, __ATOMIC_RELAXED, __HIP_MEMORY_SCOPE_AGENT); }
DI unsigned xb_add(unsigned* p, unsigned v) { return __hip_atomic_fetch_add(p, v, __ATOMIC_RELAXED, __HIP_MEMORY_SCOPE_AGENT); }
DI unsigned xb_xcc_id() { return (unsigned)__builtin_amdgcn_s_getreg((3 << 11) | 20) & 0xFu; }
#define XB_SPIN(cond, bar) do { unsigned _sp = 0; while (cond) { __builtin_amdgcn_s_sleep(1); \
    if ((++_sp & 255u) == 0u) { if (xb_ld(&(bar)[XB_TMO])) break; if (_sp > XB_SPIN_CAP) { atomicAdd(&(bar)[XB_TMO], 1u); break; } } } } while (0)
struct XcdBarrier { unsigned* bar; unsigned x; volatile LAS unsigned* st; };
DI XcdBarrier xcd_barrier_post(unsigned* bar, volatile LAS unsigned* st) {
  XcdBarrier b; b.bar = bar; b.x = xb_xcc_id(); b.st = st;
  if (threadIdx.x == 0) (void)xb_add(&bar[XB_XCNT(b.x)], 1u);
  return b;
}
DI void xcd_barrier_complete(unsigned* bar, unsigned x, unsigned& nloc, unsigned& nx) {
  const unsigned G = gridDim.x * gridDim.y * gridDim.z;
  unsigned sum, cnt, mine, sp = 0u;
  for (;;) {
    sum = 0u; cnt = 0u; mine = 0u;
#pragma unroll
    for (unsigned j = 0; j < 16; ++j) { const unsigned c = xb_ld(&bar[XB_XCNT(j)]); sum += c; cnt += (c > 0u) ? 1u : 0u; mine = (j == x) ? c : mine; }
    if (sum == G) break;
    __builtin_amdgcn_s_sleep(1);
    if ((++sp & 255u) == 0u) { if (xb_ld(&bar[XB_TMO])) break; if (sp > XB_SPIN_CAP) { atomicAdd(&bar[XB_TMO], 1u); break; } }
  }
  nloc = mine > 0u ? mine : 1u; nx = cnt > 0u ? cnt : 1u;
}
DI void xcd_barrier(const XcdBarrier& b) {
  asm volatile("s_waitcnt vmcnt(0)" ::: "memory");
  __syncthreads();
  if (threadIdx.x == 0) {
    unsigned* bar = b.bar;
    __builtin_amdgcn_s_waitcnt(0);
    unsigned nloc = b.st[0], nx = b.st[1];
    if (nloc == 0u) { xcd_barrier_complete(bar, b.x, nloc, nx); b.st[0] = nloc; b.st[1] = nx; }
    const unsigned old = xb_add(&bar[XB_XSUB(b.x)], 1u);
    const unsigned gen = old / nloc;
    if (old + 1u == (gen + 1u) * nloc) {
      __builtin_amdgcn_fence(__ATOMIC_RELEASE, "agent");
      asm volatile("s_waitcnt vmcnt(0)" ::: "memory");
      const unsigned og = xb_add(&bar[XB_TOP], 1u);
      const unsigned tg = og / nx;
      if (og + 1u == (tg + 1u) * nx) xb_add(&bar[XB_TOPGEN], 1u);
      else XB_SPIN(xb_ld(&bar[XB_TOPGEN]) == tg, bar);
      __builtin_amdgcn_fence(__ATOMIC_ACQUIRE, "agent");
      xb_add(&bar[XB_XGEN(b.x)], 1u);
      asm volatile("s_waitcnt vmcnt(0)" ::: "memory");
    } else {
      XB_SPIN(xb_ld(&bar[XB_XGEN(b.x)]) == gen, bar);
      __builtin_amdgcn_fence(__ATOMIC_ACQUIRE, "agent");
      asm volatile("s_waitcnt vmcnt(0)" ::: "memory");
    }
  }
  __syncthreads();
}

typedef const Params __attribute__((address_space(4)))* KArgs;

__global__ void __launch_bounds__(NTHR, 2) mega_kernel(Params p_unused) {
#if defined(__HIP_DEVICE_COMPILE__)
  __shared__ __attribute__((aligned(16))) unsigned char smem[SMEM_BYTES + 16];
  KArgs ka = (KArgs)__builtin_amdgcn_kernarg_segment_ptr();
  const int ph_lo = ka->ph_lo, ph_hi = ka->ph_hi;
#if !MULTI_LAUNCH
  cg::grid_group grid = cg::this_grid();
  volatile LAS unsigned* xbw = (volatile LAS unsigned*)(smem + SMEM_BYTES);
  if (threadIdx.x == 0) { xbw[0] = 0u; xbw[1] = 0u; }
  __syncthreads();
  XcdBarrier xb = xcd_barrier_post((unsigned*)(ka->ws + WS_BAR), xbw);
#endif
  int rep = 0;
  for (int ph = ph_lo; ph < ph_hi;) {
    int tid = threadIdx.x, bid = blockIdx.x, nb = gridDim.x;
    KArgs kq = ka;
    asm volatile("" : "+v"(tid), "+s"(bid), "+s"(nb), "+s"(kq));
    run_phase(*kq, smem, ph, bid, nb, tid);
    bool again = false;
#ifdef REPEAT_S
    if (rep == 0 && ((ph >= 2 && (ph - 2) % PH_PER_LAYER == REPEAT_S) || (REPEAT_S == 100 && ph == 0))) again = true;
#endif
#if !MULTI_LAUNCH
    if (again || ph + 1 < ph_hi) { if (ph == 0 && !again) grid.sync(); else xcd_barrier(xb); }
#endif
    if (again) rep = 1; else { rep = 0; ++ph; }
  }
#endif
}

extern "C" void kernel_launch(void* const* d_in, const int* in_sizes, int n_in, void* d_out, int out_size, void* d_ws, size_t ws_size, hipStream_t stream) {
  static int grid = 0;
  if (grid == 0) {
    if (n_in != 17 || ws_size < WS_END) { fprintf(stderr, "kernel_launch: unexpected n_in %d or ws_size %zu (need %zu)\n", n_in, ws_size, (size_t)WS_END); grid = -1; return; }
    int dev = 0, cus = 0, per_cu = 0;
    hipGetDevice(&dev);
    hipDeviceGetAttribute(&cus, hipDeviceAttributeMultiprocessorCount, dev);
    hipOccupancyMaxActiveBlocksPerMultiprocessor(&per_cu, (const void*)mega_kernel, NTHR, 0);
    if (per_cu < 1) { fprintf(stderr, "kernel_launch: occupancy query says %d blocks per CU\n", per_cu); grid = -1; return; }
    grid = cus;
  }
  if (grid < 0) return;
  Params p{};
  p.x = (const float*)d_in[0]; p.c = (const float*)d_in[1]; p.ctx = (const float*)d_in[2]; p.c_ctx = (const float*)d_in[3];
  p.w_mod = (const float*)d_in[4]; p.b_mod = (const float*)d_in[5]; p.norm1_g = (const float*)d_in[6]; p.norm2_g = (const float*)d_in[7];
  p.w_in = (const float*)d_in[8]; p.conv_w = (const float*)d_in[9]; p.w_out = (const float*)d_in[10]; p.lb_logits = (const float*)d_in[11];
  p.peer_wq = (const float*)d_in[12]; p.peer_subkeys = (const float*)d_in[13]; p.peer_u = (const float*)d_in[14]; p.peer_v = (const float*)d_in[15];
  p.final_g = (const float*)d_in[16]; p.out = (float*)d_out; p.ws = (unsigned char*)d_ws;
#if MULTI_LAUNCH
  for (int ph = 0; ph < N_PHASES; ++ph) {
    p.ph_lo = ph; p.ph_hi = ph + 1;
    hipLaunchKernelGGL(mega_kernel, dim3(grid), dim3(NTHR), 0, stream, p);
  }
#else
  p.ph_lo = 0; p.ph_hi = N_PHASES;
  if (hipMemsetAsync((char*)d_ws + WS_BAR, 0, 16384, stream) != hipSuccess) { fprintf(stderr, "kernel_launch: memset of barrier words failed\n"); return; }
  void* args[] = {&p};
  hipError_t e = hipLaunchCooperativeKernel((const void*)mega_kernel, dim3(grid), dim3(NTHR), args, 0, stream);
  if (e != hipSuccess) fprintf(stderr, "cooperative launch failed: %s (grid %d)\n", hipGetErrorString(e), grid);
#endif
}
```

```cpp
#include <hip/hip_runtime.h>
#include <hip/hip_cooperative_groups.h>
#include <stdint.h>
#include <stdio.h>
namespace cg = cooperative_groups;

#ifndef MULTI_LAUNCH
#define MULTI_LAUNCH 0
#endif

#define DI __device__ __forceinline__
typedef unsigned short u16;
using bf16x8 = __attribute__((ext_vector_type(8))) short;
using f32x16 = __attribute__((ext_vector_type(16))) float;
using u32x4  = __attribute__((ext_vector_type(4))) unsigned;
using u32x2  = __attribute__((ext_vector_type(2))) unsigned;
using f32x4  = __attribute__((ext_vector_type(4))) float;

constexpr int D = 1024, NLAT = 16384, NCTX = 1024, NTOK = 17408, DEPTH = 4, INC = 4096;
constexpr int SEQ = 4096, CTXL = 256, BATCH = 4;
constexpr int NTHR = 512;
constexpr int NEXP = 16384;
constexpr float EPS = 1e-6f;

constexpr size_t al256(size_t x) { return (x + 255) & ~(size_t)255; }
constexpr size_t WS_BAR   = 0;
constexpr size_t WS_MOD   = 16384;
constexpr size_t WS_LOWER = WS_MOD + al256((size_t)4 * 5 * 6144 * 4);
constexpr size_t WS_XW    = WS_LOWER + al256((size_t)4 * 2 * 512 * 4);
constexpr size_t WS_HX    = WS_XW + (size_t)NTOK * D * 4;
constexpr size_t WS_Z     = WS_HX + (size_t)NTOK * D * 2;
constexpr size_t WS_CAT   = WS_Z + (size_t)NTOK * INC * 2;
constexpr size_t WS_OF    = WS_CAT + (size_t)NTOK * D * 2;
constexpr size_t WS_OB    = WS_OF + (size_t)NTOK * 512 * 4;
constexpr size_t WS_TOPK  = WS_OB + (size_t)NTOK * 512 * 4;
constexpr size_t WS_WIN   = WS_TOPK + (size_t)NTOK * 256 * 4;
constexpr size_t WS_WOUT  = WS_WIN + (size_t)4 * 4096 * 1024 * 2;
constexpr size_t WS_WS    = WS_WOUT + (size_t)4 * 1024 * 1024 * 2;
constexpr size_t WS_UB    = WS_WS + (size_t)4 * 2048 * 1024 * 2;
constexpr size_t WS_VB    = WS_UB + (size_t)4 * NEXP * D;
constexpr size_t WS_US    = WS_VB + (size_t)4 * NEXP * D;
constexpr size_t WS_VS    = WS_US + (size_t)4 * NEXP * 4;
constexpr size_t WS_SLOC  = WS_VS + (size_t)4 * NEXP * 4;
constexpr size_t WS_SST   = WS_SLOC + (size_t)32 * 34 * 16384 * 2;
constexpr size_t WS_DT    = WS_SST + (size_t)32 * 34 * 16384 * 2;
constexpr size_t WS_HXQ   = WS_DT + (size_t)32 * 34 * 128 * 4;
constexpr size_t WS_HXS   = WS_HXQ + (size_t)NTOK * D;
constexpr size_t WS_WSQ   = WS_HXS + al256((size_t)NTOK * 4);
constexpr size_t WS_WSS   = WS_WSQ + (size_t)4 * 2048 * 1024;
constexpr size_t WS_WINQ  = WS_WSS + (size_t)4 * 2048 * 4;
constexpr size_t WS_WINS  = WS_WINQ + (size_t)4 * 4096 * 1024;
constexpr size_t WS_END   = WS_WINS + (size_t)4 * 4096 * 4;

struct Params {
  const float* x; const float* c; const float* ctx; const float* c_ctx; const float* w_mod; const float* b_mod;
  const float* norm1_g; const float* norm2_g; const float* w_in; const float* conv_w; const float* w_out;
  const float* lb_logits; const float* peer_wq; const float* peer_subkeys; const float* peer_u; const float* peer_v;
  const float* final_g; float* out; unsigned char* ws;
  int ph_lo, ph_hi;
};

typedef __attribute__((ext_vector_type(2))) __bf16 bf16v2;
typedef __attribute__((ext_vector_type(2))) float f32v2;
typedef const Params __attribute__((address_space(4)))& KP;

DI u16 f2bf(float x) { return __builtin_bit_cast(u16, (__bf16)x); }
DI float bf2f(u16 b) { return __uint_as_float(((unsigned)b) << 16); }
DI unsigned pack2(float a, float b) { f32v2 v = {a, b}; return __builtin_bit_cast(unsigned, __builtin_convertvector(v, bf16v2)); }
DI float bflo(unsigned w) { return __uint_as_float(w << 16); }
DI float bfhi(unsigned w) { return __uint_as_float(w & 0xffff0000u); }
DI float sigmoidf_(float x) { return 1.f / (1.f + __expf(-x)); }
DI float siluf_(float x) { return x / (1.f + __expf(-x)); }
DI float wave_sum(float v) {
#pragma unroll
  for (int o = 32; o >= 1; o >>= 1) v += __shfl_xor(v, o);
  return v;
}
DI int row_cls(int row) { return row < NLAT ? (row >> 12) : 4; }
DI unsigned sw128(int row, int col) { return (unsigned)(row * 256 + ((((col >> 3) ^ (row & 15))) << 4) + (col & 7) * 2); }

DI void p0_mod_all(KP p, float* smem, int bid, int nb, int tid) {
  float* cond = smem;
  float* red = smem + 5 * 1024;
  for (int i = tid; i < 5 * 1024; i += NTHR) {
    const int r = i >> 10, k = i & 1023;
    const float v = r < 4 ? p.c[r * 1024 + k] : p.c_ctx[k];
    cond[i] = siluf_(v);
  }
  __syncthreads();
  const int col = tid & 31, ks = tid >> 5;
  const float* cd0 = cond + ks * 64;
  float* mod = (float*)(p.ws + WS_MOD);
  for (int g0 = bid; g0 < 768; g0 += 3 * nb) {
    float wa[16], wb[16];
    const unsigned vo = (unsigned)((ks * 64 * 6144 + col) * 4);
    auto wbase = [&](int g) { return (const char*)(p.w_mod + (size_t)(g / 192) * 1024 * 6144 + (g % 192) * 32); };
    {
      const char* w = wbase(g0);
#pragma unroll
      for (int u = 0; u < 16; ++u) wa[u] = *(const float*)(w + (size_t)u * 24576 + vo);
    }
#pragma unroll 1
    for (int q = 0; q < 3; ++q) {
      const int g = g0 + q * nb;
      if (g >= 768) break;
      float a0 = 0, a1 = 0, a2 = 0, a3 = 0, a4 = 0;
#pragma unroll 1
      for (int hb = 0; hb < 2; ++hb) {
        const float* cd = cd0 + 32 * hb;
        asm volatile("" : "+v"(cd));
        {
          const char* w = wbase(g) + (size_t)(32 * hb + 16) * 24576;
#pragma unroll
          for (int u = 0; u < 16; ++u) wb[u] = *(const float*)(w + (size_t)u * 24576 + vo);
        }
#pragma unroll
        for (int u = 0; u < 16; ++u) { a0 += cd[u] * wa[u]; a1 += cd[1024 + u] * wa[u]; a2 += cd[2048 + u] * wa[u]; a3 += cd[3072 + u] * wa[u]; a4 += cd[4096 + u] * wa[u]; }
        __builtin_amdgcn_sched_barrier(0);
        if (hb == 0 || (q + 1 < 3 && g + nb < 768)) {
          const char* w = hb == 0 ? wbase(g) + (size_t)32 * 24576 : wbase(g + nb);
#pragma unroll
          for (int u = 0; u < 16; ++u) wa[u] = *(const float*)(w + (size_t)u * 24576 + vo);
        }
#pragma unroll
        for (int u = 0; u < 16; ++u) { a0 += cd[16 + u] * wb[u]; a1 += cd[1040 + u] * wb[u]; a2 += cd[2064 + u] * wb[u]; a3 += cd[3088 + u] * wb[u]; a4 += cd[4112 + u] * wb[u]; }
        __builtin_amdgcn_sched_barrier(0);
      }
      float* rq = red + q * 2560;
      rq[(ks * 5 + 0) * 32 + col] = a0; rq[(ks * 5 + 1) * 32 + col] = a1; rq[(ks * 5 + 2) * 32 + col] = a2;
      rq[(ks * 5 + 3) * 32 + col] = a3; rq[(ks * 5 + 4) * 32 + col] = a4;
    }
    __syncthreads();
    if (tid < 480) {
      const int q = tid / 160, rr = tid % 160, r = rr >> 5, cc = rr & 31, g = g0 + q * nb;
      if (g < 768) {
        const float* rq = red + q * 2560;
        float sacc = 0.f;
#pragma unroll
        for (int t = 0; t < 16; ++t) sacc += rq[(t * 5 + r) * 32 + cc];
        const int l = g / 192, ng = g % 192;
        mod[((size_t)l * 5 + r) * 6144 + ng * 32 + cc] = sacc + p.b_mod[l * 6144 + ng * 32 + cc];
      }
    }
    __syncthreads();
  }
}

DI void p0_transpose_waves(KP p, float* smem, int bid, int nb, int tid) {
  const int lane = tid & 63, wave = tid >> 6;
  float* t = smem + wave * (64 * 33);
  const int kr = lane >> 3, c4 = (lane & 7) * 4;
  const int j = lane >> 1, hf = lane & 1;
  float4 v[8];
  const float* src = nullptr; u16* dst = nullptr; int K = 1024, N = 0, k0 = 0, n0 = 0;
  auto decode = [&](int it) {
    if (it < 8192) { const int l = it >> 11, r = it & 2047; k0 = (r >> 7) * 64; n0 = (r & 127) * 32; N = 4096; src = p.w_in + (size_t)l * 1024 * 4096; dst = (u16*)(p.ws + WS_WIN) + (size_t)l * 4096 * 1024; }
    else { const int i2 = it - 8192, l = i2 >> 9, r = i2 & 511; k0 = (r >> 5) * 64; n0 = (r & 31) * 32; N = 1024; src = p.w_out + (size_t)l * 1024 * 1024; dst = (u16*)(p.ws + WS_WOUT) + (size_t)l * 1024 * 1024; }
  };
  auto gload = [&]() {
#pragma unroll
    for (int pp = 0; pp < 8; ++pp) v[pp] = *(const float4*)(src + (size_t)(k0 + kr + 8 * pp) * N + n0 + c4);
  };
  int it = bid * 8 + wave;
  const int step = nb * 8;
  if (it < 10240) { decode(it); gload(); }
#pragma unroll 1
  while (it < 10240) {
#pragma unroll
    for (int pp = 0; pp < 8; ++pp) {
      float* tt = t + (kr + 8 * pp) * 33 + c4;
      tt[0] = v[pp].x; tt[1] = v[pp].y; tt[2] = v[pp].z; tt[3] = v[pp].w;
    }
    u16* drow = dst + (size_t)(n0 + j) * K + k0 + 32 * hf;
    const int nxt = it + step;
    if (nxt < 10240) { decode(nxt); gload(); }
    __builtin_amdgcn_fence(__ATOMIC_ACQ_REL, "wavefront");
    __builtin_amdgcn_wave_barrier();
#pragma unroll
    for (int q = 0; q < 4; ++q) {
      const float* tt = t + (32 * hf + 8 * q) * 33 + j;
      u32x4 o;
      o[0] = pack2(tt[0 * 33], tt[1 * 33]); o[1] = pack2(tt[2 * 33], tt[3 * 33]);
      o[2] = pack2(tt[4 * 33], tt[5 * 33]); o[3] = pack2(tt[6 * 33], tt[7 * 33]);
      *(u32x4*)(drow + 8 * q) = o;
    }
    __builtin_amdgcn_fence(__ATOMIC_ACQ_REL, "wavefront");
    __builtin_amdgcn_wave_barrier();
    it = nxt;
  }
}

DI void p0_ws_item(KP p, float* smemf, int item, int tid) {
  const int l = item >> 8, hp = (item >> 4) & 15, kt = item & 15;
  unsigned char* smem = (unsigned char*)smemf;
  unsigned char* SK = smem;
  unsigned char* WQ = smem + 32768;
  const float* skg = p.peer_subkeys + ((size_t)l * 16 + hp) * 128 * 128;
#pragma unroll
  for (int u = 0; u < 4; ++u) {
    const int q = tid + NTHR * u, row = q >> 4, c8 = (q & 15) * 8;
    const float4 a = *(const float4*)(skg + row * 128 + c8), b = *(const float4*)(skg + row * 128 + c8 + 4);
    u32x4 o; o[0] = pack2(a.x, a.y); o[1] = pack2(a.z, a.w); o[2] = pack2(b.x, b.y); o[3] = pack2(b.z, b.w);
    *(u32x4*)(SK + sw128(row, c8)) = o;
  }
  const float* wqg = p.peer_wq + (size_t)l * 1024 * 2048 + (size_t)(kt * 64) * 2048 + hp * 128;
#pragma unroll
  for (int u = 0; u < 2; ++u) {
    const int q = tid + NTHR * u, row = q >> 4, c8 = (q & 15) * 8;
    const float4 a = *(const float4*)(wqg + (size_t)row * 2048 + c8), b = *(const float4*)(wqg + (size_t)row * 2048 + c8 + 4);
    u32x4 o; o[0] = pack2(a.x, a.y); o[1] = pack2(a.z, a.w); o[2] = pack2(b.x, b.y); o[3] = pack2(b.z, b.w);
    *(u32x4*)(WQ + sw128(row, c8)) = o;
  }
  __syncthreads();
  const int lane = tid & 63, wave = tid >> 6, r = lane & 31, h = lane >> 5;
  const int km = wave >> 2, kn = wave & 3;
  f32x16 acc;
#pragma unroll
  for (int e = 0; e < 16; ++e) acc[e] = 0.f;
#pragma unroll
  for (int ks = 0; ks < 8; ++ks) {
    const bf16x8 av = *(const bf16x8*)(WQ + sw128(32 * km + r, 16 * ks + 8 * h));
    const bf16x8 bv = *(const bf16x8*)(SK + sw128(32 * kn + r, 16 * ks + 8 * h));
    acc = __builtin_amdgcn_mfma_f32_32x32x16_bf16(av, bv, acc, 0, 0, 0);
  }
  u16* dst = (u16*)(p.ws + WS_WS) + ((size_t)l * 2048 + hp * 128 + 32 * kn + r) * 1024 + kt * 64 + 32 * km + 4 * h;
#pragma unroll
  for (int g = 0; g < 4; ++g) {
    u32x2 o; o[0] = pack2(acc[4 * g], acc[4 * g + 1]); o[1] = pack2(acc[4 * g + 2], acc[4 * g + 3]);
    *(u32x2*)(dst + 8 * g) = o;
  }
  __syncthreads();
}

DI void p0_quant_rows(const float* src, unsigned char* dst, float* scl, int row0, int tid, float off) {
  const int lane = tid & 63, wave = tid >> 6;
  auto qrow = [&](int row, const float4& x0, const float4& x1, const float4& x2, const float4& x3) {
    float v[16] = {x0.x, x0.y, x0.z, x0.w, x1.x, x1.y, x1.z, x1.w, x2.x, x2.y, x2.z, x2.w, x3.x, x3.y, x3.z, x3.w};
    float am = 0.f;
#pragma unroll
    for (int e = 0; e < 16; ++e) am = fmaxf(am, fabsf(v[e]));
#pragma unroll
    for (int o = 32; o >= 1; o >>= 1) am = fmaxf(am, __shfl_xor(am, o));
    const float sc = am > 0.f ? am * (1.f / 127.f) : 1.f;
    const float inv = 1.f / sc;
    u32x4 o4;
#pragma unroll
    for (int q = 0; q < 4; ++q) {
      unsigned w = 0;
#pragma unroll
      for (int e = 0; e < 4; ++e) {
        const float qv = fminf(fmaxf(rintf(v[q * 4 + e] * inv), -127.f), 127.f) + off;
        w |= (((unsigned)(int)qv) & 0xffu) << (8 * e);
      }
      o4[q] = w;
    }
    *(u32x4*)(dst + (size_t)row * D + lane * 16) = o4;
    if (lane == 0) scl[row] = sc;
  };
#pragma unroll 1
  for (int i = 0; i < 8; i += 2) {
    const int rA = row0 + i * 8 + wave, rB = rA + 8;
    const float* sa = src + (size_t)rA * D + lane * 16;
    const float* sb = src + (size_t)rB * D + lane * 16;
    const float4 a0 = *(const float4*)(sa), a1 = *(const float4*)(sa + 4), a2 = *(const float4*)(sa + 8), a3 = *(const float4*)(sa + 12);
    const float4 b0 = *(const float4*)(sb), b1 = *(const float4*)(sb + 4), b2 = *(const float4*)(sb + 8), b3 = *(const float4*)(sb + 12);
    qrow(rA, a0, a1, a2, a3);
    qrow(rB, b0, b1, b2, b3);
  }
}

DI void p0_quant_waves(KP p, int bid, int nb, int tid) {
  const int lane = tid & 63, wave = tid >> 6;
  auto qrow = [&](int rr, const float4& x0, const float4& x1, const float4& x2, const float4& x3) {
    unsigned char* dst = p.ws + (rr < NEXP ? WS_UB : WS_VB);
    float* scl = (float*)(p.ws + (rr < NEXP ? WS_US : WS_VS));
    const int row = rr & (NEXP - 1);
    float v[16] = {x0.x, x0.y, x0.z, x0.w, x1.x, x1.y, x1.z, x1.w, x2.x, x2.y, x2.z, x2.w, x3.x, x3.y, x3.z, x3.w};
    float am = 0.f;
#pragma unroll
    for (int e = 0; e < 16; ++e) am = fmaxf(am, fabsf(v[e]));
#pragma unroll
    for (int o = 32; o >= 1; o >>= 1) am = fmaxf(am, __shfl_xor(am, o));
    const float sc = am > 0.f ? am * (1.f / 127.f) : 1.f;
    const float inv = 1.f / sc;
    u32x4 o4;
#pragma unroll
    for (int q = 0; q < 4; ++q) {
      unsigned w = 0;
#pragma unroll
      for (int e = 0; e < 4; ++e) {
        const float qv = fminf(fmaxf(rintf(v[q * 4 + e] * inv), -127.f), 127.f);
        w |= (((unsigned)(int)qv) & 0xffu) << (8 * e);
      }
      o4[q] = w;
    }
    *(u32x4*)(dst + (size_t)row * D + lane * 16) = o4;
    if (lane == 0) scl[row] = sc;
  };
  auto srow = [&](int rr) { return (rr < NEXP ? p.peer_u + (size_t)rr * D : p.peer_v + (size_t)(rr - NEXP) * D) + lane * 16; };
  const int step = nb * 8;
  int rA = bid * 8 + wave, rB = rA + step;
  float4 a0, a1, a2, a3, b0, b1, b2, b3;
  if (rA < 2 * NEXP) { const float* sa = srow(rA); a0 = *(const float4*)(sa); a1 = *(const float4*)(sa + 4); a2 = *(const float4*)(sa + 8); a3 = *(const float4*)(sa + 12); }
  if (rB < 2 * NEXP) { const float* sb = srow(rB); b0 = *(const float4*)(sb); b1 = *(const float4*)(sb + 4); b2 = *(const float4*)(sb + 8); b3 = *(const float4*)(sb + 12); }
#pragma unroll 1
  while (rA < 2 * NEXP) {
    qrow(rA, a0, a1, a2, a3);
    const int nA = rA + 2 * step;
    if (nA < 2 * NEXP) { const float* sa = srow(nA); a0 = *(const float4*)(sa); a1 = *(const float4*)(sa + 4); a2 = *(const float4*)(sa + 8); a3 = *(const float4*)(sa + 12); }
    if (rB < 2 * NEXP) qrow(rB, b0, b1, b2, b3);
    const int nB = rB + 2 * step;
    if (nB < 2 * NEXP) { const float* sb = srow(nB); b0 = *(const float4*)(sb); b1 = *(const float4*)(sb + 4); b2 = *(const float4*)(sb + 8); b3 = *(const float4*)(sb + 12); }
    rA = nA; rB = nB;
  }
}

constexpr int P0_N_WS = 1024;

DI void phase_p0a(KP p, float* smem, int bid, int nb, int tid) {
  if (bid == nb - 1) {
    float* lower = (float*)(p.ws + WS_LOWER);
    for (int e = tid; e < 1024; e += NTHR) {
      const float a0 = p.lb_logits[e], a1 = p.lb_logits[1024 + e], a2 = p.lb_logits[2048 + e], a3 = p.lb_logits[3072 + e];
      const float m = fmaxf(fmaxf(a0, a1), fmaxf(a2, a3));
      const float e0 = expf(a0 - m), e1 = expf(a1 - m), e2 = expf(a2 - m), e3 = expf(a3 - m);
      const float inv = 1.f / (e0 + e1 + e2 + e3);
      lower[e] = 0.f; lower[1024 + e] = e1 * inv; lower[2048 + e] = (e1 + e2) * inv; lower[3072 + e] = (e1 + e2 + e3) * inv;
    }
  }
  p0_mod_all(p, smem, bid, nb, tid);
  for (int i = bid; i < P0_N_WS; i += nb) p0_ws_item(p, smem, i, tid);
  p0_transpose_waves(p, smem, bid, nb, tid);
  p0_quant_waves(p, bid, nb, tid);
}

template <bool FIRST = false>
DI void phase_norm(KP p, const float* g, int l, int sh_off, int sc_off, int bid, int nb, int row_end, int tid, bool wq = false) {
  const int lane = tid & 63, wave = tid >> 6;
  u16* xw = (u16*)(p.ws + WS_XW);
  const float* mod = (const float*)(p.ws + WS_MOD) + (size_t)l * 5 * 6144;
  for (int row = bid * 8 + wave; row < row_end; row += nb * 8) {
    float v[16];
    if (FIRST) {
      const float* xr = (row < NLAT ? p.x + (size_t)row * D : p.ctx + (size_t)(row - NLAT) * D) + lane * 16;
      u32x4 w0, w1;
#pragma unroll
      for (int q = 0; q < 4; ++q) {
        const float4 a = *(const float4*)(xr + q * 4);
        const unsigned lo = pack2(a.x, a.y), hi = pack2(a.z, a.w);
        if (q < 2) { w0[2 * q] = lo; w0[2 * q + 1] = hi; } else { w1[2 * (q - 2)] = lo; w1[2 * (q - 2) + 1] = hi; }
      }
      *(u32x4*)(xw + (size_t)row * D + lane * 16) = w0; *(u32x4*)(xw + (size_t)row * D + lane * 16 + 8) = w1;
#pragma unroll
      for (int e = 0; e < 4; ++e) { v[2 * e] = bflo(w0[e]); v[2 * e + 1] = bfhi(w0[e]); v[8 + 2 * e] = bflo(w1[e]); v[8 + 2 * e + 1] = bfhi(w1[e]); }
    } else {
      const u32x4 w0 = *(const u32x4*)(xw + (size_t)row * D + lane * 16), w1 = *(const u32x4*)(xw + (size_t)row * D + lane * 16 + 8);
#pragma unroll
      for (int e = 0; e < 4; ++e) { v[2 * e] = bflo(w0[e]); v[2 * e + 1] = bfhi(w0[e]); v[8 + 2 * e] = bflo(w1[e]); v[8 + 2 * e + 1] = bfhi(w1[e]); }
    }
    float ss = 0.f;
#pragma unroll
    for (int e = 0; e < 16; ++e) ss += v[e] * v[e];
    ss = wave_sum(ss);
    const float rs = rsqrtf(ss * (1.f / 1024.f) + EPS);
    const float* mr = mod + (size_t)row_cls(row) * 6144;
#pragma unroll
    for (int q = 0; q < 4; ++q) {
      const int c0 = lane * 16 + q * 4;
      const float4 gg = *(const float4*)(g + c0);
      const float4 sh = *(const float4*)(mr + sh_off + c0);
      const float4 sc = *(const float4*)(mr + sc_off + c0);
      v[q * 4 + 0] = v[q * 4 + 0] * rs * gg.x * (1.f + sc.x) + sh.x; v[q * 4 + 1] = v[q * 4 + 1] * rs * gg.y * (1.f + sc.y) + sh.y;
      v[q * 4 + 2] = v[q * 4 + 2] * rs * gg.z * (1.f + sc.z) + sh.z; v[q * 4 + 3] = v[q * 4 + 3] * rs * gg.w * (1.f + sc.w) + sh.w;
    }
    {
      float am = 0.f;
#pragma unroll
      for (int e = 0; e < 16; ++e) am = fmaxf(am, fabsf(v[e]));
#pragma unroll
      for (int o2 = 32; o2 >= 1; o2 >>= 1) am = fmaxf(am, __shfl_xor(am, o2));
      const float sc = am > 0.f ? am * (1.f / 127.f) : 1.f, inv = 1.f / sc;
      u32x4 oq;
#pragma unroll
      for (int q = 0; q < 4; ++q) {
        unsigned w = 0;
#pragma unroll
        for (int e = 0; e < 4; ++e) w |= (((unsigned)(int)rintf(v[q * 4 + e] * inv)) & 0xffu) << (8 * e);
        oq[q] = w;
      }
      *(u32x4*)(p.ws + WS_HXQ + (size_t)row * D + lane * 16) = oq;
      if (lane == 0) ((float*)(p.ws + WS_HXS))[row] = sc;
    }
  }
}

DI void phase_rowq(KP p, size_t src_off, size_t dst_off, size_t scl_off, int nrows, int bid, int nb, int tid) {
  const int lane = tid & 63, wave = tid >> 6;
  const u16* src = (const u16*)(p.ws + src_off);
  for (int row = bid * 8 + wave; row < nrows; row += nb * 8) {
    const u32x4 a = *(const u32x4*)(src + (size_t)row * 1024 + lane * 16), b = *(const u32x4*)(src + (size_t)row * 1024 + lane * 16 + 8);
    float v[16];
#pragma unroll
    for (int e = 0; e < 4; ++e) { v[2 * e] = bflo(a[e]); v[2 * e + 1] = bfhi(a[e]); v[8 + 2 * e] = bflo(b[e]); v[8 + 2 * e + 1] = bfhi(b[e]); }
    float am = 0.f;
#pragma unroll
    for (int e = 0; e < 16; ++e) am = fmaxf(am, fabsf(v[e]));
#pragma unroll
    for (int o2 = 32; o2 >= 1; o2 >>= 1) am = fmaxf(am, __shfl_xor(am, o2));
    const float sc = am > 0.f ? am * (1.f / 127.f) : 1.f, inv = 1.f / sc;
    u32x4 o;
#pragma unroll
    for (int q = 0; q < 4; ++q) {
      unsigned w = 0;
#pragma unroll
      for (int e = 0; e < 4; ++e) w |= (((unsigned)(int)rintf(v[q * 4 + e] * inv)) & 0xffu) << (8 * e);
      o[q] = w;
    }
    *(u32x4*)(p.ws + dst_off + (size_t)row * 1024 + lane * 16) = o;
    if (lane == 0) ((float*)(p.ws + scl_off))[row] = sc;
  }
}

constexpr int GEMM_LDS_STAGE = 256 * 128 + 128 * 128;
enum { EPI_Z = 0, EPI_RES = 1, EPI_TOPK = 2 };

DI unsigned lds_off(int row, int c) { return (unsigned)(row * 128 + ((c ^ ((row >> 1) & 7)) << 4)); }

template <int EPI, int BN, bool DEEP = false>
DI void gemm_tile(KP p, unsigned char* smem, const u16* A, const u16* Bt, int N, int K, int l, int m0, int n0, int tid) {
  constexpr int WN = BN / 64, WM = 8 / WN, IM = 256 / WM / 32, NB = BN / 64;
  constexpr int STAGE = 32768 + BN * 128;
  const int lane = tid & 63, wave = tid >> 6;
  const int wm = wave / WN, wn = wave % WN, r = lane & 31, h = lane >> 5;
  f32x16 acc[IM][2];
#pragma unroll
  for (int i = 0; i < IM; ++i)
#pragma unroll
    for (int j = 0; j < 2; ++j)
#pragma unroll
      for (int e = 0; e < 16; ++e) acc[i][j][e] = 0.f;
  u32x4 ra[4], rb[NB];
  const int nk = K / 64;
  const unsigned voff = (unsigned)(((tid >> 3) * K + (tid & 7) * 8) * 2);
  auto gload = [&](int kt) {
#pragma unroll
    for (int i = 0; i < 4; ++i) {
      const char* base = (const char*)(A + (size_t)(m0 + 64 * i) * K + kt * 64);
      ra[i] = *(const u32x4*)(base + voff);
    }
#pragma unroll
    for (int i = 0; i < NB; ++i) {
      const char* base = (const char*)(Bt + (size_t)(n0 + 64 * i) * K + kt * 64);
      rb[i] = *(const u32x4*)(base + voff);
    }
  };
  auto lstore = [&](int buf) {
    unsigned char* sa = smem + buf * STAGE;
    unsigned char* sb = sa + 32768;
#pragma unroll
    for (int i = 0; i < 4; ++i) {
      const int q = tid + i * NTHR, row = q >> 3, c = q & 7;
      *(u32x4*)(sa + lds_off(row, c)) = ra[i];
    }
#pragma unroll
    for (int i = 0; i < NB; ++i) {
      const int q = tid + i * NTHR, row = q >> 3, c = q & 7;
      *(u32x4*)(sb + lds_off(row, c)) = rb[i];
    }
  };
  auto compute = [&](int kt) {
    const unsigned char* sa = smem + (kt & 1) * STAGE;
    const unsigned char* sb = sa + 32768;
#pragma unroll
    for (int s = 0; s < 4; ++s) {
      bf16x8 fa[IM], fb[2];
#pragma unroll
      for (int i = 0; i < IM; ++i) fa[i] = *(const bf16x8*)(sa + lds_off(wm * (IM * 32) + i * 32 + r, 2 * s + h));
#pragma unroll
      for (int j = 0; j < 2; ++j) fb[j] = *(const bf16x8*)(sb + lds_off(wn * 64 + j * 32 + r, 2 * s + h));
#pragma unroll
      for (int i = 0; i < IM; ++i)
#pragma unroll
        for (int j = 0; j < 2; ++j) acc[i][j] = __builtin_amdgcn_mfma_f32_32x32x16_bf16(fa[i], fb[j], acc[i][j], 0, 0, 0);
      if constexpr (BN == 256) __builtin_amdgcn_sched_barrier(0);
    }
  };
  if constexpr (!DEEP) {
    gload(0);
    lstore(0);
    __syncthreads();
    for (int kt = 0; kt < nk; ++kt) {
      if (kt + 1 < nk) gload(kt + 1);
      compute(kt);
      if (kt + 1 < nk) lstore((kt + 1) & 1);
      __syncthreads();
    }
  } else {
    u32x4 ra2[4], rb2[NB];
    auto gload2 = [&](int kt) {
#pragma unroll
      for (int i = 0; i < 4; ++i) ra2[i] = *(const u32x4*)((const char*)(A + (size_t)(m0 + 64 * i) * K + kt * 64) + voff);
#pragma unroll
      for (int i = 0; i < NB; ++i) rb2[i] = *(const u32x4*)((const char*)(Bt + (size_t)(n0 + 64 * i) * K + kt * 64) + voff);
    };
    auto lstore2 = [&](int buf) {
      unsigned char* sa = smem + buf * STAGE;
      unsigned char* sb = sa + 32768;
#pragma unroll
      for (int i = 0; i < 4; ++i) { const int q = tid + i * NTHR; *(u32x4*)(sa + lds_off(q >> 3, q & 7)) = ra2[i]; }
#pragma unroll
      for (int i = 0; i < NB; ++i) { const int q = tid + i * NTHR; *(u32x4*)(sb + lds_off(q >> 3, q & 7)) = rb2[i]; }
    };
    gload(0);
    gload2(1);
    lstore(0);
    if (2 < nk) gload(2);
    __syncthreads();
    for (int kt = 0; kt < nk; kt += 2) {
      if (kt + 1 < nk) { lstore2(1); if (kt + 3 < nk) gload2(kt + 3); }
      compute(kt);
      __syncthreads();
      if (kt + 2 < nk) { lstore(0); if (kt + 4 < nk) gload(kt + 4); }
      compute(kt + 1);
      __syncthreads();
    }
  }
#pragma unroll 1
  for (int hf = 0; hf < BN / 128; ++hf) {
    const bool mine = (wn >> 1) == hf;
    const int n0h = n0 + hf * 128, lc = (wn & 1) * 64 + r, lr = wm * (IM * 32) + 4 * h;
    if constexpr (EPI == EPI_Z) {
      u16* st = (u16*)smem;
      if (mine) {
        u16* lb = st + lr * 136 + lc;
#pragma unroll
        for (int i = 0; i < IM; ++i)
#pragma unroll
          for (int j = 0; j < 2; ++j)
#pragma unroll
            for (int e = 0; e < 16; ++e) lb[(i * 32 + (e & 3) + 8 * (e >> 2)) * 136 + j * 32] = f2bf(acc[i][j][e]);
      }
      __syncthreads();
      u16* Z = (u16*)(p.ws + WS_Z) + (size_t)m0 * N + n0h;
#pragma unroll 2
      for (int i = 0; i < 8; ++i) {
        const int q = tid + i * NTHR, row = q >> 4, c = q & 15;
        *(u32x4*)(Z + (size_t)row * N + c * 8) = *(const u32x4*)(st + row * 136 + c * 8);
      }
      __syncthreads();
    } else if constexpr (EPI == EPI_RES) {
      float* st = (float*)smem;
      if (mine) {
        float* lb = st + lr * 132 + lc;
#pragma unroll
        for (int i = 0; i < IM; ++i)
#pragma unroll
          for (int j = 0; j < 2; ++j)
#pragma unroll
            for (int e = 0; e < 16; ++e) lb[(i * 32 + (e & 3) + 8 * (e >> 2)) * 132 + j * 32] = acc[i][j][e];
      }
      __syncthreads();
      float* xw = (float*)(p.ws + WS_XW) + (size_t)m0 * D + n0h;
      const float* g1p = (const float*)(p.ws + WS_MOD) + ((size_t)l * 5 + row_cls(m0)) * 6144 + 2048 + n0h;
      const int c = tid & 31;
      const float4 g1 = *(const float4*)(g1p + c * 4);
#pragma unroll 2
      for (int i = 0; i < 16; ++i) {
        const int row = (tid >> 5) + i * 16;
        const float4 a = *(const float4*)(st + row * 132 + c * 4);
        float4 xv = *(const float4*)(xw + (size_t)row * D + c * 4);
        xv.x += g1.x * a.x; xv.y += g1.y * a.y; xv.z += g1.z * a.z; xv.w += g1.w * a.w;
        *(float4*)(xw + (size_t)row * D + c * 4) = xv;
      }
      __syncthreads();
    } else {
      float* st = (float*)smem;
      if (mine) {
        float* lb = st + lr * 129 + lc;
#pragma unroll
        for (int i = 0; i < IM; ++i)
#pragma unroll
          for (int j = 0; j < 2; ++j)
#pragma unroll
            for (int e = 0; e < 16; ++e) lb[(i * 32 + (e & 3) + 8 * (e >> 2)) * 129 + j * 32] = acc[i][j][e];
      }
      __syncthreads();
      if (tid < 256) {
        float t16[16];
#pragma unroll
        for (int i = 0; i < 16; ++i) t16[i] = __uint_as_float(0xff800000u);
        for (int kk = 0; kk < 128; ++kk) {
          const float sv = st[tid * 129 + kk];
          const float x = __uint_as_float((__float_as_uint(sv) & ~0x7fu) | (unsigned)(127 - kk));
#pragma unroll
          for (int i = 15; i >= 1; --i) t16[i] = __builtin_amdgcn_fmed3f(x, t16[i - 1], t16[i]);
          t16[0] = fmaxf(t16[0], x);
        }
        unsigned* tk = (unsigned*)(p.ws + WS_TOPK) + ((size_t)(m0 + tid) * 16 + (n0h >> 7)) * 16;
#pragma unroll
        for (int q = 0; q < 4; ++q) {
          u32x4 o; o[0] = __float_as_uint(t16[q * 4]); o[1] = __float_as_uint(t16[q * 4 + 1]); o[2] = __float_as_uint(t16[q * 4 + 2]); o[3] = __float_as_uint(t16[q * 4 + 3]);
          *(u32x4*)(tk + q * 4) = o;
        }
      }
      __syncthreads();
    }
  }
}

template <int EPI>
DI void gemm_phase(KP p, unsigned char* smem, const u16* A, const u16* Bt, int M, int N, int K, int l, int bid, int nb, int m_tiles_active, int tid) {
  const int ntn = N / 128;
  const int ntiles = m_tiles_active * ntn;
#pragma unroll 1
  for (int tile = bid; tile < ntiles; tile += nb)
    gemm_tile<EPI, 128, true>(p, smem, A, Bt, N, K, l, (tile / ntn) * 256, (tile % ntn) * 128, tid);
}

namespace pg8 {
#define PG8_LAS __attribute__((address_space(3)))
typedef unsigned short bf16_t;
typedef short bf16x8 __attribute__((ext_vector_type(8)));
typedef float f32x4 __attribute__((ext_vector_type(4)));
typedef unsigned u32x4 __attribute__((ext_vector_type(4)));
constexpr int BM = 256, BK = 64, HALF = 128, HTB = HALF * BK * 2  , STAGE_BYTES = 8 * HTB, NXCD = 8, WGM = 8;

__host__ __device__ __forceinline__ int lds_byte(int r, int c) { const int st = (r >> 4) * 2 + (c >> 5), rr = r & 15, cc = c & 31, ob = rr * 64 + cc * 2; return st * 1024 + (ob ^ (((ob >> 9) & 1) << 5)); }
__host__ __device__ __forceinline__ void stage_rc(int b, int& R, int& C) { const int st = b / 1024, sb = b % 1024, swz = sb ^ (((sb >> 9) & 1) << 5); R = (st >> 1) * 16 + swz / 64; C = (st & 1) * 32 + (swz % 64) / 2; }
__host__ __device__ __forceinline__ int perm32(int rho) { const int n = rho >> 4, i = rho & 15; return 8 * (i >> 2) + 4 * n + (i & 3); }

struct Unit { int pm, pn; };
struct Gemm { const bf16_t* A; const bf16_t* Bt; int M, N, K; };

template <class Epi, class Sched>
__device__ __forceinline__ void gemm_phase(PG8_LAS unsigned char* lds, const Gemm g, const Sched& S, const Epi& E, const int tid) {
    const int wid = __builtin_amdgcn_readfirstlane(tid >> 6), lane = tid & 63, wr = wid >> 2, wc = wid & 3, fr = lane & 15, fq = lane >> 4;
    const int K = g.K, nt = K / BK;
    unsigned voffA[2], voffB[2];
#pragma unroll
    for (int i = 0; i < 2; ++i) { int R, C; stage_rc(tid * 16 + i * 8192, R, C); const int Rb = Epi::PERM ? ((R & ~31) + perm32(R & 31)) : R;
        voffA[i] = (unsigned)(R * K + C) * 2u; voffB[i] = (unsigned)(Rb * K + C) * 2u; }
    const size_t kstep = (size_t)(BK * 2);
    const size_t hstep = (size_t)HALF * K * 2;
    const size_t tstep = 2 * hstep;
    const unsigned ldsw = (unsigned)wid * 1024u;
    const int aoff = lds_byte(wr * 64 + fr, fq * 8), boff = lds_byte(wc * 32 + fr, fq * 8);
#define PG8_SA(b, h) (((b) * 2 + (h)) * HTB)
#define PG8_SB(b, h) ((4 + (b) * 2 + (h)) * HTB)
#define PG8_STAGE(bufoff, gbase, voff) do { _Pragma("unroll") for (int _i = 0; _i < 2; ++_i) \
        __builtin_amdgcn_global_load_lds((const unsigned*)((const char*)(gbase) + (voff)[_i]), (PG8_LAS unsigned*)(lds + (bufoff) + ldsw + _i * 8192), 16, 0, 0); } while (0)
#define PG8_LDA(dst, b, h) do { _Pragma("unroll") for (int m = 0; m < 4; ++m) _Pragma("unroll") for (int k = 0; k < 2; ++k) dst[m][k] = *(const PG8_LAS bf16x8*)(lds + PG8_SA(b, h) + aoff + m * 2048 + k * 1024); } while (0)
#define PG8_LDB(dst, b, h) do { _Pragma("unroll") for (int n = 0; n < 2; ++n) _Pragma("unroll") for (int k = 0; k < 2; ++k) dst[n][k] = *(const PG8_LAS bf16x8*)(lds + PG8_SB(b, h) + boff + n * 2048 + k * 1024); } while (0)
#define PG8_MMA(ai, bj, At, Bt) do { __builtin_amdgcn_s_setprio(1); _Pragma("unroll") for (int m = 0; m < 4; ++m) _Pragma("unroll") for (int n = 0; n < 2; ++n) _Pragma("unroll") for (int k = 0; k < 2; ++k) \
        acc[ai][bj][m][n] = __builtin_amdgcn_mfma_f32_16x16x32_bf16(Bt[n][k], At[m][k], acc[ai][bj][m][n], 0, 0, 0); __builtin_amdgcn_s_setprio(0); } while (0)
#define PG8_WAIT_V(n) asm volatile("s_waitcnt vmcnt(" #n ")" ::: "memory")
#define PG8_WAIT_L(n) asm volatile("s_waitcnt lgkmcnt(" #n ")" ::: "memory")
#define PG8_BAR __builtin_amdgcn_s_barrier()
#define PG8_SCHED __builtin_amdgcn_sched_barrier(0)
    Unit cur, nxt; int ui = 0;
    if (!S.next(0, cur)) return;
    f32x4 acc[2][2][4][2];
#pragma unroll
    for (int a = 0; a < 2; ++a)
#pragma unroll
        for (int b = 0; b < 2; ++b)
#pragma unroll
            for (int m = 0; m < 4; ++m)
#pragma unroll
                for (int n = 0; n < 2; ++n) acc[a][b][m][n] = (f32x4){0.f, 0.f, 0.f, 0.f};
    bf16x8 At[4][2], B0[2][2], B1[2][2];
    const char* cA = (const char*)g.A + (size_t)cur.pm * tstep; const char* cB = (const char*)g.Bt + (size_t)cur.pn * tstep;
    S.a_ready(cur);
    PG8_STAGE(PG8_SB(0, 0), cB, voffB); PG8_STAGE(PG8_SA(0, 0), cA, voffA); PG8_STAGE(PG8_SB(0, 1), cB + hstep, voffB); PG8_STAGE(PG8_SA(0, 1), cA + hstep, voffA);
    if (wr == 1) PG8_BAR;
    PG8_WAIT_V(4); PG8_BAR;
    PG8_STAGE(PG8_SB(1, 0), cB + kstep, voffB); PG8_STAGE(PG8_SA(1, 0), cA + kstep, voffA); PG8_STAGE(PG8_SB(1, 1), cB + hstep + kstep, voffB);
    PG8_WAIT_V(6); PG8_BAR;
    for (;;) {
        const bool has_next = S.next(ui + 1, nxt);
        const char* nA = has_next ? (const char*)g.A + (size_t)nxt.pm * tstep : cA; const char* nB = has_next ? (const char*)g.Bt + (size_t)nxt.pn * tstep : cB;
        for (int t = 0; t < nt; t += 2) {
            const bool last = (t == nt - 2);
            const char* a1 = cA + (size_t)(t + 1) * kstep;
            const char* a2 = last ? nA : cA + (size_t)(t + 2) * kstep; const char* b2 = last ? nB : cB + (size_t)(t + 2) * kstep;
            const char* a3 = a2 + kstep; const char* b3 = b2 + kstep;
            if (last && has_next) S.a_ready(nxt);
            PG8_LDB(B0, 0, 0); PG8_SCHED; PG8_LDA(At, 0, 0); PG8_STAGE(PG8_SA(1, 1), a1 + hstep, voffA);
            PG8_WAIT_L(8); PG8_BAR; PG8_WAIT_L(0); PG8_MMA(0, 0, At, B0); PG8_BAR; PG8_SCHED;
            PG8_LDB(B1, 0, 1); PG8_STAGE(PG8_SB(0, 0), b2, voffB);
            PG8_BAR; PG8_WAIT_L(0); PG8_MMA(0, 1, At, B1); PG8_BAR;
            PG8_LDA(At, 0, 1); PG8_STAGE(PG8_SA(0, 0), a2, voffA);
            PG8_BAR; PG8_WAIT_L(0); PG8_MMA(1, 0, At, B0); PG8_BAR; PG8_SCHED;
            PG8_STAGE(PG8_SB(0, 1), b2 + hstep, voffB);
            PG8_WAIT_V(6); PG8_BAR; PG8_MMA(1, 1, At, B1); PG8_BAR;
            PG8_LDB(B0, 1, 0); PG8_SCHED; PG8_LDA(At, 1, 0); PG8_STAGE(PG8_SA(0, 1), a2 + hstep, voffA);
            PG8_WAIT_L(8); PG8_BAR; PG8_WAIT_L(0); PG8_MMA(0, 0, At, B0); PG8_BAR; PG8_SCHED;
            PG8_LDB(B1, 1, 1); PG8_STAGE(PG8_SB(1, 0), b3, voffB);
            PG8_BAR; PG8_WAIT_L(0); PG8_MMA(0, 1, At, B1); PG8_BAR;
            PG8_LDA(At, 1, 1); PG8_STAGE(PG8_SA(1, 0), a3, voffA);
            PG8_BAR; PG8_WAIT_L(0); PG8_MMA(1, 0, At, B0); PG8_BAR; PG8_SCHED;
            PG8_STAGE(PG8_SB(1, 1), b3 + hstep, voffB);
            PG8_WAIT_V(6); PG8_BAR; PG8_MMA(1, 1, At, B1); PG8_BAR;
        }
        if constexpr (!Epi::AFTER_DRAIN) { E(acc, cur, wr, wc, fr, fq); S.done(cur); }
        if (!has_next) break;
#pragma unroll
        for (int a = 0; a < 2; ++a)
#pragma unroll
            for (int b = 0; b < 2; ++b)
#pragma unroll
                for (int m = 0; m < 4; ++m)
#pragma unroll
                    for (int n = 0; n < 2; ++n) acc[a][b][m][n] = (f32x4){0.f, 0.f, 0.f, 0.f};
        cur = nxt; cA = nA; cB = nB; ++ui;
    }
    PG8_WAIT_V(0);
    if (wr == 0) PG8_BAR;
    PG8_BAR;
    if constexpr (Epi::AFTER_DRAIN) { E.fused(acc, cur, wr, wc, fr, fq, lds, wid, lane); S.done(cur); }
#undef PG8_SA
#undef PG8_SB
#undef PG8_STAGE
#undef PG8_LDA
#undef PG8_LDB
#undef PG8_MMA
#undef PG8_WAIT_V
#undef PG8_WAIT_L
#undef PG8_BAR
#undef PG8_SCHED
}

typedef int i32x4 __attribute__((ext_vector_type(4)));
template <class Epi, class Sched>
__device__ __forceinline__ void gemm_phase_i8(PG8_LAS unsigned char* lds, const Gemm g, const Sched& S, const Epi& E, const int tid) {
    const int wid = __builtin_amdgcn_readfirstlane(tid >> 6), lane = tid & 63, wr = wid >> 2, wc = wid & 3, fr = lane & 15, fq = lane >> 4;
    const int K = g.K  , nt = K / (2 * BK);
    unsigned voffA[2], voffB[2];
#pragma unroll
    for (int i = 0; i < 2; ++i) { int R, C; stage_rc(tid * 16 + i * 8192, R, C); const int Rb = Epi::PERM ? ((R & ~31) + perm32(R & 31)) : R;
        voffA[i] = (unsigned)(R * K + 2 * C); voffB[i] = (unsigned)(Rb * K + 2 * C); }
    const size_t kstep = (size_t)(BK * 2);
    const size_t hstep = (size_t)HALF * K;
    const size_t tstep = 2 * hstep;
    const unsigned ldsw = (unsigned)wid * 1024u;
    const int aoff = lds_byte(wr * 64 + fr, fq * 8), boff = lds_byte(wc * 32 + fr, fq * 8);
#define PG8_SA(b, h) (((b) * 2 + (h)) * HTB)
#define PG8_SB(b, h) ((4 + (b) * 2 + (h)) * HTB)
#define PG8_STAGE(bufoff, gbase, voff) do { _Pragma("unroll") for (int _i = 0; _i < 2; ++_i) \
        __builtin_amdgcn_global_load_lds((const unsigned*)((const char*)(gbase) + (voff)[_i]), (PG8_LAS unsigned*)(lds + (bufoff) + ldsw + _i * 8192), 16, 0, 0); } while (0)
#define PG8_LDA(dst, b, h) do { _Pragma("unroll") for (int m = 0; m < 4; ++m) _Pragma("unroll") for (int k = 0; k < 2; ++k) dst[m][k] = *(const PG8_LAS bf16x8*)(lds + PG8_SA(b, h) + aoff + m * 2048 + k * 1024); } while (0)
#define PG8_LDB(dst, b, h) do { _Pragma("unroll") for (int n = 0; n < 2; ++n) _Pragma("unroll") for (int k = 0; k < 2; ++k) dst[n][k] = *(const PG8_LAS bf16x8*)(lds + PG8_SB(b, h) + boff + n * 2048 + k * 1024); } while (0)
#define PG8_MMA(ai, bj, At, Bt) do { __builtin_amdgcn_s_setprio(1); _Pragma("unroll") for (int m = 0; m < 4; ++m) _Pragma("unroll") for (int n = 0; n < 2; ++n) _Pragma("unroll") for (int k = 0; k < 2; ++k) \
        acc[ai][bj][m][n] = __builtin_amdgcn_mfma_i32_16x16x64_i8(__builtin_bit_cast(i32x4, Bt[n][k]), __builtin_bit_cast(i32x4, At[m][k]), acc[ai][bj][m][n], 0, 0, 0); __builtin_amdgcn_s_setprio(0); } while (0)
#define PG8_WAIT_V(n) asm volatile("s_waitcnt vmcnt(" #n ")" ::: "memory")
#define PG8_WAIT_L(n) asm volatile("s_waitcnt lgkmcnt(" #n ")" ::: "memory")
#define PG8_BAR __builtin_amdgcn_s_barrier()
#define PG8_SCHED __builtin_amdgcn_sched_barrier(0)
    Unit cur, nxt; int ui = 0;
    if (!S.next(0, cur)) return;
    i32x4 acc[2][2][4][2];
#pragma unroll
    for (int a = 0; a < 2; ++a)
#pragma unroll
        for (int b = 0; b < 2; ++b)
#pragma unroll
            for (int m = 0; m < 4; ++m)
#pragma unroll
                for (int n = 0; n < 2; ++n) acc[a][b][m][n] = (i32x4){0, 0, 0, 0};
    bf16x8 At[4][2], B0[2][2], B1[2][2];
    const char* cA = (const char*)g.A + (size_t)cur.pm * tstep; const char* cB = (const char*)g.Bt + (size_t)cur.pn * tstep;
    S.a_ready(cur);
    PG8_STAGE(PG8_SB(0, 0), cB, voffB); PG8_STAGE(PG8_SA(0, 0), cA, voffA); PG8_STAGE(PG8_SB(0, 1), cB + hstep, voffB); PG8_STAGE(PG8_SA(0, 1), cA + hstep, voffA);
    if (wr == 1) PG8_BAR;
    PG8_WAIT_V(4); PG8_BAR;
    PG8_STAGE(PG8_SB(1, 0), cB + kstep, voffB); PG8_STAGE(PG8_SA(1, 0), cA + kstep, voffA); PG8_STAGE(PG8_SB(1, 1), cB + hstep + kstep, voffB);
    PG8_WAIT_V(6); PG8_BAR;
    for (;;) {
        const bool has_next = S.next(ui + 1, nxt);
        const char* nA = has_next ? (const char*)g.A + (size_t)nxt.pm * tstep : cA; const char* nB = has_next ? (const char*)g.Bt + (size_t)nxt.pn * tstep : cB;
        for (int t = 0; t < nt; t += 2) {
            const bool last = (t == nt - 2);
            const char* a1 = cA + (size_t)(t + 1) * kstep;
            const char* a2 = last ? nA : cA + (size_t)(t + 2) * kstep; const char* b2 = last ? nB : cB + (size_t)(t + 2) * kstep;
            const char* a3 = a2 + kstep; const char* b3 = b2 + kstep;
            if (last && has_next) S.a_ready(nxt);
            PG8_LDB(B0, 0, 0); PG8_SCHED; PG8_LDA(At, 0, 0); PG8_STAGE(PG8_SA(1, 1), a1 + hstep, voffA);
            PG8_WAIT_L(8); PG8_BAR; PG8_WAIT_L(0); PG8_MMA(0, 0, At, B0); PG8_BAR; PG8_SCHED;
            PG8_LDB(B1, 0, 1); PG8_STAGE(PG8_SB(0, 0), b2, voffB);
            PG8_BAR; PG8_WAIT_L(0); PG8_MMA(0, 1, At, B1); PG8_BAR;
            PG8_LDA(At, 0, 1); PG8_STAGE(PG8_SA(0, 0), a2, voffA);
            PG8_BAR; PG8_WAIT_L(0); PG8_MMA(1, 0, At, B0); PG8_BAR; PG8_SCHED;
            PG8_STAGE(PG8_SB(0, 1), b2 + hstep, voffB);
            PG8_WAIT_V(6); PG8_BAR; PG8_MMA(1, 1, At, B1); PG8_BAR;
            PG8_LDB(B0, 1, 0); PG8_SCHED; PG8_LDA(At, 1, 0); PG8_STAGE(PG8_SA(0, 1), a2 + hstep, voffA);
            PG8_WAIT_L(8); PG8_BAR; PG8_WAIT_L(0); PG8_MMA(0, 0, At, B0); PG8_BAR; PG8_SCHED;
            PG8_LDB(B1, 1, 1); PG8_STAGE(PG8_SB(1, 0), b3, voffB);
            PG8_BAR; PG8_WAIT_L(0); PG8_MMA(0, 1, At, B1); PG8_BAR;
            PG8_LDA(At, 1, 1); PG8_STAGE(PG8_SA(1, 0), a3, voffA);
            PG8_BAR; PG8_WAIT_L(0); PG8_MMA(1, 0, At, B0); PG8_BAR; PG8_SCHED;
            PG8_STAGE(PG8_SB(1, 1), b3 + hstep, voffB);
            PG8_WAIT_V(6); PG8_BAR; PG8_MMA(1, 1, At, B1); PG8_BAR;
        }
        if constexpr (!Epi::AFTER_DRAIN) { E(acc, cur, wr, wc, fr, fq); S.done(cur); }
        if (!has_next) break;
#pragma unroll
        for (int a = 0; a < 2; ++a)
#pragma unroll
            for (int b = 0; b < 2; ++b)
#pragma unroll
                for (int m = 0; m < 4; ++m)
#pragma unroll
                    for (int n = 0; n < 2; ++n) acc[a][b][m][n] = (i32x4){0, 0, 0, 0};
        cur = nxt; cA = nA; cB = nB; ++ui;
    }
    PG8_WAIT_V(0);
    if (wr == 0) PG8_BAR;
    PG8_BAR;
    if constexpr (Epi::AFTER_DRAIN) { E.fused(acc, cur, wr, wc, fr, fq, lds, wid, lane); S.done(cur); }
#undef PG8_SA
#undef PG8_SB
#undef PG8_STAGE
#undef PG8_LDA
#undef PG8_LDB
#undef PG8_MMA
#undef PG8_WAIT_V
#undef PG8_WAIT_L
#undef PG8_BAR
#undef PG8_SCHED
}

struct LinOrder {
  int nN, nunits, G, c;
  __device__ __forceinline__ bool next(int i, Unit& u) const { const int L = i * G + c; if (L >= nunits) return false; u.pm = L / nN; u.pn = L % nN; return true; }
  __device__ __forceinline__ void a_ready(const Unit&) const {}
  __device__ __forceinline__ void done(const Unit&) const {}
};
struct OneUnit {
  Unit u0;
  __device__ __forceinline__ bool next(int i, Unit& u) const { if (i) return false; u = u0; return true; }
  __device__ __forceinline__ void a_ready(const Unit&) const {}
  __device__ __forceinline__ void done(const Unit&) const {}
};
struct EpiZ {
  static constexpr bool PERM = true, AFTER_DRAIN = false;
  bf16_t* O; int ldc;
  __device__ __forceinline__ void operator()(const f32x4 (&acc)[2][2][4][2], const Unit& u, int wr, int wc, int fr, int fq) const {
    const int row0 = u.pm * BM + wr * 64 + fr, col0 = u.pn * BM + wc * 32 + 8 * fq;
#pragma unroll
    for (int ai = 0; ai < 2; ++ai)
#pragma unroll
      for (int m = 0; m < 4; ++m) { bf16_t* rowp = O + (size_t)(row0 + ai * HALF + m * 16) * ldc + col0;
#pragma unroll
        for (int bj = 0; bj < 2; ++bj) { const f32x4 v0 = acc[ai][bj][m][0], v1 = acc[ai][bj][m][1];
          u32x4 w; w.x = ::pack2(v0[0], v0[1]); w.y = ::pack2(v0[2], v0[3]); w.z = ::pack2(v1[0], v1[1]); w.w = ::pack2(v1[2], v1[3]);
          *(u32x4*)(rowp + bj * HALF) = w; } }
  }
};
struct EpiRes {
  static constexpr bool PERM = true, AFTER_DRAIN = false;
  bf16_t* xw; const float* modl;
  __device__ __forceinline__ void operator()(const f32x4 (&acc)[2][2][4][2], const Unit& u, int wr, int wc, int fr, int fq) const {
    const int row0 = u.pm * BM + wr * 64 + fr, col0 = u.pn * BM + wc * 32 + 8 * fq;
    const float* g1p = modl + (size_t)::row_cls(u.pm * BM) * 6144 + 2048 + col0;
    f32x4 gv[2][2];
#pragma unroll
    for (int bj = 0; bj < 2; ++bj)
#pragma unroll
      for (int n = 0; n < 2; ++n) gv[bj][n] = *(const f32x4*)(g1p + bj * HALF + 4 * n);
#pragma unroll
    for (int ai = 0; ai < 2; ++ai)
#pragma unroll
      for (int m = 0; m < 4; ++m) { bf16_t* rowp = xw + (size_t)(row0 + ai * HALF + m * 16) * 1024 + col0;
#pragma unroll
        for (int bj = 0; bj < 2; ++bj) { const f32x4 v0 = acc[ai][bj][m][0], v1 = acc[ai][bj][m][1];
          u32x4 w = *(const u32x4*)(rowp + bj * HALF);
          w.x = ::pack2(::bflo(w.x) + gv[bj][0][0] * v0[0], ::bfhi(w.x) + gv[bj][0][1] * v0[1]); w.y = ::pack2(::bflo(w.y) + gv[bj][0][2] * v0[2], ::bfhi(w.y) + gv[bj][0][3] * v0[3]);
          w.z = ::pack2(::bflo(w.z) + gv[bj][1][0] * v1[0], ::bfhi(w.z) + gv[bj][1][1] * v1[1]); w.w = ::pack2(::bflo(w.w) + gv[bj][1][2] * v1[2], ::bfhi(w.w) + gv[bj][1][3] * v1[3]);
          *(u32x4*)(rowp + bj * HALF) = w; } }
  }
};
struct EpiTopk {
  static constexpr bool PERM = false, AFTER_DRAIN = true;
  unsigned* topk;
  __device__ __forceinline__ void operator()(const f32x4 (&)[2][2][4][2], const Unit&, int, int, int, int) const {}
  __device__ __forceinline__ void fused(const f32x4 (&acc)[2][2][4][2], const Unit& u, int wr, int wc, int fr, int fq, PG8_LAS unsigned char* lds, int wid, int lane) const {
    PG8_LAS float* st = (PG8_LAS float*)lds;
    const int tid = wid * 64 + lane;
#pragma unroll 1
    for (int bj = 0; bj < 2; ++bj) {
#pragma unroll
      for (int ai = 0; ai < 2; ++ai)
#pragma unroll
        for (int m = 0; m < 4; ++m)
#pragma unroll
          for (int n = 0; n < 2; ++n) {
            PG8_LAS float* q = st + (ai * HALF + wr * 64 + m * 16 + fr) * 129 + wc * 32 + n * 16 + 4 * fq;
            const f32x4 v = bj == 0 ? acc[ai][0][m][n] : acc[ai][1][m][n];
            q[0] = v[0]; q[1] = v[1]; q[2] = v[2]; q[3] = v[3];
          }
      asm volatile("s_waitcnt lgkmcnt(0)" ::: "memory"); __builtin_amdgcn_s_barrier(); asm volatile("" ::: "memory");
      if (tid < 256) {
        float t16[16];
#pragma unroll
        for (int i = 0; i < 16; ++i) t16[i] = __uint_as_float(0xff800000u);
        for (int kk = 0; kk < 128; ++kk) {
          const float sv = st[tid * 129 + kk];
          const float x = __uint_as_float((__float_as_uint(sv) & ~0x7fu) | (unsigned)(127 - kk));
#pragma unroll
          for (int i = 15; i >= 1; --i) t16[i] = __builtin_amdgcn_fmed3f(x, t16[i - 1], t16[i]);
          t16[0] = fmaxf(t16[0], x);
        }
        unsigned* tk = topk + ((size_t)(u.pm * BM + tid) * 16 + (u.pn * 2 + bj)) * 16;
#pragma unroll
        for (int q = 0; q < 4; ++q) {
          u32x4 o; o.x = __float_as_uint(t16[q * 4]); o.y = __float_as_uint(t16[q * 4 + 1]); o.z = __float_as_uint(t16[q * 4 + 2]); o.w = __float_as_uint(t16[q * 4 + 3]);
          *(u32x4*)(tk + q * 4) = o;
        }
      }
      asm volatile("s_waitcnt lgkmcnt(0)" ::: "memory"); __builtin_amdgcn_s_barrier(); asm volatile("" ::: "memory");
    }
  }
};
struct EpiZI8 {
  static constexpr bool PERM = true, AFTER_DRAIN = false;
  bf16_t* O; int ldc; const float* rsc; const float* csc;
  __device__ __forceinline__ void operator()(const i32x4 (&acc)[2][2][4][2], const Unit& u, int wr, int wc, int fr, int fq) const {
    const int row0 = u.pm * BM + wr * 64 + fr, col0 = u.pn * BM + wc * 32 + 8 * fq;
    f32x4 cs[2][2];
#pragma unroll
    for (int bj = 0; bj < 2; ++bj)
#pragma unroll
      for (int n = 0; n < 2; ++n) cs[bj][n] = *(const f32x4*)(csc + col0 + bj * HALF + 4 * n);
#pragma unroll
    for (int ai = 0; ai < 2; ++ai)
#pragma unroll
      for (int m = 0; m < 4; ++m) { const int row = row0 + ai * HALF + m * 16; const float rs = rsc[row]; bf16_t* rowp = O + (size_t)row * ldc + col0;
#pragma unroll
        for (int bj = 0; bj < 2; ++bj) { const i32x4 a0 = acc[ai][bj][m][0], a1 = acc[ai][bj][m][1];
          u32x4 w;
          w.x = ::pack2((float)a0[0] * rs * cs[bj][0][0], (float)a0[1] * rs * cs[bj][0][1]); w.y = ::pack2((float)a0[2] * rs * cs[bj][0][2], (float)a0[3] * rs * cs[bj][0][3]);
          w.z = ::pack2((float)a1[0] * rs * cs[bj][1][0], (float)a1[1] * rs * cs[bj][1][1]); w.w = ::pack2((float)a1[2] * rs * cs[bj][1][2], (float)a1[3] * rs * cs[bj][1][3]);
          *(u32x4*)(rowp + bj * HALF) = w; } }
  }
};
struct EpiTopkI8 {
  static constexpr bool PERM = false, AFTER_DRAIN = true;
  unsigned* topk; const float* rsc; const float* csc;
  __device__ __forceinline__ void operator()(const i32x4 (&)[2][2][4][2], const Unit&, int, int, int, int) const {}
  __device__ __forceinline__ void fused(const i32x4 (&acc)[2][2][4][2], const Unit& u, int wr, int wc, int fr, int fq, PG8_LAS unsigned char* lds, int wid, int lane) const {
    PG8_LAS float* st = (PG8_LAS float*)lds;
    const int tid = wid * 64 + lane;
    float rs[2][4];
#pragma unroll
    for (int ai = 0; ai < 2; ++ai)
#pragma unroll
      for (int m = 0; m < 4; ++m) rs[ai][m] = rsc[u.pm * BM + ai * HALF + wr * 64 + m * 16 + fr];
#pragma unroll 1
    for (int bj = 0; bj < 2; ++bj) {
      f32x4 cs[2];
#pragma unroll
      for (int n = 0; n < 2; ++n) cs[n] = *(const f32x4*)(csc + u.pn * BM + bj * HALF + wc * 32 + n * 16 + 4 * fq);
#pragma unroll
      for (int ai = 0; ai < 2; ++ai)
#pragma unroll
        for (int m = 0; m < 4; ++m)
#pragma unroll
          for (int n = 0; n < 2; ++n) {
            PG8_LAS float* q = st + (ai * HALF + wr * 64 + m * 16 + fr) * 129 + wc * 32 + n * 16 + 4 * fq;
            const i32x4 v = bj == 0 ? acc[ai][0][m][n] : acc[ai][1][m][n];
            q[0] = (float)v[0] * rs[ai][m] * cs[n][0]; q[1] = (float)v[1] * rs[ai][m] * cs[n][1]; q[2] = (float)v[2] * rs[ai][m] * cs[n][2]; q[3] = (float)v[3] * rs[ai][m] * cs[n][3];
          }
      asm volatile("s_waitcnt lgkmcnt(0)" ::: "memory"); __builtin_amdgcn_s_barrier(); asm volatile("" ::: "memory");
      if (tid < 256) {
        float t16[16];
#pragma unroll
        for (int i = 0; i < 16; ++i) t16[i] = __uint_as_float(0xff800000u);
        for (int kk = 0; kk < 128; ++kk) {
          const float sv = st[tid * 129 + kk];
          const float x = __uint_as_float((__float_as_uint(sv) & ~0x7fu) | (unsigned)(127 - kk));
#pragma unroll
          for (int i = 15; i >= 1; --i) t16[i] = __builtin_amdgcn_fmed3f(x, t16[i - 1], t16[i]);
          t16[0] = fmaxf(t16[0], x);
        }
        unsigned* tk = topk + ((size_t)(u.pm * BM + tid) * 16 + (u.pn * 2 + bj)) * 16;
#pragma unroll
        for (int q = 0; q < 4; ++q) {
          u32x4 o; o.x = __float_as_uint(t16[q * 4]); o.y = __float_as_uint(t16[q * 4 + 1]); o.z = __float_as_uint(t16[q * 4 + 2]); o.w = __float_as_uint(t16[q * 4 + 3]);
          *(u32x4*)(tk + q * 4) = o;
        }
      }
      asm volatile("s_waitcnt lgkmcnt(0)" ::: "memory"); __builtin_amdgcn_s_barrier(); asm volatile("" ::: "memory");
    }
  }
};
}

enum { G8_Z = 0, G8_RES = 1, G8_TOPK = 2 };
template <int EPI>
DI void gemm8_phase(KP p, unsigned char* smem, const u16* A, const u16* Bt, int N, int K, int l, int bid, int nb, int m_tiles_active, int tid) {
  pg8::Gemm g{A, Bt, m_tiles_active * 256, N, K};
  const int nN = N / 256, nunits = m_tiles_active * nN;
  PG8_LAS unsigned char* lds = (PG8_LAS unsigned char*)smem;
  if constexpr (EPI == G8_Z) {
    pg8::LinOrder S{nN, nunits, nb, bid};
    pg8::Gemm g8{(const pg8::bf16_t*)(p.ws + WS_HXQ), (const pg8::bf16_t*)(p.ws + WS_WINQ + (size_t)l * 4096 * 1024), m_tiles_active * 256, N, K};
    pg8::EpiZI8 E{(pg8::bf16_t*)(p.ws + WS_Z), N, (const float*)(p.ws + WS_HXS), (const float*)(p.ws + WS_WINS) + (size_t)l * 4096};
    pg8::gemm_phase_i8<pg8::EpiZI8, pg8::LinOrder>(lds, g8, S, E, tid);
  } else if constexpr (EPI == G8_RES) {
    pg8::LinOrder S{nN, nunits, nb, bid};
    pg8::EpiRes E{(pg8::bf16_t*)(p.ws + WS_XW), (const float*)(p.ws + WS_MOD) + (size_t)l * 5 * 6144};
    pg8::gemm_phase<pg8::EpiRes, pg8::LinOrder>(lds, g, S, E, tid);
  } else {
    pg8::Gemm g8{(const pg8::bf16_t*)(p.ws + WS_HXQ), (const pg8::bf16_t*)(p.ws + WS_WSQ + (size_t)l * 2048 * 1024), m_tiles_active * 256, N, K};
    pg8::EpiTopkI8 E{(unsigned*)(p.ws + WS_TOPK), (const float*)(p.ws + WS_HXS), (const float*)(p.ws + WS_WSS) + (size_t)l * 2048};
#pragma unroll 1
    for (int L = bid; L < nunits; L += nb) {
      pg8::OneUnit S{pg8::Unit{L / nN, L % nN}};
      pg8::gemm_phase_i8<pg8::EpiTopkI8, pg8::OneUnit>(lds, g8, S, E, tid);
    }
  }
  __syncthreads();
  if constexpr (EPI == G8_RES || EPI == G8_TOPK) {
    const int rem = nunits % nb;
    if (l + 1 < DEPTH && rem != 0 && bid >= rem) {
      const float* src = (EPI == G8_RES ? p.peer_u : p.peer_v);
      unsigned char* dst = p.ws + (EPI == G8_RES ? WS_UB : WS_VB);
      float* scl = (float*)(p.ws + (EPI == G8_RES ? WS_US : WS_VS));
#pragma unroll 1
      for (int it = bid - rem; it < 256; it += nb - rem) p0_quant_rows(src, dst, scl, (l + 1) * NEXP + it * 64, tid, 0.f);
    }
  }
}

constexpr float LOG2E = 1.4426950408889634f;
DI int seg_row0(int b, int j) { return j < 2 ? NLAT + b * CTXL + 128 * j : b * SEQ + 128 * (j - 2); }
DI int pi_bwd(int j) { return j < 2 ? 1 - j : 35 - j; }
DI float ex2(float x) { return __builtin_amdgcn_exp2f(x); }
DI unsigned sw32(int row, int col) { return (unsigned)(row * 64 + ((((col >> 3) ^ ((row >> 2) & 3))) << 4) + (col & 7) * 2); }
DI bf16x8 pack8(float a0, float a1, float a2, float a3, float a4, float a5, float a6, float a7) {
  u32x4 p; p[0] = pack2(a0, a1); p[1] = pack2(a2, a3); p[2] = pack2(a4, a5); p[3] = pack2(a6, a7);
  return __builtin_bit_cast(bf16x8, p);
}
DI bf16x8 cat8(u32x2 lo, u32x2 hi) { u32x4 p; p[0] = lo[0]; p[1] = lo[1]; p[2] = hi[0]; p[3] = hi[1]; return __builtin_bit_cast(bf16x8, p); }

DI void rec_pass1(KP p, unsigned char* smem, int l, int item, int tid) {
  const int j = item % 34, bh = item / 34, b = bh >> 2, hd = bh & 3;
  const int R0 = seg_row0(b, j);
  const int lane = tid & 63, wave = tid >> 6, r = lane & 31, h = lane >> 5;
  unsigned char* KOT = smem;
  unsigned char* VT = smem + 65536;
  float* TX = (float*)(smem + 98304);
  const u16* Z = (const u16*)(p.ws + WS_Z);
  const int k = tid & 127, qd = tid >> 7;
  unsigned char* STG = smem + 100352;
  u32x4 pre[4];
  auto gstage = [&](int colbase) {
#pragma unroll
    for (int u = 0; u < 4; ++u) { const int q = tid + NTHR * u; pre[u] = *(const u32x4*)(Z + (size_t)(R0 + (q >> 4)) * INC + colbase + (q & 15) * 8); }
  };
  auto wstage = [&]() {
#pragma unroll
    for (int u = 0; u < 4; ++u) { const int q = tid + NTHR * u; *(u32x4*)(STG + q * 16) = pre[u]; }
  };
  gstage(hd * 128);
  wstage();
  __syncthreads();
  gstage(512 + hd * 128);
  {
    u16 vv[32];
#pragma unroll
    for (int ii = 0; ii < 32; ++ii) vv[ii] = *(const u16*)(STG + (32 * qd + ii) * 256 + k * 2);
#pragma unroll
    for (int c4 = 0; c4 < 4; ++c4) {
      u32x4 o;
#pragma unroll
      for (int e = 0; e < 4; ++e) o[e] = (unsigned)vv[c4 * 8 + 2 * e] | ((unsigned)vv[c4 * 8 + 2 * e + 1] << 16);
      *(u32x4*)(VT + sw128(k, 32 * qd + 8 * c4)) = o;
    }
  }
  __syncthreads();
#pragma unroll 1
  for (int d = 0; d < 2; ++d) {
    wstage();
    __syncthreads();
    if (d == 0) gstage(1024 + hd * 128);
    const float lb = ((const float*)(p.ws + WS_LOWER))[((size_t)l * 2 + d) * 512 + hd * 128 + k];
    float lf[32], kk[32];
    float tot = 0.f;
#pragma unroll
    for (int ii = 0; ii < 32; ++ii) {
      const float z = bf2f(*(const u16*)(STG + (32 * qd + ii) * 256 + k * 2));
      const float sg = __builtin_amdgcn_rcpf(1.f + ex2(-z * LOG2E));
      const float f = fmaxf(lb + (1.f - lb) * sg, 1e-20f);
      lf[ii] = __builtin_amdgcn_logf(f);
      kk[ii] = (1.f - lb) * (1.f - sg);
      tot += lf[ii];
    }
    TX[qd * 128 + k] = tot;
    __syncthreads();
    const float t0 = TX[k], t1 = TX[128 + k], t2 = TX[256 + k], t3 = TX[384 + k];
    float run;
    if (d == 0) run = (qd == 0 ? t1 + t2 + t3 : qd == 1 ? t2 + t3 : qd == 2 ? t3 : 0.f);
    else run = (qd == 0 ? 0.f : qd == 1 ? t0 : qd == 2 ? t0 + t1 : t0 + t1 + t2);
    float ko[32];
    if (d == 0) {
#pragma unroll
      for (int ii = 31; ii >= 0; --ii) { ko[ii] = kk[ii] * ex2(run); run += lf[ii]; }
    } else {
#pragma unroll
      for (int ii = 0; ii < 32; ++ii) { ko[ii] = kk[ii] * ex2(run); run += lf[ii]; }
    }
#pragma unroll
    for (int c4 = 0; c4 < 4; ++c4) {
      u32x4 o;
#pragma unroll
      for (int e = 0; e < 4; ++e) o[e] = pack2(ko[c4 * 8 + 2 * e], ko[c4 * 8 + 2 * e + 1]);
      *(u32x4*)(KOT + d * 32768 + sw128(k, 32 * qd + 8 * c4)) = o;
    }
    if (qd == 0) {
      const int pi = d ? pi_bwd(j) : j;
      ((float*)(p.ws + WS_DT))[((size_t)(bh * 2 + d) * 34 + pi) * 128 + k] = ex2(t0 + t1 + t2 + t3);
    }
    __syncthreads();
  }
  {
    const int d = wave >> 2, w4 = wave & 3;
    f32x16 acc[4];
#pragma unroll
    for (int mt = 0; mt < 4; ++mt)
#pragma unroll
      for (int e = 0; e < 16; ++e) acc[mt][e] = 0.f;
#pragma unroll
    for (int ks = 0; ks < 8; ++ks) {
      const bf16x8 bv = *(const bf16x8*)(VT + sw128(32 * w4 + r, 16 * ks + 8 * h));
#pragma unroll
      for (int mt = 0; mt < 4; ++mt) {
        const bf16x8 av = *(const bf16x8*)(KOT + d * 32768 + sw128(32 * mt + r, 16 * ks + 8 * h));
        acc[mt] = __builtin_amdgcn_mfma_f32_32x32x16_bf16(av, bv, acc[mt], 0, 0, 0);
      }
    }
    const int pi = d ? pi_bwd(j) : j;
    u16* sl = (u16*)(p.ws + WS_SLOC) + ((size_t)(bh * 2 + d) * 34 + pi) * 16384;
#pragma unroll
    for (int mt = 0; mt < 4; ++mt)
#pragma unroll
      for (int g = 0; g < 4; ++g) {
        u32x2 o; o[0] = pack2(acc[mt][4 * g], acc[mt][4 * g + 1]); o[1] = pack2(acc[mt][4 * g + 2], acc[mt][4 * g + 3]);
        *(u32x2*)(sl + ((((w4 * 4 + mt) * 4 + g) * 64 + lane) * 4)) = o;
      }
  }
  __syncthreads();
}

DI void rec_pass2(KP p, int bid, int nb, int tid) {
  const u16* SL = (const u16*)(p.ws + WS_SLOC);
  u16* SS = (u16*)(p.ws + WS_SST);
  const float* DT = (const float*)(p.ws + WS_DT);
  for (int gid = bid * NTHR + tid; gid < 32 * 4096; gid += nb * NTHR) {
    const int seq = gid >> 12, grp = gid & 4095;
    const int lane = grp & 63, g = (grp >> 6) & 3, mt = (grp >> 8) & 3;
    const int k0 = 32 * mt + 8 * g + 4 * (lane >> 5);
    const u16* sl = SL + (size_t)seq * 34 * 16384 + grp * 4;
    u16* ss = SS + (size_t)seq * 34 * 16384 + grp * 4;
    const float* dt = DT + (size_t)seq * 34 * 128 + k0;
    float s0 = 0.f, s1 = 0.f, s2 = 0.f, s3 = 0.f;
#pragma unroll 3
    for (int pi = 0; pi < 33; ++pi) {
      const u32x2 w = *(const u32x2*)(sl + (size_t)pi * 16384);
      const float4 dd = *(const float4*)(dt + pi * 128);
      s0 = dd.x * s0 + bflo(w[0]); s1 = dd.y * s1 + bfhi(w[0]); s2 = dd.z * s2 + bflo(w[1]); s3 = dd.w * s3 + bfhi(w[1]);
      u32x2 o; o[0] = pack2(s0, s1); o[1] = pack2(s2, s3);
      *(u32x2*)(ss + (size_t)(pi + 1) * 16384) = o;
    }
  }
}

DI void rec_pass3(KP p, unsigned char* smem, int l, int item, int tid) {
  const int j = item % 34, bh = item / 34, b = bh >> 2, hd = bh & 3;
  const int R0 = seg_row0(b, j);
  const int lane = tid & 63, wave = tid >> 6, r = lane & 31, h = lane >> 5;
  const int d = tid >> 8, tt = tid & 255, w4 = wave & 3;
  unsigned char* base = smem + d * 67584;
  unsigned char* SZ = base, *SQ = base + 8192, *SV = base + 16384;
  unsigned char* QT = base + 24576, *KT = base + 32768, *QI = base + 40960, *KOT = base + 49152, *VT = base + 57344;
  float* DTc = (float*)(base + 65536);
  float* TX = (float*)(base + 66048);
  const u16* Z = (const u16*)(p.ws + WS_Z);
  u16* O = (u16*)(p.ws + (d ? WS_OB : WS_OF));
  const int pi = d ? pi_bwd(j) : j;
  f32x16 S[4];
  if (pi == 0) {
#pragma unroll
    for (int mt = 0; mt < 4; ++mt)
#pragma unroll
      for (int e = 0; e < 16; ++e) S[mt][e] = 0.f;
  } else {
    const u16* ss = (const u16*)(p.ws + WS_SST) + ((size_t)(bh * 2 + d) * 34 + pi) * 16384;
#pragma unroll
    for (int mt = 0; mt < 4; ++mt)
#pragma unroll
      for (int g = 0; g < 4; ++g) {
        const u32x2 w = *(const u32x2*)(ss + ((((w4 * 4 + mt) * 4 + g) * 64 + lane) * 4));
        S[mt][4 * g] = bflo(w[0]); S[mt][4 * g + 1] = bfhi(w[0]); S[mt][4 * g + 2] = bflo(w[1]); S[mt][4 * g + 3] = bfhi(w[1]);
      }
  }
  const int k = tt & 127, half = tt >> 7;
  const float lb = ((const float*)(p.ws + WS_LOWER))[((size_t)l * 2 + d) * 512 + hd * 128 + k];
  const int zg_col = (d ? 1024 : 512) + hd * 128, q_col = 1536 + hd * 128, v_col = hd * 128;
  u32x4 pz[2], pq[2], pv[2];
  auto gl = [&](int c) {
#pragma unroll
    for (int u = 0; u < 2; ++u) {
      const int q = tt + 256 * u, i = q >> 4, c16 = q & 15;
      const int n = d ? (127 - 32 * c - i) : (32 * c + i);
      const u16* zr = Z + (size_t)(R0 + n) * INC + c16 * 8;
      pz[u] = *(const u32x4*)(zr + zg_col); pq[u] = *(const u32x4*)(zr + q_col); pv[u] = *(const u32x4*)(zr + v_col);
    }
  };
  gl(0);
#pragma unroll 1
  for (int c = 0; c < 4; ++c) {
#pragma unroll
    for (int u = 0; u < 2; ++u) {
      const int q = tt + 256 * u;
      *(u32x4*)(SZ + q * 16) = pz[u]; *(u32x4*)(SQ + q * 16) = pq[u]; *(u32x4*)(SV + q * 16) = pv[u];
    }
    __syncthreads();
    if (c + 1 < 4) gl(c + 1);
    {
      float cc = 0.f;
#pragma unroll
      for (int ii = 0; ii < 16; ++ii) {
        const int i = 16 * half + ii;
        const float z = bf2f(*(const u16*)(SZ + i * 256 + k * 2));
        const float sg = __builtin_amdgcn_rcpf(1.f + ex2(-z * LOG2E));
        const float f = fmaxf(lb + (1.f - lb) * sg, 1e-20f);
        cc += __builtin_amdgcn_logf(f);
      }
      TX[half * 128 + k] = cc;
    }
    __syncthreads();
    {
      const float T0 = TX[k], T1 = TX[128 + k];
      const float e0 = ex2(T0), e1 = ex2(T1);
      float ko[16];
      float cc = 0.f;
#pragma unroll
      for (int ii = 0; ii < 16; ++ii) {
        const int i = 16 * half + ii;
        const float z = bf2f(*(const u16*)(SZ + i * 256 + k * 2));
        const float sg = __builtin_amdgcn_rcpf(1.f + ex2(-z * LOG2E));
        const float f = fmaxf(lb + (1.f - lb) * sg, 1e-20f);
        cc += __builtin_amdgcn_logf(f);
        const float kk = (1.f - lb) * (1.f - sg);
        const float qq = bf2f(*(const u16*)(SQ + i * 256 + k * 2));
        float qt, qi, kt;
        if (half == 0) {
          qt = qq * ex2(fminf(cc - T0, 120.f)); qi = qq * ex2(cc);
          kt = kk * ex2(T0 - cc); ko[ii] = kt * e1;
        } else {
          qt = qq * ex2(cc); qi = qt * e0;
          kt = kk * ex2(fminf(-cc, 120.f)); ko[ii] = kk * ex2(T1 - cc);
        }
        *(u16*)(QT + sw128(i, k)) = f2bf(qt); *(u16*)(KT + sw128(i, k)) = f2bf(kt); *(u16*)(QI + sw128(i, k)) = f2bf(qi);
      }
      if (half == 0) DTc[k] = e0 * e1;
      u32x4 o0, o1;
#pragma unroll
      for (int e = 0; e < 4; ++e) { o0[e] = pack2(ko[2 * e], ko[2 * e + 1]); o1[e] = pack2(ko[8 + 2 * e], ko[8 + 2 * e + 1]); }
      *(u32x4*)(KOT + sw32(k, 16 * half)) = o0; *(u32x4*)(KOT + sw32(k, 16 * half + 8)) = o1;
      u32x4 v0, v1;
#pragma unroll
      for (int e = 0; e < 4; ++e) {
        v0[e] = (unsigned)*(const u16*)(SV + (16 * half + 2 * e) * 256 + k * 2) | ((unsigned)*(const u16*)(SV + (16 * half + 2 * e + 1) * 256 + k * 2) << 16);
        v1[e] = (unsigned)*(const u16*)(SV + (16 * half + 8 + 2 * e) * 256 + k * 2) | ((unsigned)*(const u16*)(SV + (16 * half + 8 + 2 * e + 1) * 256 + k * 2) << 16);
      }
      *(u32x4*)(VT + sw32(k, 16 * half)) = v0; *(u32x4*)(VT + sw32(k, 16 * half + 8)) = v1;
    }
    __syncthreads();
    {
      f32x16 X;
#pragma unroll
      for (int e = 0; e < 16; ++e) X[e] = 0.f;
#pragma unroll 2
      for (int ks = 0; ks < 8; ++ks) {
        const bf16x8 a = *(const bf16x8*)(KT + sw128(r, 16 * ks + 8 * h));
        const bf16x8 bq = *(const bf16x8*)(QT + sw128(r, 16 * ks + 8 * h));
        X = __builtin_amdgcn_mfma_f32_32x32x16_bf16(a, bq, X, 0, 0, 0);
      }
#pragma unroll
      for (int e = 0; e < 16; ++e) { const int sidx = (e & 3) + 8 * (e >> 2) + 4 * h; if (sidx > r) X[e] = 0.f; }
      f32x16 o;
#pragma unroll
      for (int e = 0; e < 16; ++e) o[e] = 0.f;
#pragma unroll
      for (int s2 = 0; s2 < 2; ++s2) {
        const bf16x8 xa = pack8(X[8 * s2], X[8 * s2 + 1], X[8 * s2 + 2], X[8 * s2 + 3], X[8 * s2 + 4], X[8 * s2 + 5], X[8 * s2 + 6], X[8 * s2 + 7]);
        const u32x2 lo = *(const u32x2*)(VT + sw32(32 * w4 + r, 16 * s2 + 4 * h));
        const u32x2 hi = *(const u32x2*)(VT + sw32(32 * w4 + r, 16 * s2 + 8 + 4 * h));
        o = __builtin_amdgcn_mfma_f32_32x32x16_bf16(xa, cat8(lo, hi), o, 0, 0, 0);
      }
#pragma unroll
      for (int mt = 0; mt < 4; ++mt)
#pragma unroll
        for (int s2 = 0; s2 < 2; ++s2) {
          const bf16x8 sb = pack8(S[mt][8 * s2], S[mt][8 * s2 + 1], S[mt][8 * s2 + 2], S[mt][8 * s2 + 3], S[mt][8 * s2 + 4], S[mt][8 * s2 + 5], S[mt][8 * s2 + 6], S[mt][8 * s2 + 7]);
          const u32x2 lo = *(const u32x2*)(QI + sw128(r, 32 * mt + 16 * s2 + 4 * h));
          const u32x2 hi = *(const u32x2*)(QI + sw128(r, 32 * mt + 16 * s2 + 8 + 4 * h));
          o = __builtin_amdgcn_mfma_f32_32x32x16_bf16(cat8(lo, hi), sb, o, 0, 0, 0);
          if (s2 == 1) __builtin_amdgcn_sched_barrier(0);
        }
#pragma unroll
      for (int mt = 0; mt < 4; ++mt)
#pragma unroll
        for (int g = 0; g < 4; ++g) {
          const float4 dd = *(const float4*)(DTc + 32 * mt + 8 * g + 4 * h);
          S[mt][4 * g] *= dd.x; S[mt][4 * g + 1] *= dd.y; S[mt][4 * g + 2] *= dd.z; S[mt][4 * g + 3] *= dd.w;
        }
#pragma unroll
      for (int s2 = 0; s2 < 2; ++s2) {
        const bf16x8 bv = *(const bf16x8*)(VT + sw32(32 * w4 + r, 16 * s2 + 8 * h));
#pragma unroll
        for (int mt = 0; mt < 4; ++mt) {
          const bf16x8 av = *(const bf16x8*)(KOT + sw32(32 * mt + r, 16 * s2 + 8 * h));
          S[mt] = __builtin_amdgcn_mfma_f32_32x32x16_bf16(av, bv, S[mt], 0, 0, 0);
        }
      }
#pragma unroll
      for (int e = 0; e < 16; ++e) {
        const int i = (e & 3) + 8 * (e >> 2) + 4 * h;
        const int n = d ? (127 - 32 * c - i) : (32 * c + i);
        O[(size_t)(R0 + n) * 512 + hd * 128 + 32 * w4 + r] = f2bf(o[e]);
      }
    }
  }
  __syncthreads();
}

DI void conv_rows8(KP p, int l, int row0, int tid) {
  const int lane = tid & 63, row = row0 + (tid >> 6);
  const int ch = lane * 8;
  const u16* Z = (const u16*)(p.ws + WS_Z);
  u16* cat = (u16*)(p.ws + WS_CAT);
  const float* cw = p.conv_w + (size_t)l * 3 * 512 + ch;
  int rm, rp; bool hm, hp_;
  if (row < NLAT) {
    const int t = row & 4095, gr = t >> 6, gc = t & 63;
    if (ch < 256) { hm = gc > 0; hp_ = gc < 63; rm = row - 1; rp = row + 1; }
    else { hm = gr > 0; hp_ = gr < 63; rm = row - 64; rp = row + 64; }
  } else {
    const int t = (row - NLAT) & 255;
    hm = t > 0; hp_ = t < 255; rm = row - 1; rp = row + 1;
  }
  if (!hm) rm = row;
  if (!hp_) rp = row;
  const u32x4 c0 = *(const u32x4*)(Z + (size_t)row * INC + 2560 + ch), h0 = *(const u32x4*)(Z + (size_t)row * INC + 3584 + ch);
  const u32x4 cm = *(const u32x4*)(Z + (size_t)rm * INC + 2560 + ch), hmv = *(const u32x4*)(Z + (size_t)rm * INC + 3584 + ch);
  const u32x4 cp = *(const u32x4*)(Z + (size_t)rp * INC + 2560 + ch), hpv = *(const u32x4*)(Z + (size_t)rp * INC + 3584 + ch);
  const u32x4 bgv = *(const u32x4*)(Z + (size_t)row * INC + 3072 + ch);
  const float4 w0a = *(const float4*)cw, w0b = *(const float4*)(cw + 4);
  const float4 w1a = *(const float4*)(cw + 512), w1b = *(const float4*)(cw + 516);
  const float4 w2a = *(const float4*)(cw + 1024), w2b = *(const float4*)(cw + 1028);
  const float w0[8] = {w0a.x, w0a.y, w0a.z, w0a.w, w0b.x, w0b.y, w0b.z, w0b.w};
  const float w1[8] = {w1a.x, w1a.y, w1a.z, w1a.w, w1b.x, w1b.y, w1b.z, w1b.w};
  const float w2[8] = {w2a.x, w2a.y, w2a.z, w2a.w, w2b.x, w2b.y, w2b.z, w2b.w};
  const float fm = hm ? 1.f : 0.f, fp = hp_ ? 1.f : 0.f;
  u32x4 o;
#pragma unroll
  for (int e = 0; e < 4; ++e) {
    float r2[2];
#pragma unroll
    for (int hh = 0; hh < 2; ++hh) {
      const float uc = (hh ? bfhi(c0[e]) : bflo(c0[e])) * (hh ? bfhi(h0[e]) : bflo(h0[e]));
      const float um = (hh ? bfhi(cm[e]) : bflo(cm[e])) * (hh ? bfhi(hmv[e]) : bflo(hmv[e]));
      const float up = (hh ? bfhi(cp[e]) : bflo(cp[e])) * (hh ? bfhi(hpv[e]) : bflo(hpv[e]));
      const float bg = hh ? bfhi(bgv[e]) : bflo(bgv[e]);
      r2[hh] = bg * (w1[2 * e + hh] * uc + fm * w0[2 * e + hh] * um + fp * w2[2 * e + hh] * up);
    }
    o[e] = pack2(r2[0], r2[1]);
  }
  *(u32x4*)(cat + (size_t)row * D + 512 + ch) = o;
}

DI void phase_rec1(KP p, unsigned char* smem, int l, int bid, int nb, int tid) {
  const int nitems = 544 + NTOK / 8;
  for (int it = bid; it < nitems; it += nb) {
    if (it < 544) rec_pass1(p, smem, l, it, tid);
    else conv_rows8(p, l, (it - 544) * 8, tid);
  }
}
DI void phase_rec3(KP p, unsigned char* smem, int l, int bid, int nb, int tid) {
  for (int it = bid; it < 544; it += nb) {
    if (l == DEPTH - 1 && (it % 34) < 2) continue;
    rec_pass3(p, smem, l, it, tid);
  }
}

DI void phase_recpost(KP p, int l, int bid, int nb, int tid) {
  const int lane = tid & 63, wave = tid >> 6;
  const u16* OF = (const u16*)(p.ws + WS_OF);
  const u16* OB = (const u16*)(p.ws + WS_OB);
  const u16* Z = (const u16*)(p.ws + WS_Z);
  u16* cat = (u16*)(p.ws + WS_CAT);
  for (int row = bid * 8 + wave; row < NTOK; row += nb * 8) {
    const u32x4 af = *(const u32x4*)(OF + (size_t)row * 512 + lane * 8), ab = *(const u32x4*)(OB + (size_t)row * 512 + lane * 8);
    float o[8];
#pragma unroll
    for (int e = 0; e < 4; ++e) { o[2 * e] = bflo(af[e]) + bflo(ab[e]); o[2 * e + 1] = bfhi(af[e]) + bfhi(ab[e]); }
    float ss = 0.f;
#pragma unroll
    for (int e = 0; e < 8; ++e) ss += o[e] * o[e];
    ss += __shfl_xor(ss, 1); ss += __shfl_xor(ss, 2); ss += __shfl_xor(ss, 4); ss += __shfl_xor(ss, 8);
    const float rs = rsqrtf(ss * (1.f / 128.f) + EPS);
    const u32x4 gw = *(const u32x4*)(Z + (size_t)row * INC + 2048 + lane * 8);
    u32x4 ow;
#pragma unroll
    for (int e = 0; e < 4; ++e) {
      const float g0 = bflo(gw[e]), g1 = bfhi(gw[e]);
      ow[e] = pack2(o[2 * e] * rs * siluf_(g0), o[2 * e + 1] * rs * siluf_(g1));
    }
    *(u32x4*)(cat + (size_t)row * D + lane * 8) = ow;
  }
}

DI float gelu_erf(float x) { return 0.5f * x * (1.f + erff(x * 0.70710678118654752f)); }

using i32x4 = __attribute__((ext_vector_type(4))) int;
constexpr int PM_CF = 0, PM_WG = 32768, PM_HQ = 65536, PM_CM = 65536, PM_IB = 65536, PM_MISC = 133120;
DI unsigned pm_perm(unsigned hi, unsigned lo, unsigned sel) { return __builtin_amdgcn_perm(hi, lo, sel); }

DI void peer_mfma_pass(KP p, unsigned char* smem, int l, int row0, int ntok, int tid) {
  const int lane = tid & 63, wave = __builtin_amdgcn_readfirstlane(tid >> 6);
  const int ngroups = (ntok + 15) >> 4;
  const int nwg = ngroups >= 4 ? 2 : 8;
  const int tg = ngroups >= 4 ? (wave >> 1) : 0, ch = ngroups >= 4 ? (wave & 1) : wave;
  float* CF = (float*)(smem + PM_CF);
  unsigned* WG = (unsigned*)(smem + PM_WG);
  unsigned char* HQ = smem + PM_HQ;
  unsigned short* CM = (unsigned short*)(smem + PM_CM);
  unsigned* CNT = (unsigned*)(smem + PM_MISC);
  float* HS = (float*)(smem + PM_MISC) + 128;
  unsigned* CMAX = (unsigned*)(smem + PM_MISC) + 192;
  float* SS = (float*)(smem + PM_MISC) + 256;
  const unsigned char* UB = p.ws + WS_UB + (size_t)l * NEXP * D;
  const unsigned char* VB = p.ws + WS_VB + (size_t)l * NEXP * D;
  const float* US = (const float*)(p.ws + WS_US) + (size_t)l * NEXP;
  const float* VS = (const float*)(p.ws + WS_VS) + (size_t)l * NEXP;
  const float* mod = (const float*)(p.ws + WS_MOD);
#ifdef PROBE_ABC
#pragma unroll 1
  for (int arep = 0; arep < 2; ++arep) {
#endif
  if (tid < 128) CNT[tid] = 0u;
  if (tid < 64) { CMAX[tid] = 0u; SS[tid] = 0.f; }
  __syncthreads();
  unsigned ent[16], slot[16];
  const bool actA = tid < ntok * 8;
  if (actA) {
    const int t = tid >> 3, head = tid & 7;
    unsigned char* IB = smem + PM_IB + tid * 32;
    const unsigned* t1 = (const unsigned*)(p.ws + WS_TOPK) + ((size_t)(row0 + t) * 16 + head * 2) * 16;
    float s1[16], s2[16];
#pragma unroll
    for (int q = 0; q < 4; ++q) {
      const u32x4 a = *(const u32x4*)(t1 + q * 4), b = *(const u32x4*)(t1 + 16 + q * 4);
#pragma unroll
      for (int e = 0; e < 4; ++e) {
        s1[q * 4 + e] = __uint_as_float(a[e]); s2[q * 4 + e] = __uint_as_float(b[e]);
        IB[q * 4 + e] = (unsigned char)(127u - (a[e] & 127u));
        IB[16 + q * 4 + e] = (unsigned char)(127u - (b[e] & 127u));
      }
    }
    float t16[16];
#pragma unroll
    for (int i = 0; i < 16; ++i) t16[i] = __uint_as_float(0xff800000u);
#pragma unroll
    for (int i = 0; i < 16; ++i)
#pragma unroll
      for (int j = 0; j < 16; ++j)
        if ((i + 1) * (j + 1) <= 16) {
          const float sm = s1[i] + s2[j];
          const float x = __uint_as_float((__float_as_uint(sm) & ~0xffu) | (unsigned)(255 - (i * 16 + j)));
#pragma unroll
          for (int q = 15; q >= 1; --q) t16[q] = __builtin_amdgcn_fmed3f(x, t16[q - 1], t16[q]);
          t16[0] = fmaxf(t16[0], x);
        }
    float den = 0.f;
#pragma unroll
    for (int i = 0; i < 16; ++i) den += __expf(t16[i] - t16[0]);
    const float inv = 16383.f / den;
    const unsigned mtag = (unsigned)(t & 15) << 14;
    unsigned* cg = CNT + (t >> 4) * 32;
#pragma unroll
    for (int i = 0; i < 16; ++i) {
      const unsigned ci = 255u - (__float_as_uint(t16[i]) & 255u);
      const unsigned i1 = IB[ci >> 4], i2 = IB[16 + (ci & 15)];
      const unsigned gq = (unsigned)(int)rintf(__expf(t16[i] - t16[0]) * inv);
      const unsigned en = ((i1 * 128u + i2) << 18) | mtag | gq;
      ent[i] = en;
      slot[i] = atomicAdd(&cg[en >> 27], 1u);
    }
  }
  __syncthreads();
  if (tid < 128) {
    const unsigned c = CNT[tid];
    unsigned inc = c;
#pragma unroll
    for (int o = 1; o < 32; o <<= 1) { const unsigned v = __shfl_up(inc, o); if ((lane & 31) >= o) inc += v; }
    CNT[tid] = inc - c;
  }
  __syncthreads();
  if (actA) {
    const int t = tid >> 3;
    unsigned* wg = WG + (t >> 4) * 2048;
    const unsigned* cg = CNT + (t >> 4) * 32;
#pragma unroll
    for (int i = 0; i < 16; ++i) wg[cg[ent[i] >> 27] + slot[i]] = ent[i];
  }
  __syncthreads();
#pragma unroll 1
  for (int i = 0; i < 8; ++i) {
    const int t = wave * 8 + i;
    if (t < ntok) {
      const u32x4 pk = *(const u32x4*)(p.ws + WS_HXQ + (size_t)(row0 + t) * D + lane * 16);
      const float sc = ((const float*)(p.ws + WS_HXS))[row0 + t];
      *(u32x4*)(HQ + t * 1024 + lane * 16) = pk;
      if (lane == 0) HS[t] = sc;
    }
  }
  __syncthreads();
#ifdef PROBE_ABC
  }
#endif
  const bool gact = tg < ngroups;
  const int nt_g = gact ? ((ntok - tg * 16) < 16 ? (ntok - tg * 16) : 16) : 0;
  const int nent = nt_g * 128;
  const unsigned* wg = WG + tg * 2048;
  float* cfg = CF + tg * 2048;
  const int mrow = lane & 15, kq = lane >> 4;
  i32x4 areg[16];
  if (gact) {
    const int tsrc = (mrow < nt_g) ? (tg * 16 + mrow) : (tg * 16);
#pragma unroll
    for (int s2 = 0; s2 < 16; ++s2) areg[s2] = *(const i32x4*)(HQ + tsrc * 1024 + 64 * s2 + 16 * kq);
  }
  __syncthreads();
#ifdef PROBE_U2
#pragma unroll 1
  for (int urep = 0; urep < 2; ++urep)
#endif
  if (gact) {
#ifdef PROBE_U2
    const unsigned uemask = urep == 0 ? PROBE_EMASK : 0xffffffffu;
#else
    const unsigned uemask = 0xffffffffu;
#endif
    unsigned char* ust = smem + PM_HQ + wave * 8320;
    const int nch = nent >> 4;
    u32x4 rr[8];
    auto gl8 = [&](int k0) {
#pragma unroll
      for (int j = 0; j < 8; ++j) {
        const unsigned en = (unsigned)__builtin_amdgcn_readfirstlane((int)wg[k0 + j]) & uemask;
        rr[j] = *(const u32x4*)(UB + (size_t)(en >> 18) * D + lane * 16);
      }
    };
    if (ch < nch) gl8(16 * ch);
#pragma unroll 1
    for (int c = ch; c < nch; c += nwg) {
      const unsigned en_cur = wg[16 * c + mrow];
      const unsigned e = en_cur >> 18;
      const float us = US[e], vs = VS[e];
      i32x4 d0 = {0, 0, 0, 0}, d1 = {0, 0, 0, 0};
#pragma unroll
      for (int j = 0; j < 8; ++j) *(u32x4*)(ust + j * 1040 + lane * 16) = rr[j];
      gl8(16 * c + 8);
#pragma unroll
      for (int s2 = 0; s2 < 16; ++s2) {
        const i32x4 b = *(const i32x4*)(ust + (mrow & 7) * 1040 + 64 * s2 + 16 * kq);
        d0 = __builtin_amdgcn_mfma_i32_16x16x64_i8(areg[s2], b, d0, 0, 0, 0);
        if ((s2 & 3) == 3) __builtin_amdgcn_sched_barrier(0);
      }
#pragma unroll
      for (int j = 0; j < 8; ++j) *(u32x4*)(ust + j * 1040 + lane * 16) = rr[j];
      if (c + nwg < nch) gl8(16 * (c + nwg));
#pragma unroll
      for (int s2 = 0; s2 < 16; ++s2) {
        const i32x4 b = *(const i32x4*)(ust + (mrow & 7) * 1040 + 64 * s2 + 16 * kq);
        d1 = __builtin_amdgcn_mfma_i32_16x16x64_i8(areg[s2], b, d1, 0, 0, 0);
        if ((s2 & 3) == 3) __builtin_amdgcn_sched_barrier(0);
      }
      const int mp = (int)((en_cur >> 14) & 15u);
      if ((mp >> 2) == kq) {
        const int r = mp & 3;
        const i32x4 dd = mrow < 8 ? d0 : d1;
        const int dv = r == 0 ? dd[0] : r == 1 ? dd[1] : r == 2 ? dd[2] : dd[3];
        const float dot = us * HS[tg * 16 + mp] * (float)dv;
        const float cf = (float)(en_cur & 0x3fffu) * (1.f / 16383.f) * gelu_erf(dot) * vs;
        cfg[16 * c + mrow] = cf;
        atomicMax(&CMAX[tg * 16 + mp], __float_as_uint(fabsf(cf)));
      }
    }
  }
  __syncthreads();
  for (int k = tid; k < ngroups * 2048; k += NTHR) {
    const int g2 = k >> 11;
    const int ntg = (ntok - g2 * 16) < 16 ? (ntok - g2 * 16) : 16;
    if ((k & 2047) < ntg * 128) {
      const unsigned en = WG[k];
      const unsigned m = (en >> 14) & 15u;
      const float cmx = __uint_as_float(CMAX[g2 * 16 + m]);
      const float q = cmx > 0.f ? rintf(CF[k] * (127.f / cmx)) : 0.f;
      CM[k] = (unsigned short)((m << 8) | (((unsigned)(int)q) & 0xffu));
    }
  }
  __syncthreads();
  if (gact) {
    const int i16 = lane & 15, kq = lane >> 4;
    const unsigned short* cmg = CM + tg * 2048;
    const int nch = nent >> 5;
    float csc[4];
#pragma unroll
    for (int r = 0; r < 4; ++r) csc[r] = __uint_as_float(CMAX[tg * 16 + 4 * kq + r]) * (1.f / 127.f);
#pragma unroll 1
    for (int cbp = 0; cbp < 8 / nwg; ++cbp) {
      const int colb = (1024 / nwg) * ch + 128 * cbp + 8 * i16;
      i32x4 acc[8];
#ifdef PROBE_V2
#pragma unroll 1
      for (int vrep = 0; vrep < 2; ++vrep) {
      const unsigned vemask = vrep == 0 ? PROBE_EMASK : 0xffffffffu;
#else
      const unsigned vemask = 0xffffffffu;
#endif
#pragma unroll
      for (int c = 0; c < 8; ++c) acc[c] = (i32x4){0, 0, 0, 0};
      u32x2 x[8];
      if (nch > 0) {
        const u32x4 w0 = *(const u32x4*)(wg + 8 * kq), w1 = *(const u32x4*)(wg + 8 * kq + 4);
#pragma unroll
        for (int j = 0; j < 4; ++j) {
          x[j] = *(const u32x2*)(VB + (size_t)((w0[j] & vemask) >> 18) * D + colb);
          x[4 + j] = *(const u32x2*)(VB + (size_t)((w1[j] & vemask) >> 18) * D + colb);
        }
      }
#pragma unroll 1
      for (int c = 0; c < nch; ++c) {
        unsigned ylo[8], yhi[8];
#pragma unroll
        for (int w = 0; w < 2; ++w) {
          {
            const unsigned t0 = pm_perm(x[1][w], x[0][w], 0x05010400u), t1 = pm_perm(x[1][w], x[0][w], 0x07030602u);
            const unsigned t2 = pm_perm(x[3][w], x[2][w], 0x05010400u), t3 = pm_perm(x[3][w], x[2][w], 0x07030602u);
            ylo[4 * w + 0] = pm_perm(t2, t0, 0x05040100u); ylo[4 * w + 1] = pm_perm(t2, t0, 0x07060302u);
            ylo[4 * w + 2] = pm_perm(t3, t1, 0x05040100u); ylo[4 * w + 3] = pm_perm(t3, t1, 0x07060302u);
          }
          {
            const unsigned t0 = pm_perm(x[5][w], x[4][w], 0x05010400u), t1 = pm_perm(x[5][w], x[4][w], 0x07030602u);
            const unsigned t2 = pm_perm(x[7][w], x[6][w], 0x05010400u), t3 = pm_perm(x[7][w], x[6][w], 0x07030602u);
            yhi[4 * w + 0] = pm_perm(t2, t0, 0x05040100u); yhi[4 * w + 1] = pm_perm(t2, t0, 0x07060302u);
            yhi[4 * w + 2] = pm_perm(t3, t1, 0x05040100u); yhi[4 * w + 3] = pm_perm(t3, t1, 0x07060302u);
          }
        }
        const u32x4 cmv = *(const u32x4*)(cmg + 32 * c + 8 * kq);
        unsigned alo = 0, ahi = 0;
#pragma unroll
        for (int j = 0; j < 8; ++j) {
          const unsigned hw = (cmv[j >> 1] >> (16 * (j & 1))) & 0xffffu;
          const unsigned bv = ((hw >> 8) == (unsigned)i16) ? (hw & 0xffu) : 0u;
          if (j < 4) alo |= bv << (8 * j); else ahi |= bv << (8 * (j - 4));
        }
        if (c + 1 < nch) {
          const u32x4 w0 = *(const u32x4*)(wg + 32 * (c + 1) + 8 * kq), w1 = *(const u32x4*)(wg + 32 * (c + 1) + 8 * kq + 4);
#pragma unroll
          for (int j = 0; j < 4; ++j) {
            x[j] = *(const u32x2*)(VB + (size_t)((w0[j] & vemask) >> 18) * D + colb);
            x[4 + j] = *(const u32x2*)(VB + (size_t)((w1[j] & vemask) >> 18) * D + colb);
          }
        }
        const i32x4 av = {(int)alo, (int)ahi, 0, 0};
#pragma unroll
        for (int cc = 0; cc < 8; ++cc) {
          const i32x4 bv = {(int)ylo[cc], (int)yhi[cc], 0, 0};
          acc[cc] = __builtin_amdgcn_mfma_i32_16x16x64_i8(av, bv, acc[cc], 0, 0, 0);
        }
      }
#ifdef PROBE_V2
      }
#endif
#pragma unroll
      for (int r = 0; r < 4; ++r) {
        const int m = 4 * kq + r;
        if (m < nt_g) {
          const int row = row0 + tg * 16 + m;
          const float* g2p = mod + ((size_t)l * 5 + row_cls(row)) * 6144 + 5120 + colb;
          u16* xr = (u16*)(p.ws + WS_XW) + (size_t)row * D + colb;
          u32x4 xw4 = *(const u32x4*)xr;
#pragma unroll
          for (int q = 0; q < 2; ++q) {
            const float4 gv = *(const float4*)(g2p + q * 4);
            xw4[2 * q] = pack2(bflo(xw4[2 * q]) + gv.x * csc[r] * (float)acc[q * 4 + 0][r], bfhi(xw4[2 * q]) + gv.y * csc[r] * (float)acc[q * 4 + 1][r]);
            xw4[2 * q + 1] = pack2(bflo(xw4[2 * q + 1]) + gv.z * csc[r] * (float)acc[q * 4 + 2][r], bfhi(xw4[2 * q + 1]) + gv.w * csc[r] * (float)acc[q * 4 + 3][r]);
          }
          *(u32x4*)xr = xw4;
        }
      }
    }
  }
  asm volatile("s_waitcnt vmcnt(0)" ::: "memory");
  __syncthreads();
  __builtin_amdgcn_fence(__ATOMIC_ACQUIRE, "agent");
  asm volatile("s_waitcnt vmcnt(0)" ::: "memory");
#ifdef PROBE_E2
#pragma unroll 1
  for (int erep = 0; erep < 2; ++erep)
#endif
#pragma unroll 1
  for (int i = 0; i < 8; ++i) {
    const int t = wave * 8 + i;
    if (t < ntok) {
      const int row = row0 + t;
      const int cls = row_cls(row);
      const u16* xr = (const u16*)(p.ws + WS_XW) + (size_t)row * D + lane * 16;
      float xn[16];
      float ssq = 0.f;
      {
        const u32x4 w0 = *(const u32x4*)xr, w1 = *(const u32x4*)(xr + 8);
#pragma unroll
        for (int e = 0; e < 4; ++e) { xn[2 * e] = bflo(w0[e]); xn[2 * e + 1] = bfhi(w0[e]); xn[8 + 2 * e] = bflo(w1[e]); xn[8 + 2 * e + 1] = bfhi(w1[e]); }
#pragma unroll
        for (int e = 0; e < 16; ++e) ssq += xn[e] * xn[e];
      }
      ssq = wave_sum(ssq);
      const float rs = rsqrtf(ssq * (1.f / 1024.f) + EPS);
      if (l < DEPTH - 1) {
        const float* ng = p.norm1_g + (size_t)(l + 1) * D + lane * 16;
        const float* mr = mod + ((size_t)(l + 1) * 5 + cls) * 6144 + lane * 16;
        float y[16];
#pragma unroll
        for (int q = 0; q < 4; ++q) {
          const float4 n4 = *(const float4*)(ng + q * 4), sc4 = *(const float4*)(mr + 1024 + q * 4), sh4 = *(const float4*)(mr + q * 4);
          y[q * 4 + 0] = xn[q * 4 + 0] * rs * n4.x * (1.f + sc4.x) + sh4.x; y[q * 4 + 1] = xn[q * 4 + 1] * rs * n4.y * (1.f + sc4.y) + sh4.y;
          y[q * 4 + 2] = xn[q * 4 + 2] * rs * n4.z * (1.f + sc4.z) + sh4.z; y[q * 4 + 3] = xn[q * 4 + 3] * rs * n4.w * (1.f + sc4.w) + sh4.w;
        }
        {
          float am = 0.f;
#pragma unroll
          for (int e = 0; e < 16; ++e) am = fmaxf(am, fabsf(y[e]));
#pragma unroll
          for (int o2 = 32; o2 >= 1; o2 >>= 1) am = fmaxf(am, __shfl_xor(am, o2));
          const float qs = am > 0.f ? am * (1.f / 127.f) : 1.f, qi = 1.f / qs;
          u32x4 oq;
#pragma unroll
          for (int q = 0; q < 4; ++q) {
            unsigned w = 0;
#pragma unroll
            for (int e = 0; e < 4; ++e) w |= (((unsigned)(int)rintf(y[q * 4 + e] * qi)) & 0xffu) << (8 * e);
            oq[q] = w;
          }
          *(u32x4*)(p.ws + WS_HXQ + (size_t)row * D + lane * 16) = oq;
          if (lane == 0) ((float*)(p.ws + WS_HXS))[row] = qs;
        }
      } else {
        const float* fg = p.final_g + lane * 16;
        float* orow = p.out + (size_t)row * D + lane * 16;
#pragma unroll
        for (int q = 0; q < 4; ++q) {
          const float4 f4 = *(const float4*)(fg + q * 4);
          *(float4*)(orow + q * 4) = make_float4(xn[q * 4] * rs * f4.x, xn[q * 4 + 1] * rs * f4.y, xn[q * 4 + 2] * rs * f4.z, xn[q * 4 + 3] * rs * f4.w);
        }
      }
    }
  }
  __syncthreads();
}

DI void phase_peer_mfma(KP p, unsigned char* smem, int l, int bid, int nb, int tid) {
  const int npass = (l < DEPTH - 1) ? 2 : 1;
#pragma unroll 1
  for (int ps = 0; ps < npass; ++ps) {
    const int nt = ps == 0 ? 64 : 4;
    const int base = ps == 0 ? 0 : NLAT, lim = ps == 0 ? NLAT : NTOK;
#pragma unroll 1
    for (int r0 = base + bid * nt; r0 < lim; r0 += nb * nt) peer_mfma_pass(p, smem, l, r0, nt, tid);
  }
}

constexpr int PH_PER_LAYER = 9;
constexpr int N_PHASES = 2 + DEPTH * PH_PER_LAYER;
constexpr int SMEM_BYTES = 256 * 132 * 4;

#ifndef ONLYMASK
#define ONLYMASK 0xffff
#endif
#define PHON(x) ((ONLYMASK >> (x)) & 1)
DI void run_phase(KP p, unsigned char* smem, int ph, int bid, int nb, int tid) {
  if (ph == 0) { if (PHON(10)) phase_p0a(p, (float*)smem, bid, nb, tid); return; }
  if (ph == 1) { if (PHON(4)) { phase_norm<true>(p, p.norm1_g, 0, 0, 1024, bid, nb, NTOK, tid, true); phase_rowq(p, WS_WS, WS_WSQ, WS_WSS, 4 * 2048, bid, nb, tid); phase_rowq(p, WS_WIN, WS_WINQ, WS_WINS, 4 * 4096, bid, nb, tid); } return; }
  const int l = (ph - 2) / PH_PER_LAYER, s = (ph - 2) % PH_PER_LAYER;
  const bool last = (l == DEPTH - 1);
  switch (s) {
    case 0: if (PHON(0)) gemm8_phase<G8_Z>(p, smem, (const u16*)(p.ws + WS_HX), (const u16*)(p.ws + WS_WIN) + (size_t)l * 4096 * 1024, 4096, 1024, l, bid, nb, NTOK / 256, tid); break;
    case 1: if (PHON(7)) phase_rec1(p, smem, l, bid, nb, tid); break;
    case 2: if (PHON(8)) rec_pass2(p, bid, nb, tid); break;
    case 3: if (PHON(9)) phase_rec3(p, smem, l, bid, nb, tid); break;
    case 4: if (PHON(2)) phase_recpost(p, l, bid, nb, tid); break;
    case 5: if (PHON(3)) gemm8_phase<G8_RES>(p, smem, (const u16*)(p.ws + WS_CAT), (const u16*)(p.ws + WS_WOUT) + (size_t)l * 1024 * 1024, 1024, 1024, l, bid, nb, last ? NLAT / 256 : NTOK / 256, tid); break;
    case 6: if (PHON(4)) phase_norm(p, p.norm2_g + (size_t)l * D, l, 3072, 4096, bid, nb, last ? NLAT : NTOK, tid, true); break;
    case 7: if (PHON(5)) gemm8_phase<G8_TOPK>(p, smem, (const u16*)(p.ws + WS_HX), (const u16*)(p.ws + WS_WS) + (size_t)l * 2048 * 1024, 2048, 1024, l, bid, nb, last ? NLAT / 256 : NTOK / 256, tid); break;
    case 8: if (PHON(6)) phase_peer_mfma(p, smem, l, bid, nb, tid); break;
  }
}


#define XB_TMO      128
#define XB_XCNT(j)  (256  + 64 * (j))
#define XB_XSUB(j)  (1280 + 64 * (j))
#define XB_XGEN(j)  (2304 + 64 * (j))
#define XB_TOP      3328
#define XB_TOPGEN   3392
#define XCD_BAR_WORDS 3456
#define XB_SPIN_CAP (1u << 22)
#define LAS __attribute__((address_space(3)))
DI unsigned xb_ld(unsigned* p)              { return __hip_atomic_load(p, __ATOMIC_RELAXED, __HIP_MEMORY_SCOPE_AGENT); }
DI unsigned xb_add(unsigned* p, unsigned v) { return __hip_atomic_fetch_add(p, v, __ATOMIC_RELAXED, __HIP_MEMORY_SCOPE_AGENT); }
DI unsigned xb_xcc_id() { return (unsigned)__builtin_amdgcn_s_getreg((3 << 11) | 20) & 0xFu; }
#define XB_SPIN(cond, bar) do { unsigned _sp = 0; while (cond) { __builtin_amdgcn_s_sleep(1); \
    if ((++_sp & 255u) == 0u) { if (xb_ld(&(bar)[XB_TMO])) break; if (_sp > XB_SPIN_CAP) { atomicAdd(&(bar)[XB_TMO], 1u); break; } } } } while (0)
struct XcdBarrier { unsigned* bar; unsigned x; volatile LAS unsigned* st; };
DI XcdBarrier xcd_barrier_post(unsigned* bar, volatile LAS unsigned* st) {
  XcdBarrier b; b.bar = bar; b.x = xb_xcc_id(); b.st = st;
  if (threadIdx.x == 0) (void)xb_add(&bar[XB_XCNT(b.x)], 1u);
  return b;
}
DI void xcd_barrier_complete(unsigned* bar, unsigned x, unsigned& nloc, unsigned& nx) {
  const unsigned G = gridDim.x * gridDim.y * gridDim.z;
  unsigned sum, cnt, mine, sp = 0u;
  for (;;) {
    sum = 0u; cnt = 0u; mine = 0u;
#pragma unroll
    for (unsigned j = 0; j < 16; ++j) { const unsigned c = xb_ld(&bar[XB_XCNT(j)]); sum += c; cnt += (c > 0u) ? 1u : 0u; mine = (j == x) ? c : mine; }
    if (sum == G) break;
    __builtin_amdgcn_s_sleep(1);
    if ((++sp & 255u) == 0u) { if (xb_ld(&bar[XB_TMO])) break; if (sp > XB_SPIN_CAP) { atomicAdd(&bar[XB_TMO], 1u); break; } }
  }
  nloc = mine > 0u ? mine : 1u; nx = cnt > 0u ? cnt : 1u;
}
DI void xcd_barrier(const XcdBarrier& b) {
  asm volatile("s_waitcnt vmcnt(0)" ::: "memory");
  __syncthreads();
  if (threadIdx.x == 0) {
    unsigned* bar = b.bar;
    __builtin_amdgcn_s_waitcnt(0);
    unsigned nloc = b.st[0], nx = b.st[1];
    if (nloc == 0u) { xcd_barrier_complete(bar, b.x, nloc, nx); b.st[0] = nloc; b.st[1] = nx; }
    const unsigned old = xb_add(&bar[XB_XSUB(b.x)], 1u);
    const unsigned gen = old / nloc;
    if (old + 1u == (gen + 1u) * nloc) {
      __builtin_amdgcn_fence(__ATOMIC_RELEASE, "agent");
      asm volatile("s_waitcnt vmcnt(0)" ::: "memory");
      const unsigned og = xb_add(&bar[XB_TOP], 1u);
      const unsigned tg = og / nx;
      if (og + 1u == (tg + 1u) * nx) xb_add(&bar[XB_TOPGEN], 1u);
      else XB_SPIN(xb_ld(&bar[XB_TOPGEN]) == tg, bar);
      __builtin_amdgcn_fence(__ATOMIC_ACQUIRE, "agent");
      xb_add(&bar[XB_XGEN(b.x)], 1u);
      asm volatile("s_waitcnt vmcnt(0)" ::: "memory");
    } else {
      XB_SPIN(xb_ld(&bar[XB_XGEN(b.x)]) == gen, bar);
      __builtin_amdgcn_fence(__ATOMIC_ACQUIRE, "agent");
      asm volatile("s_waitcnt vmcnt(0)" ::: "memory");
    }
  }
  __syncthreads();
}

typedef const Params __attribute__((address_space(4)))* KArgs;

__global__ void __launch_bounds__(NTHR, 2) mega_kernel(Params p_unused) {
#if defined(__HIP_DEVICE_COMPILE__)
  __shared__ __attribute__((aligned(16))) unsigned char smem[SMEM_BYTES + 16];
  KArgs ka = (KArgs)__builtin_amdgcn_kernarg_segment_ptr();
  const int ph_lo = ka->ph_lo, ph_hi = ka->ph_hi;
#if !MULTI_LAUNCH
  cg::grid_group grid = cg::this_grid();
  volatile LAS unsigned* xbw = (volatile LAS unsigned*)(smem + SMEM_BYTES);
  if (threadIdx.x == 0) { xbw[0] = 0u; xbw[1] = 0u; }
  __syncthreads();
  XcdBarrier xb = xcd_barrier_post((unsigned*)(ka->ws + WS_BAR), xbw);
#endif
  int rep = 0;
  for (int ph = ph_lo; ph < ph_hi;) {
    int tid = threadIdx.x, bid = blockIdx.x, nb = gridDim.x;
    KArgs kq = ka;
    asm volatile("" : "+v"(tid), "+s"(bid), "+s"(nb), "+s"(kq));
#ifdef AMP_K
    if (AMP_COND(ph) && threadIdx.x == 0) *(volatile LAS unsigned long long*)(smem + SMEM_BYTES + 8) = wall_clock64();
#endif
    run_phase(*kq, smem, ph, bid, nb, tid);
    bool again = false;
#ifdef REPEAT_S
    if (rep == 0 && ((ph >= 2 && (ph - 2) % PH_PER_LAYER == REPEAT_S) || (REPEAT_S == 100 && ph == 0))) again = true;
#endif
#if !MULTI_LAUNCH
    if (again || ph + 1 < ph_hi) { if (ph == 0 && !again) grid.sync(); else xcd_barrier(xb); }
#endif
#ifdef AMP_K
    if (AMP_COND(ph)) {
      if (threadIdx.x == 0) {
        const unsigned long long t0 = *(volatile LAS unsigned long long*)(smem + SMEM_BYTES + 8), t1 = wall_clock64();
        const unsigned long long dt = (t1 - t0) * AMP_K;
        while (wall_clock64() - t1 < dt) __builtin_amdgcn_s_sleep(8);
      }
      __syncthreads();
    }
#endif
    if (again) rep = 1; else { rep = 0; ++ph; }
  }
#endif
}

extern "C" void kernel_launch(void* const* d_in, const int* in_sizes, int n_in, void* d_out, int out_size, void* d_ws, size_t ws_size, hipStream_t stream) {
  static int grid = 0;
  if (grid == 0) {
    if (n_in != 17 || ws_size < WS_END) { fprintf(stderr, "kernel_launch: unexpected n_in %d or ws_size %zu (need %zu)\n", n_in, ws_size, (size_t)WS_END); grid = -1; return; }
    int dev = 0, cus = 0, per_cu = 0;
    hipGetDevice(&dev);
    hipDeviceGetAttribute(&cus, hipDeviceAttributeMultiprocessorCount, dev);
    hipOccupancyMaxActiveBlocksPerMultiprocessor(&per_cu, (const void*)mega_kernel, NTHR, 0);
    if (per_cu < 1) { fprintf(stderr, "kernel_launch: occupancy query says %d blocks per CU\n", per_cu); grid = -1; return; }
    grid = cus;
  }
  if (grid < 0) return;
  Params p{};
  p.x = (const float*)d_in[0]; p.c = (const float*)d_in[1]; p.ctx = (const float*)d_in[2]; p.c_ctx = (const float*)d_in[3];
  p.w_mod = (const float*)d_in[4]; p.b_mod = (const float*)d_in[5]; p.norm1_g = (const float*)d_in[6]; p.norm2_g = (const float*)d_in[7];
  p.w_in = (const float*)d_in[8]; p.conv_w = (const float*)d_in[9]; p.w_out = (const float*)d_in[10]; p.lb_logits = (const float*)d_in[11];
  p.peer_wq = (const float*)d_in[12]; p.peer_subkeys = (const float*)d_in[13]; p.peer_u = (const float*)d_in[14]; p.peer_v = (const float*)d_in[15];
  p.final_g = (const float*)d_in[16]; p.out = (float*)d_out; p.ws = (unsigned char*)d_ws;
#if MULTI_LAUNCH
  for (int ph = 0; ph < N_PHASES; ++ph) {
    p.ph_lo = ph; p.ph_hi = ph + 1;
    hipLaunchKernelGGL(mega_kernel, dim3(grid), dim3(NTHR), 0, stream, p);
  }
#else
  p.ph_lo = 0; p.ph_hi = N_PHASES;
  if (hipMemsetAsync((char*)d_ws + WS_BAR, 0, 16384, stream) != hipSuccess) { fprintf(stderr, "kernel_launch: memset of barrier words failed\n"); return; }
  void* args[] = {&p};
  hipError_t e = hipLaunchCooperativeKernel((const void*)mega_kernel, dim3(grid), dim3(NTHR), args, 0, stream);
  if (e != hipSuccess) fprintf(stderr, "cooperative launch failed: %s (grid %d)\n", hipGetErrorString(e), grid);
#endif
}
```

```cpp
#include <hip/hip_runtime.h>
#include <hip/hip_cooperative_groups.h>
#include <stdint.h>
#include <stdio.h>
namespace cg = cooperative_groups;

#ifndef MULTI_LAUNCH
#define MULTI_LAUNCH 0
#endif

#define DI __device__ __forceinline__
typedef unsigned short u16;
using bf16x8 = __attribute__((ext_vector_type(8))) short;
using f32x16 = __attribute__((ext_vector_type(16))) float;
using u32x4  = __attribute__((ext_vector_type(4))) unsigned;
using u32x2  = __attribute__((ext_vector_type(2))) unsigned;
using f32x4  = __attribute__((ext_vector_type(4))) float;

constexpr int D = 1024, NLAT = 16384, NCTX = 1024, NTOK = 17408, DEPTH = 4, INC = 4096;
constexpr int SEQ = 4096, CTXL = 256, BATCH = 4;
constexpr int NTHR = 512;
constexpr int NEXP = 16384;
constexpr float EPS = 1e-6f;

constexpr size_t al256(size_t x) { return (x + 255) & ~(size_t)255; }
constexpr size_t WS_BAR   = 0;
constexpr size_t WS_MOD   = 16384;
constexpr size_t WS_LOWER = WS_MOD + al256((size_t)4 * 5 * 6144 * 4);
constexpr size_t WS_XW    = WS_LOWER + al256((size_t)4 * 2 * 512 * 4);
constexpr size_t WS_HX    = WS_XW + (size_t)NTOK * D * 4;
constexpr size_t WS_Z     = WS_HX + (size_t)NTOK * D * 2;
constexpr size_t WS_CAT   = WS_Z + (size_t)NTOK * INC * 2;
constexpr size_t WS_OF    = WS_CAT + (size_t)NTOK * D * 2;
constexpr size_t WS_OB    = WS_OF + (size_t)NTOK * 512 * 4;
constexpr size_t WS_TOPK  = WS_OB + (size_t)NTOK * 512 * 4;
constexpr size_t WS_WIN   = WS_TOPK + (size_t)NTOK * 256 * 4;
constexpr size_t WS_WOUT  = WS_WIN + (size_t)4 * 4096 * 1024 * 2;
constexpr size_t WS_WS    = WS_WOUT + (size_t)4 * 1024 * 1024 * 2;
constexpr size_t WS_UB    = WS_WS + (size_t)4 * 2048 * 1024 * 2;
constexpr size_t WS_VB    = WS_UB + (size_t)4 * NEXP * D;
constexpr size_t WS_US    = WS_VB + (size_t)4 * NEXP * D;
constexpr size_t WS_VS    = WS_US + (size_t)4 * NEXP * 4;
constexpr size_t WS_SLOC  = WS_VS + (size_t)4 * NEXP * 4;
constexpr size_t WS_SST   = WS_SLOC + (size_t)32 * 34 * 16384 * 2;
constexpr size_t WS_DT    = WS_SST + (size_t)32 * 34 * 16384 * 2;
constexpr size_t WS_HXQ   = WS_DT + (size_t)32 * 34 * 128 * 4;
constexpr size_t WS_HXS   = WS_HXQ + (size_t)NTOK * D;
constexpr size_t WS_WSQ   = WS_HXS + al256((size_t)NTOK * 4);
constexpr size_t WS_WSS   = WS_WSQ + (size_t)4 * 2048 * 1024;
constexpr size_t WS_WINQ  = WS_WSS + (size_t)4 * 2048 * 4;
constexpr size_t WS_WINS  = WS_WINQ + (size_t)4 * 4096 * 1024;
constexpr size_t WS_END   = WS_WINS + (size_t)4 * 4096 * 4;

struct Params {
  const float* x; const float* c; const float* ctx; const float* c_ctx; const float* w_mod; const float* b_mod;
  const float* norm1_g; const float* norm2_g; const float* w_in; const float* conv_w; const float* w_out;
  const float* lb_logits; const float* peer_wq; const float* peer_subkeys; const float* peer_u; const float* peer_v;
  const float* final_g; float* out; unsigned char* ws;
  int ph_lo, ph_hi;
};

typedef __attribute__((ext_vector_type(2))) __bf16 bf16v2;
typedef __attribute__((ext_vector_type(2))) float f32v2;
typedef const Params __attribute__((address_space(4)))& KP;

DI u16 f2bf(float x) { return __builtin_bit_cast(u16, (__bf16)x); }
DI float bf2f(u16 b) { return __uint_as_float(((unsigned)b) << 16); }
DI unsigned pack2(float a, float b) { f32v2 v = {a, b}; return __builtin_bit_cast(unsigned, __builtin_convertvector(v, bf16v2)); }
DI float bflo(unsigned w) { return __uint_as_float(w << 16); }
DI float bfhi(unsigned w) { return __uint_as_float(w & 0xffff0000u); }
DI float sigmoidf_(float x) { return 1.f / (1.f + __expf(-x)); }
DI float siluf_(float x) { return x / (1.f + __expf(-x)); }
DI float wave_sum(float v) {
#pragma unroll
  for (int o = 32; o >= 1; o >>= 1) v += __shfl_xor(v, o);
  return v;
}
DI int row_cls(int row) { return row < NLAT ? (row >> 12) : 4; }
DI unsigned sw128(int row, int col) { return (unsigned)(row * 256 + ((((col >> 3) ^ (row & 15))) << 4) + (col & 7) * 2); }

DI void p0_mod_groups(KP p, float* smem, int gb, int vb, int nvb, int tid) {
  const int ge = gb + 192;
  float* cond = smem;
  float* red = smem + 5 * 1024;
  for (int i = tid; i < 5 * 1024; i += NTHR) {
    const int r = i >> 10, k = i & 1023;
    const float v = r < 4 ? p.c[r * 1024 + k] : p.c_ctx[k];
    cond[i] = siluf_(v);
  }
  __syncthreads();
  const int col = tid & 31, ks = tid >> 5;
  const float* cd0 = cond + ks * 64;
  float* mod = (float*)(p.ws + WS_MOD);
  for (int g0 = gb + vb; g0 < ge; g0 += 3 * nvb) {
    float wa[16], wb[16];
    const unsigned vo = (unsigned)((ks * 64 * 6144 + col) * 4);
    auto wbase = [&](int g) { return (const char*)(p.w_mod + (size_t)(g / 192) * 1024 * 6144 + (g % 192) * 32); };
    {
      const char* w = wbase(g0);
#pragma unroll
      for (int u = 0; u < 16; ++u) wa[u] = *(const float*)(w + (size_t)u * 24576 + vo);
    }
#pragma unroll 1
    for (int q = 0; q < 3; ++q) {
      const int g = g0 + q * nvb;
      if (g >= ge) break;
      float a0 = 0, a1 = 0, a2 = 0, a3 = 0, a4 = 0;
#pragma unroll 1
      for (int hb = 0; hb < 2; ++hb) {
        const float* cd = cd0 + 32 * hb;
        asm volatile("" : "+v"(cd));
        {
          const char* w = wbase(g) + (size_t)(32 * hb + 16) * 24576;
#pragma unroll
          for (int u = 0; u < 16; ++u) wb[u] = *(const float*)(w + (size_t)u * 24576 + vo);
        }
#pragma unroll
        for (int u = 0; u < 16; ++u) { a0 += cd[u] * wa[u]; a1 += cd[1024 + u] * wa[u]; a2 += cd[2048 + u] * wa[u]; a3 += cd[3072 + u] * wa[u]; a4 += cd[4096 + u] * wa[u]; }
        __builtin_amdgcn_sched_barrier(0);
        if (hb == 0 || (q + 1 < 3 && g + nvb < ge)) {
          const char* w = hb == 0 ? wbase(g) + (size_t)32 * 24576 : wbase(g + nvb);
#pragma unroll
          for (int u = 0; u < 16; ++u) wa[u] = *(const float*)(w + (size_t)u * 24576 + vo);
        }
#pragma unroll
        for (int u = 0; u < 16; ++u) { a0 += cd[16 + u] * wb[u]; a1 += cd[1040 + u] * wb[u]; a2 += cd[2064 + u] * wb[u]; a3 += cd[3088 + u] * wb[u]; a4 += cd[4112 + u] * wb[u]; }
        __builtin_amdgcn_sched_barrier(0);
      }
      float* rq = red + q * 2560;
      rq[(ks * 5 + 0) * 32 + col] = a0; rq[(ks * 5 + 1) * 32 + col] = a1; rq[(ks * 5 + 2) * 32 + col] = a2;
      rq[(ks * 5 + 3) * 32 + col] = a3; rq[(ks * 5 + 4) * 32 + col] = a4;
    }
    __syncthreads();
    if (tid < 480) {
      const int q = tid / 160, rr = tid % 160, r = rr >> 5, cc = rr & 31, g = g0 + q * nvb;
      if (g < ge) {
        const float* rq = red + q * 2560;
        float sacc = 0.f;
#pragma unroll
        for (int t = 0; t < 16; ++t) sacc += rq[(t * 5 + r) * 32 + cc];
        const int l = g / 192, ng = g % 192;
        mod[((size_t)l * 5 + r) * 6144 + ng * 32 + cc] = sacc + p.b_mod[l * 6144 + ng * 32 + cc];
      }
    }
    __syncthreads();
  }
}

DI void p0_transpose_waves(KP p, float* smem, int bid, int nb, int tid) {
  const int lane = tid & 63, wave = tid >> 6;
  float* t = smem + wave * (64 * 33);
  const int kr = lane >> 3, c4 = (lane & 7) * 4;
  const int j = lane >> 1, hf = lane & 1;
  float4 v[8];
  const float* src = nullptr; u16* dst = nullptr; int K = 1024, N = 0, k0 = 0, n0 = 0;
  auto decode = [&](int it) {
    if (it < 8192) { const int l = it >> 11, r = it & 2047; k0 = (r >> 7) * 64; n0 = (r & 127) * 32; N = 4096; src = p.w_in + (size_t)l * 1024 * 4096; dst = (u16*)(p.ws + WS_WIN) + (size_t)l * 4096 * 1024; }
    else { const int i2 = it - 8192, l = i2 >> 9, r = i2 & 511; k0 = (r >> 5) * 64; n0 = (r & 31) * 32; N = 1024; src = p.w_out + (size_t)l * 1024 * 1024; dst = (u16*)(p.ws + WS_WOUT) + (size_t)l * 1024 * 1024; }
  };
  auto gload = [&]() {
#pragma unroll
    for (int pp = 0; pp < 8; ++pp) v[pp] = *(const float4*)(src + (size_t)(k0 + kr + 8 * pp) * N + n0 + c4);
  };
  int it = bid * 8 + wave;
  const int step = nb * 8;
  if (it < 10240) { decode(it); gload(); }
#pragma unroll 1
  while (it < 10240) {
#pragma unroll
    for (int pp = 0; pp < 8; ++pp) {
      float* tt = t + (kr + 8 * pp) * 33 + c4;
      tt[0] = v[pp].x; tt[1] = v[pp].y; tt[2] = v[pp].z; tt[3] = v[pp].w;
    }
    u16* drow = dst + (size_t)(n0 + j) * K + k0 + 32 * hf;
    const int nxt = it + step;
    if (nxt < 10240) { decode(nxt); gload(); }
    __builtin_amdgcn_fence(__ATOMIC_ACQ_REL, "wavefront");
    __builtin_amdgcn_wave_barrier();
#pragma unroll
    for (int q = 0; q < 4; ++q) {
      const float* tt = t + (32 * hf + 8 * q) * 33 + j;
      u32x4 o;
      o[0] = pack2(tt[0 * 33], tt[1 * 33]); o[1] = pack2(tt[2 * 33], tt[3 * 33]);
      o[2] = pack2(tt[4 * 33], tt[5 * 33]); o[3] = pack2(tt[6 * 33], tt[7 * 33]);
      *(u32x4*)(drow + 8 * q) = o;
    }
    __builtin_amdgcn_fence(__ATOMIC_ACQ_REL, "wavefront");
    __builtin_amdgcn_wave_barrier();
    it = nxt;
  }
}

DI void p0_ws_item(KP p, float* smemf, int item, int tid) {
  const int l = item >> 8, hp = (item >> 4) & 15, kt = item & 15;
  unsigned char* smem = (unsigned char*)smemf;
  unsigned char* SK = smem;
  unsigned char* WQ = smem + 32768;
  const float* skg = p.peer_subkeys + ((size_t)l * 16 + hp) * 128 * 128;
#pragma unroll
  for (int u = 0; u < 4; ++u) {
    const int q = tid + NTHR * u, row = q >> 4, c8 = (q & 15) * 8;
    const float4 a = *(const float4*)(skg + row * 128 + c8), b = *(const float4*)(skg + row * 128 + c8 + 4);
    u32x4 o; o[0] = pack2(a.x, a.y); o[1] = pack2(a.z, a.w); o[2] = pack2(b.x, b.y); o[3] = pack2(b.z, b.w);
    *(u32x4*)(SK + sw128(row, c8)) = o;
  }
  const float* wqg = p.peer_wq + (size_t)l * 1024 * 2048 + (size_t)(kt * 64) * 2048 + hp * 128;
#pragma unroll
  for (int u = 0; u < 2; ++u) {
    const int q = tid + NTHR * u, row = q >> 4, c8 = (q & 15) * 8;
    const float4 a = *(const float4*)(wqg + (size_t)row * 2048 + c8), b = *(const float4*)(wqg + (size_t)row * 2048 + c8 + 4);
    u32x4 o; o[0] = pack2(a.x, a.y); o[1] = pack2(a.z, a.w); o[2] = pack2(b.x, b.y); o[3] = pack2(b.z, b.w);
    *(u32x4*)(WQ + sw128(row, c8)) = o;
  }
  __syncthreads();
  const int lane = tid & 63, wave = tid >> 6, r = lane & 31, h = lane >> 5;
  const int km = wave >> 2, kn = wave & 3;
  f32x16 acc;
#pragma unroll
  for (int e = 0; e < 16; ++e) acc[e] = 0.f;
#pragma unroll
  for (int ks = 0; ks < 8; ++ks) {
    const bf16x8 av = *(const bf16x8*)(WQ + sw128(32 * km + r, 16 * ks + 8 * h));
    const bf16x8 bv = *(const bf16x8*)(SK + sw128(32 * kn + r, 16 * ks + 8 * h));
    acc = __builtin_amdgcn_mfma_f32_32x32x16_bf16(av, bv, acc, 0, 0, 0);
  }
  u16* dst = (u16*)(p.ws + WS_WS) + ((size_t)l * 2048 + hp * 128 + 32 * kn + r) * 1024 + kt * 64 + 32 * km + 4 * h;
#pragma unroll
  for (int g = 0; g < 4; ++g) {
    u32x2 o; o[0] = pack2(acc[4 * g], acc[4 * g + 1]); o[1] = pack2(acc[4 * g + 2], acc[4 * g + 3]);
    *(u32x2*)(dst + 8 * g) = o;
  }
  __syncthreads();
}

DI void p0_quant_rows(const float* src, unsigned char* dst, float* scl, int row0, int tid, float off) {
  const int lane = tid & 63, wave = tid >> 6;
  auto qrow = [&](int row, const float4& x0, const float4& x1, const float4& x2, const float4& x3) {
    float v[16] = {x0.x, x0.y, x0.z, x0.w, x1.x, x1.y, x1.z, x1.w, x2.x, x2.y, x2.z, x2.w, x3.x, x3.y, x3.z, x3.w};
    float am = 0.f;
#pragma unroll
    for (int e = 0; e < 16; ++e) am = fmaxf(am, fabsf(v[e]));
#pragma unroll
    for (int o = 32; o >= 1; o >>= 1) am = fmaxf(am, __shfl_xor(am, o));
    const float sc = am > 0.f ? am * (1.f / 127.f) : 1.f;
    const float inv = 1.f / sc;
    u32x4 o4;
#pragma unroll
    for (int q = 0; q < 4; ++q) {
      unsigned w = 0;
#pragma unroll
      for (int e = 0; e < 4; ++e) {
        const float qv = fminf(fmaxf(rintf(v[q * 4 + e] * inv), -127.f), 127.f) + off;
        w |= (((unsigned)(int)qv) & 0xffu) << (8 * e);
      }
      o4[q] = w;
    }
    *(u32x4*)(dst + (size_t)row * D + lane * 16) = o4;
    if (lane == 0) scl[row] = sc;
  };
#pragma unroll 1
  for (int i = 0; i < 8; i += 2) {
    const int rA = row0 + i * 8 + wave, rB = rA + 8;
    const float* sa = src + (size_t)rA * D + lane * 16;
    const float* sb = src + (size_t)rB * D + lane * 16;
    const float4 a0 = *(const float4*)(sa), a1 = *(const float4*)(sa + 4), a2 = *(const float4*)(sa + 8), a3 = *(const float4*)(sa + 12);
    const float4 b0 = *(const float4*)(sb), b1 = *(const float4*)(sb + 4), b2 = *(const float4*)(sb + 8), b3 = *(const float4*)(sb + 12);
    qrow(rA, a0, a1, a2, a3);
    qrow(rB, b0, b1, b2, b3);
  }
}

DI void p0_quant_waves(KP p, int bid, int nb, int tid) {
  const int lane = tid & 63, wave = tid >> 6;
  auto qrow = [&](int rr, const float4& x0, const float4& x1, const float4& x2, const float4& x3) {
    unsigned char* dst = p.ws + (rr < NEXP ? WS_UB : WS_VB);
    float* scl = (float*)(p.ws + (rr < NEXP ? WS_US : WS_VS));
    const int row = rr & (NEXP - 1);
    float v[16] = {x0.x, x0.y, x0.z, x0.w, x1.x, x1.y, x1.z, x1.w, x2.x, x2.y, x2.z, x2.w, x3.x, x3.y, x3.z, x3.w};
    float am = 0.f;
#pragma unroll
    for (int e = 0; e < 16; ++e) am = fmaxf(am, fabsf(v[e]));
#pragma unroll
    for (int o = 32; o >= 1; o >>= 1) am = fmaxf(am, __shfl_xor(am, o));
    const float sc = am > 0.f ? am * (1.f / 127.f) : 1.f;
    const float inv = 1.f / sc;
    u32x4 o4;
#pragma unroll
    for (int q = 0; q < 4; ++q) {
      unsigned w = 0;
#pragma unroll
      for (int e = 0; e < 4; ++e) {
        const float qv = fminf(fmaxf(rintf(v[q * 4 + e] * inv), -127.f), 127.f);
        w |= (((unsigned)(int)qv) & 0xffu) << (8 * e);
      }
      o4[q] = w;
    }
    *(u32x4*)(dst + (size_t)row * D + lane * 16) = o4;
    if (lane == 0) scl[row] = sc;
  };
  auto srow = [&](int rr) { return (rr < NEXP ? p.peer_u + (size_t)rr * D : p.peer_v + (size_t)(rr - NEXP) * D) + lane * 16; };
  const int step = nb * 8;
  int rA = bid * 8 + wave, rB = rA + step;
  float4 a0, a1, a2, a3, b0, b1, b2, b3;
  if (rA < 2 * NEXP) { const float* sa = srow(rA); a0 = *(const float4*)(sa); a1 = *(const float4*)(sa + 4); a2 = *(const float4*)(sa + 8); a3 = *(const float4*)(sa + 12); }
  if (rB < 2 * NEXP) { const float* sb = srow(rB); b0 = *(const float4*)(sb); b1 = *(const float4*)(sb + 4); b2 = *(const float4*)(sb + 8); b3 = *(const float4*)(sb + 12); }
#pragma unroll 1
  while (rA < 2 * NEXP) {
    qrow(rA, a0, a1, a2, a3);
    const int nA = rA + 2 * step;
    if (nA < 2 * NEXP) { const float* sa = srow(nA); a0 = *(const float4*)(sa); a1 = *(const float4*)(sa + 4); a2 = *(const float4*)(sa + 8); a3 = *(const float4*)(sa + 12); }
    if (rB < 2 * NEXP) qrow(rB, b0, b1, b2, b3);
    const int nB = rB + 2 * step;
    if (nB < 2 * NEXP) { const float* sb = srow(nB); b0 = *(const float4*)(sb); b1 = *(const float4*)(sb + 4); b2 = *(const float4*)(sb + 8); b3 = *(const float4*)(sb + 12); }
    rA = nA; rB = nB;
  }
}

constexpr int P0_N_WS = 1024;

DI void phase_p0a(KP p, float* smem, int bid, int nb, int tid) {
  if (bid == nb - 1) {
    float* lower = (float*)(p.ws + WS_LOWER);
    for (int e = tid; e < 1024; e += NTHR) {
      const float a0 = p.lb_logits[e], a1 = p.lb_logits[1024 + e], a2 = p.lb_logits[2048 + e], a3 = p.lb_logits[3072 + e];
      const float m = fmaxf(fmaxf(a0, a1), fmaxf(a2, a3));
      const float e0 = expf(a0 - m), e1 = expf(a1 - m), e2 = expf(a2 - m), e3 = expf(a3 - m);
      const float inv = 1.f / (e0 + e1 + e2 + e3);
      lower[e] = 0.f; lower[1024 + e] = e1 * inv; lower[2048 + e] = (e1 + e2) * inv; lower[3072 + e] = (e1 + e2 + e3) * inv;
    }
  }
  p0_mod_groups(p, smem, 0, bid, nb, tid);
  for (int i = bid; i < P0_N_WS; i += nb) p0_ws_item(p, smem, i, tid);
  p0_transpose_waves(p, smem, bid, nb, tid);
  p0_quant_waves(p, bid, nb, tid);
}

template <bool FIRST = false>
DI void phase_norm(KP p, const float* g, int l, int sh_off, int sc_off, int bid, int nb, int row_end, int tid, bool wq = false) {
  const int lane = tid & 63, wave = tid >> 6;
  u16* xw = (u16*)(p.ws + WS_XW);
  const float* mod = (const float*)(p.ws + WS_MOD) + (size_t)l * 5 * 6144;
  for (int row = bid * 8 + wave; row < row_end; row += nb * 8) {
    float v[16];
    if (FIRST) {
      const float* xr = (row < NLAT ? p.x + (size_t)row * D : p.ctx + (size_t)(row - NLAT) * D) + lane * 16;
      u32x4 w0, w1;
#pragma unroll
      for (int q = 0; q < 4; ++q) {
        const float4 a = *(const float4*)(xr + q * 4);
        const unsigned lo = pack2(a.x, a.y), hi = pack2(a.z, a.w);
        if (q < 2) { w0[2 * q] = lo; w0[2 * q + 1] = hi; } else { w1[2 * (q - 2)] = lo; w1[2 * (q - 2) + 1] = hi; }
      }
      *(u32x4*)(xw + (size_t)row * D + lane * 16) = w0; *(u32x4*)(xw + (size_t)row * D + lane * 16 + 8) = w1;
#pragma unroll
      for (int e = 0; e < 4; ++e) { v[2 * e] = bflo(w0[e]); v[2 * e + 1] = bfhi(w0[e]); v[8 + 2 * e] = bflo(w1[e]); v[8 + 2 * e + 1] = bfhi(w1[e]); }
    } else {
      const u32x4 w0 = *(const u32x4*)(xw + (size_t)row * D + lane * 16), w1 = *(const u32x4*)(xw + (size_t)row * D + lane * 16 + 8);
#pragma unroll
      for (int e = 0; e < 4; ++e) { v[2 * e] = bflo(w0[e]); v[2 * e + 1] = bfhi(w0[e]); v[8 + 2 * e] = bflo(w1[e]); v[8 + 2 * e + 1] = bfhi(w1[e]); }
    }
    float ss = 0.f;
#pragma unroll
    for (int e = 0; e < 16; ++e) ss += v[e] * v[e];
    ss = wave_sum(ss);
    const float rs = rsqrtf(ss * (1.f / 1024.f) + EPS);
    const float* mr = mod + (size_t)row_cls(row) * 6144;
#pragma unroll
    for (int q = 0; q < 4; ++q) {
      const int c0 = lane * 16 + q * 4;
      const float4 gg = *(const float4*)(g + c0);
      const float4 sh = *(const float4*)(mr + sh_off + c0);
      const float4 sc = *(const float4*)(mr + sc_off + c0);
      v[q * 4 + 0] = v[q * 4 + 0] * rs * gg.x * (1.f + sc.x) + sh.x; v[q * 4 + 1] = v[q * 4 + 1] * rs * gg.y * (1.f + sc.y) + sh.y;
      v[q * 4 + 2] = v[q * 4 + 2] * rs * gg.z * (1.f + sc.z) + sh.z; v[q * 4 + 3] = v[q * 4 + 3] * rs * gg.w * (1.f + sc.w) + sh.w;
    }
    {
      float am = 0.f;
#pragma unroll
      for (int e = 0; e < 16; ++e) am = fmaxf(am, fabsf(v[e]));
#pragma unroll
      for (int o2 = 32; o2 >= 1; o2 >>= 1) am = fmaxf(am, __shfl_xor(am, o2));
      const float sc = am > 0.f ? am * (1.f / 127.f) : 1.f, inv = 1.f / sc;
      u32x4 oq;
#pragma unroll
      for (int q = 0; q < 4; ++q) {
        unsigned w = 0;
#pragma unroll
        for (int e = 0; e < 4; ++e) w |= (((unsigned)(int)rintf(v[q * 4 + e] * inv)) & 0xffu) << (8 * e);
        oq[q] = w;
      }
      *(u32x4*)(p.ws + WS_HXQ + (size_t)row * D + lane * 16) = oq;
      if (lane == 0) ((float*)(p.ws + WS_HXS))[row] = sc;
    }
  }
}

DI void phase_rowq(KP p, size_t src_off, size_t dst_off, size_t scl_off, int nrows, int bid, int nb, int tid) {
  const int lane = tid & 63, wave = tid >> 6;
  const u16* src = (const u16*)(p.ws + src_off);
  for (int row = bid * 8 + wave; row < nrows; row += nb * 8) {
    const u32x4 a = *(const u32x4*)(src + (size_t)row * 1024 + lane * 16), b = *(const u32x4*)(src + (size_t)row * 1024 + lane * 16 + 8);
    float v[16];
#pragma unroll
    for (int e = 0; e < 4; ++e) { v[2 * e] = bflo(a[e]); v[2 * e + 1] = bfhi(a[e]); v[8 + 2 * e] = bflo(b[e]); v[8 + 2 * e + 1] = bfhi(b[e]); }
    float am = 0.f;
#pragma unroll
    for (int e = 0; e < 16; ++e) am = fmaxf(am, fabsf(v[e]));
#pragma unroll
    for (int o2 = 32; o2 >= 1; o2 >>= 1) am = fmaxf(am, __shfl_xor(am, o2));
    const float sc = am > 0.f ? am * (1.f / 127.f) : 1.f, inv = 1.f / sc;
    u32x4 o;
#pragma unroll
    for (int q = 0; q < 4; ++q) {
      unsigned w = 0;
#pragma unroll
      for (int e = 0; e < 4; ++e) w |= (((unsigned)(int)rintf(v[q * 4 + e] * inv)) & 0xffu) << (8 * e);
      o[q] = w;
    }
    *(u32x4*)(p.ws + dst_off + (size_t)row * 1024 + lane * 16) = o;
    if (lane == 0) ((float*)(p.ws + scl_off))[row] = sc;
  }
}

constexpr int GEMM_LDS_STAGE = 256 * 128 + 128 * 128;
enum { EPI_Z = 0, EPI_RES = 1, EPI_TOPK = 2 };

DI unsigned lds_off(int row, int c) { return (unsigned)(row * 128 + ((c ^ ((row >> 1) & 7)) << 4)); }

template <int EPI, int BN, bool DEEP = false>
DI void gemm_tile(KP p, unsigned char* smem, const u16* A, const u16* Bt, int N, int K, int l, int m0, int n0, int tid) {
  constexpr int WN = BN / 64, WM = 8 / WN, IM = 256 / WM / 32, NB = BN / 64;
  constexpr int STAGE = 32768 + BN * 128;
  const int lane = tid & 63, wave = tid >> 6;
  const int wm = wave / WN, wn = wave % WN, r = lane & 31, h = lane >> 5;
  f32x16 acc[IM][2];
#pragma unroll
  for (int i = 0; i < IM; ++i)
#pragma unroll
    for (int j = 0; j < 2; ++j)
#pragma unroll
      for (int e = 0; e < 16; ++e) acc[i][j][e] = 0.f;
  u32x4 ra[4], rb[NB];
  const int nk = K / 64;
  const unsigned voff = (unsigned)(((tid >> 3) * K + (tid & 7) * 8) * 2);
  auto gload = [&](int kt) {
#pragma unroll
    for (int i = 0; i < 4; ++i) {
      const char* base = (const char*)(A + (size_t)(m0 + 64 * i) * K + kt * 64);
      ra[i] = *(const u32x4*)(base + voff);
    }
#pragma unroll
    for (int i = 0; i < NB; ++i) {
      const char* base = (const char*)(Bt + (size_t)(n0 + 64 * i) * K + kt * 64);
      rb[i] = *(const u32x4*)(base + voff);
    }
  };
  auto lstore = [&](int buf) {
    unsigned char* sa = smem + buf * STAGE;
    unsigned char* sb = sa + 32768;
#pragma unroll
    for (int i = 0; i < 4; ++i) {
      const int q = tid + i * NTHR, row = q >> 3, c = q & 7;
      *(u32x4*)(sa + lds_off(row, c)) = ra[i];
    }
#pragma unroll
    for (int i = 0; i < NB; ++i) {
      const int q = tid + i * NTHR, row = q >> 3, c = q & 7;
      *(u32x4*)(sb + lds_off(row, c)) = rb[i];
    }
  };
  auto compute = [&](int kt) {
    const unsigned char* sa = smem + (kt & 1) * STAGE;
    const unsigned char* sb = sa + 32768;
#pragma unroll
    for (int s = 0; s < 4; ++s) {
      bf16x8 fa[IM], fb[2];
#pragma unroll
      for (int i = 0; i < IM; ++i) fa[i] = *(const bf16x8*)(sa + lds_off(wm * (IM * 32) + i * 32 + r, 2 * s + h));
#pragma unroll
      for (int j = 0; j < 2; ++j) fb[j] = *(const bf16x8*)(sb + lds_off(wn * 64 + j * 32 + r, 2 * s + h));
#pragma unroll
      for (int i = 0; i < IM; ++i)
#pragma unroll
        for (int j = 0; j < 2; ++j) acc[i][j] = __builtin_amdgcn_mfma_f32_32x32x16_bf16(fa[i], fb[j], acc[i][j], 0, 0, 0);
      if constexpr (BN == 256) __builtin_amdgcn_sched_barrier(0);
    }
  };
  if constexpr (!DEEP) {
    gload(0);
    lstore(0);
    __syncthreads();
    for (int kt = 0; kt < nk; ++kt) {
      if (kt + 1 < nk) gload(kt + 1);
      compute(kt);
      if (kt + 1 < nk) lstore((kt + 1) & 1);
      __syncthreads();
    }
  } else {
    u32x4 ra2[4], rb2[NB];
    auto gload2 = [&](int kt) {
#pragma unroll
      for (int i = 0; i < 4; ++i) ra2[i] = *(const u32x4*)((const char*)(A + (size_t)(m0 + 64 * i) * K + kt * 64) + voff);
#pragma unroll
      for (int i = 0; i < NB; ++i) rb2[i] = *(const u32x4*)((const char*)(Bt + (size_t)(n0 + 64 * i) * K + kt * 64) + voff);
    };
    auto lstore2 = [&](int buf) {
      unsigned char* sa = smem + buf * STAGE;
      unsigned char* sb = sa + 32768;
#pragma unroll
      for (int i = 0; i < 4; ++i) { const int q = tid + i * NTHR; *(u32x4*)(sa + lds_off(q >> 3, q & 7)) = ra2[i]; }
#pragma unroll
      for (int i = 0; i < NB; ++i) { const int q = tid + i * NTHR; *(u32x4*)(sb + lds_off(q >> 3, q & 7)) = rb2[i]; }
    };
    gload(0);
    gload2(1);
    lstore(0);
    if (2 < nk) gload(2);
    __syncthreads();
    for (int kt = 0; kt < nk; kt += 2) {
      if (kt + 1 < nk) { lstore2(1); if (kt + 3 < nk) gload2(kt + 3); }
      compute(kt);
      __syncthreads();
      if (kt + 2 < nk) { lstore(0); if (kt + 4 < nk) gload(kt + 4); }
      compute(kt + 1);
      __syncthreads();
    }
  }
#pragma unroll 1
  for (int hf = 0; hf < BN / 128; ++hf) {
    const bool mine = (wn >> 1) == hf;
    const int n0h = n0 + hf * 128, lc = (wn & 1) * 64 + r, lr = wm * (IM * 32) + 4 * h;
    if constexpr (EPI == EPI_Z) {
      u16* st = (u16*)smem;
      if (mine) {
        u16* lb = st + lr * 136 + lc;
#pragma unroll
        for (int i = 0; i < IM; ++i)
#pragma unroll
          for (int j = 0; j < 2; ++j)
#pragma unroll
            for (int e = 0; e < 16; ++e) lb[(i * 32 + (e & 3) + 8 * (e >> 2)) * 136 + j * 32] = f2bf(acc[i][j][e]);
      }
      __syncthreads();
      u16* Z = (u16*)(p.ws + WS_Z) + (size_t)m0 * N + n0h;
#pragma unroll 2
      for (int i = 0; i < 8; ++i) {
        const int q = tid + i * NTHR, row = q >> 4, c = q & 15;
        *(u32x4*)(Z + (size_t)row * N + c * 8) = *(const u32x4*)(st + row * 136 + c * 8);
      }
      __syncthreads();
    } else if constexpr (EPI == EPI_RES) {
      float* st = (float*)smem;
      if (mine) {
        float* lb = st + lr * 132 + lc;
#pragma unroll
        for (int i = 0; i < IM; ++i)
#pragma unroll
          for (int j = 0; j < 2; ++j)
#pragma unroll
            for (int e = 0; e < 16; ++e) lb[(i * 32 + (e & 3) + 8 * (e >> 2)) * 132 + j * 32] = acc[i][j][e];
      }
      __syncthreads();
      float* xw = (float*)(p.ws + WS_XW) + (size_t)m0 * D + n0h;
      const float* g1p = (const float*)(p.ws + WS_MOD) + ((size_t)l * 5 + row_cls(m0)) * 6144 + 2048 + n0h;
      const int c = tid & 31;
      const float4 g1 = *(const float4*)(g1p + c * 4);
#pragma unroll 2
      for (int i = 0; i < 16; ++i) {
        const int row = (tid >> 5) + i * 16;
        const float4 a = *(const float4*)(st + row * 132 + c * 4);
        float4 xv = *(const float4*)(xw + (size_t)row * D + c * 4);
        xv.x += g1.x * a.x; xv.y += g1.y * a.y; xv.z += g1.z * a.z; xv.w += g1.w * a.w;
        *(float4*)(xw + (size_t)row * D + c * 4) = xv;
      }
      __syncthreads();
    } else {
      float* st = (float*)smem;
      if (mine) {
        float* lb = st + lr * 129 + lc;
#pragma unroll
        for (int i = 0; i < IM; ++i)
#pragma unroll
          for (int j = 0; j < 2; ++j)
#pragma unroll
            for (int e = 0; e < 16; ++e) lb[(i * 32 + (e & 3) + 8 * (e >> 2)) * 129 + j * 32] = acc[i][j][e];
      }
      __syncthreads();
      if (tid < 256) {
        float t16[16];
#pragma unroll
        for (int i = 0; i < 16; ++i) t16[i] = __uint_as_float(0xff800000u);
        for (int kk = 0; kk < 128; ++kk) {
          const float sv = st[tid * 129 + kk];
          const float x = __uint_as_float((__float_as_uint(sv) & ~0x7fu) | (unsigned)(127 - kk));
#pragma unroll
          for (int i = 15; i >= 1; --i) t16[i] = __builtin_amdgcn_fmed3f(x, t16[i - 1], t16[i]);
          t16[0] = fmaxf(t16[0], x);
        }
        unsigned* tk = (unsigned*)(p.ws + WS_TOPK) + ((size_t)(m0 + tid) * 16 + (n0h >> 7)) * 16;
#pragma unroll
        for (int q = 0; q < 4; ++q) {
          u32x4 o; o[0] = __float_as_uint(t16[q * 4]); o[1] = __float_as_uint(t16[q * 4 + 1]); o[2] = __float_as_uint(t16[q * 4 + 2]); o[3] = __float_as_uint(t16[q * 4 + 3]);
          *(u32x4*)(tk + q * 4) = o;
        }
      }
      __syncthreads();
    }
  }
}

template <int EPI>
DI void gemm_phase(KP p, unsigned char* smem, const u16* A, const u16* Bt, int M, int N, int K, int l, int bid, int nb, int m_tiles_active, int tid) {
  const int ntn = N / 128;
  const int ntiles = m_tiles_active * ntn;
#pragma unroll 1
  for (int tile = bid; tile < ntiles; tile += nb)
    gemm_tile<EPI, 128, true>(p, smem, A, Bt, N, K, l, (tile / ntn) * 256, (tile % ntn) * 128, tid);
}

namespace pg8 {
#define PG8_LAS __attribute__((address_space(3)))
typedef unsigned short bf16_t;
typedef short bf16x8 __attribute__((ext_vector_type(8)));
typedef float f32x4 __attribute__((ext_vector_type(4)));
typedef unsigned u32x4 __attribute__((ext_vector_type(4)));
constexpr int BM = 256, BK = 64, HALF = 128, HTB = HALF * BK * 2  , STAGE_BYTES = 8 * HTB, NXCD = 8, WGM = 8;

__host__ __device__ __forceinline__ int lds_byte(int r, int c) { const int st = (r >> 4) * 2 + (c >> 5), rr = r & 15, cc = c & 31, ob = rr * 64 + cc * 2; return st * 1024 + (ob ^ (((ob >> 9) & 1) << 5)); }
__host__ __device__ __forceinline__ void stage_rc(int b, int& R, int& C) { const int st = b / 1024, sb = b % 1024, swz = sb ^ (((sb >> 9) & 1) << 5); R = (st >> 1) * 16 + swz / 64; C = (st & 1) * 32 + (swz % 64) / 2; }
__host__ __device__ __forceinline__ int perm32(int rho) { const int n = rho >> 4, i = rho & 15; return 8 * (i >> 2) + 4 * n + (i & 3); }

struct Unit { int pm, pn; };
struct Gemm { const bf16_t* A; const bf16_t* Bt; int M, N, K; };

template <class Epi, class Sched>
__device__ __forceinline__ void gemm_phase(PG8_LAS unsigned char* lds, const Gemm g, const Sched& S, const Epi& E, const int tid) {
    const int wid = __builtin_amdgcn_readfirstlane(tid >> 6), lane = tid & 63, wr = wid >> 2, wc = wid & 3, fr = lane & 15, fq = lane >> 4;
    const int K = g.K, nt = K / BK;
    unsigned voffA[2], voffB[2];
#pragma unroll
    for (int i = 0; i < 2; ++i) { int R, C; stage_rc(tid * 16 + i * 8192, R, C); const int Rb = Epi::PERM ? ((R & ~31) + perm32(R & 31)) : R;
        voffA[i] = (unsigned)(R * K + C) * 2u; voffB[i] = (unsigned)(Rb * K + C) * 2u; }
    const size_t kstep = (size_t)(BK * 2);
    const size_t hstep = (size_t)HALF * K * 2;
    const size_t tstep = 2 * hstep;
    const unsigned ldsw = (unsigned)wid * 1024u;
    const int aoff = lds_byte(wr * 64 + fr, fq * 8), boff = lds_byte(wc * 32 + fr, fq * 8);
#define PG8_SA(b, h) (((b) * 2 + (h)) * HTB)
#define PG8_SB(b, h) ((4 + (b) * 2 + (h)) * HTB)
#define PG8_STAGE(bufoff, gbase, voff) do { _Pragma("unroll") for (int _i = 0; _i < 2; ++_i) \
        __builtin_amdgcn_global_load_lds((const unsigned*)((const char*)(gbase) + (voff)[_i]), (PG8_LAS unsigned*)(lds + (bufoff) + ldsw + _i * 8192), 16, 0, 0); } while (0)
#define PG8_LDA(dst, b, h) do { _Pragma("unroll") for (int m = 0; m < 4; ++m) _Pragma("unroll") for (int k = 0; k < 2; ++k) dst[m][k] = *(const PG8_LAS bf16x8*)(lds + PG8_SA(b, h) + aoff + m * 2048 + k * 1024); } while (0)
#define PG8_LDB(dst, b, h) do { _Pragma("unroll") for (int n = 0; n < 2; ++n) _Pragma("unroll") for (int k = 0; k < 2; ++k) dst[n][k] = *(const PG8_LAS bf16x8*)(lds + PG8_SB(b, h) + boff + n * 2048 + k * 1024); } while (0)
#define PG8_MMA(ai, bj, At, Bt) do { __builtin_amdgcn_s_setprio(1); _Pragma("unroll") for (int m = 0; m < 4; ++m) _Pragma("unroll") for (int n = 0; n < 2; ++n) _Pragma("unroll") for (int k = 0; k < 2; ++k) \
        acc[ai][bj][m][n] = __builtin_amdgcn_mfma_f32_16x16x32_bf16(Bt[n][k], At[m][k], acc[ai][bj][m][n], 0, 0, 0); __builtin_amdgcn_s_setprio(0); } while (0)
#define PG8_WAIT_V(n) asm volatile("s_waitcnt vmcnt(" #n ")" ::: "memory")
#define PG8_WAIT_L(n) asm volatile("s_waitcnt lgkmcnt(" #n ")" ::: "memory")
#define PG8_BAR __builtin_amdgcn_s_barrier()
#define PG8_SCHED __builtin_amdgcn_sched_barrier(0)
    Unit cur, nxt; int ui = 0;
    if (!S.next(0, cur)) return;
    f32x4 acc[2][2][4][2];
#pragma unroll
    for (int a = 0; a < 2; ++a)
#pragma unroll
        for (int b = 0; b < 2; ++b)
#pragma unroll
            for (int m = 0; m < 4; ++m)
#pragma unroll
                for (int n = 0; n < 2; ++n) acc[a][b][m][n] = (f32x4){0.f, 0.f, 0.f, 0.f};
    bf16x8 At[4][2], B0[2][2], B1[2][2];
    const char* cA = (const char*)g.A + (size_t)cur.pm * tstep; const char* cB = (const char*)g.Bt + (size_t)cur.pn * tstep;
    S.a_ready(cur);
    PG8_STAGE(PG8_SB(0, 0), cB, voffB); PG8_STAGE(PG8_SA(0, 0), cA, voffA); PG8_STAGE(PG8_SB(0, 1), cB + hstep, voffB); PG8_STAGE(PG8_SA(0, 1), cA + hstep, voffA);
    if (wr == 1) PG8_BAR;
    PG8_WAIT_V(4); PG8_BAR;
    PG8_STAGE(PG8_SB(1, 0), cB + kstep, voffB); PG8_STAGE(PG8_SA(1, 0), cA + kstep, voffA); PG8_STAGE(PG8_SB(1, 1), cB + hstep + kstep, voffB);
    PG8_WAIT_V(6); PG8_BAR;
    for (;;) {
        const bool has_next = S.next(ui + 1, nxt);
        const char* nA = has_next ? (const char*)g.A + (size_t)nxt.pm * tstep : cA; const char* nB = has_next ? (const char*)g.Bt + (size_t)nxt.pn * tstep : cB;
        for (int t = 0; t < nt; t += 2) {
            const bool last = (t == nt - 2);
            const char* a1 = cA + (size_t)(t + 1) * kstep;
            const char* a2 = last ? nA : cA + (size_t)(t + 2) * kstep; const char* b2 = last ? nB : cB + (size_t)(t + 2) * kstep;
            const char* a3 = a2 + kstep; const char* b3 = b2 + kstep;
            if (last && has_next) S.a_ready(nxt);
            PG8_LDB(B0, 0, 0); PG8_SCHED; PG8_LDA(At, 0, 0); PG8_STAGE(PG8_SA(1, 1), a1 + hstep, voffA);
            PG8_WAIT_L(8); PG8_BAR; PG8_WAIT_L(0); PG8_MMA(0, 0, At, B0); PG8_BAR; PG8_SCHED;
            PG8_LDB(B1, 0, 1); PG8_STAGE(PG8_SB(0, 0), b2, voffB);
            PG8_BAR; PG8_WAIT_L(0); PG8_MMA(0, 1, At, B1); PG8_BAR;
            PG8_LDA(At, 0, 1); PG8_STAGE(PG8_SA(0, 0), a2, voffA);
            PG8_BAR; PG8_WAIT_L(0); PG8_MMA(1, 0, At, B0); PG8_BAR; PG8_SCHED;
            PG8_STAGE(PG8_SB(0, 1), b2 + hstep, voffB);
            PG8_WAIT_V(6); PG8_BAR; PG8_MMA(1, 1, At, B1); PG8_BAR;
            PG8_LDB(B0, 1, 0); PG8_SCHED; PG8_LDA(At, 1, 0); PG8_STAGE(PG8_SA(0, 1), a2 + hstep, voffA);
            PG8_WAIT_L(8); PG8_BAR; PG8_WAIT_L(0); PG8_MMA(0, 0, At, B0); PG8_BAR; PG8_SCHED;
            PG8_LDB(B1, 1, 1); PG8_STAGE(PG8_SB(1, 0), b3, voffB);
            PG8_BAR; PG8_WAIT_L(0); PG8_MMA(0, 1, At, B1); PG8_BAR;
            PG8_LDA(At, 1, 1); PG8_STAGE(PG8_SA(1, 0), a3, voffA);
            PG8_BAR; PG8_WAIT_L(0); PG8_MMA(1, 0, At, B0); PG8_BAR; PG8_SCHED;
            PG8_STAGE(PG8_SB(1, 1), b3 + hstep, voffB);
            PG8_WAIT_V(6); PG8_BAR; PG8_MMA(1, 1, At, B1); PG8_BAR;
        }
        if constexpr (!Epi::AFTER_DRAIN) { E(acc, cur, wr, wc, fr, fq); S.done(cur); }
        if (!has_next) break;
#pragma unroll
        for (int a = 0; a < 2; ++a)
#pragma unroll
            for (int b = 0; b < 2; ++b)
#pragma unroll
                for (int m = 0; m < 4; ++m)
#pragma unroll
                    for (int n = 0; n < 2; ++n) acc[a][b][m][n] = (f32x4){0.f, 0.f, 0.f, 0.f};
        cur = nxt; cA = nA; cB = nB; ++ui;
    }
    PG8_WAIT_V(0);
    if (wr == 0) PG8_BAR;
    PG8_BAR;
    if constexpr (Epi::AFTER_DRAIN) { E.fused(acc, cur, wr, wc, fr, fq, lds, wid, lane); S.done(cur); }
#undef PG8_SA
#undef PG8_SB
#undef PG8_STAGE
#undef PG8_LDA
#undef PG8_LDB
#undef PG8_MMA
#undef PG8_WAIT_V
#undef PG8_WAIT_L
#undef PG8_BAR
#undef PG8_SCHED
}

typedef int i32x4 __attribute__((ext_vector_type(4)));
template <class Epi, class Sched>
__device__ __forceinline__ void gemm_phase_i8(PG8_LAS unsigned char* lds, const Gemm g, const Sched& S, const Epi& E, const int tid) {
    const int wid = __builtin_amdgcn_readfirstlane(tid >> 6), lane = tid & 63, wr = wid >> 2, wc = wid & 3, fr = lane & 15, fq = lane >> 4;
    const int K = g.K  , nt = K / (2 * BK);
    unsigned voffA[2], voffB[2];
#pragma unroll
    for (int i = 0; i < 2; ++i) { int R, C; stage_rc(tid * 16 + i * 8192, R, C); const int Rb = Epi::PERM ? ((R & ~31) + perm32(R & 31)) : R;
        voffA[i] = (unsigned)(R * K + 2 * C); voffB[i] = (unsigned)(Rb * K + 2 * C); }
    const size_t kstep = (size_t)(BK * 2);
    const size_t hstep = (size_t)HALF * K;
    const size_t tstep = 2 * hstep;
    const unsigned ldsw = (unsigned)wid * 1024u;
    const int aoff = lds_byte(wr * 64 + fr, fq * 8), boff = lds_byte(wc * 32 + fr, fq * 8);
#define PG8_SA(b, h) (((b) * 2 + (h)) * HTB)
#define PG8_SB(b, h) ((4 + (b) * 2 + (h)) * HTB)
#define PG8_STAGE(bufoff, gbase, voff) do { _Pragma("unroll") for (int _i = 0; _i < 2; ++_i) \
        __builtin_amdgcn_global_load_lds((const unsigned*)((const char*)(gbase) + (voff)[_i]), (PG8_LAS unsigned*)(lds + (bufoff) + ldsw + _i * 8192), 16, 0, 0); } while (0)
#define PG8_LDA(dst, b, h) do { _Pragma("unroll") for (int m = 0; m < 4; ++m) _Pragma("unroll") for (int k = 0; k < 2; ++k) dst[m][k] = *(const PG8_LAS bf16x8*)(lds + PG8_SA(b, h) + aoff + m * 2048 + k * 1024); } while (0)
#define PG8_LDB(dst, b, h) do { _Pragma("unroll") for (int n = 0; n < 2; ++n) _Pragma("unroll") for (int k = 0; k < 2; ++k) dst[n][k] = *(const PG8_LAS bf16x8*)(lds + PG8_SB(b, h) + boff + n * 2048 + k * 1024); } while (0)
#define PG8_MMA(ai, bj, At, Bt) do { __builtin_amdgcn_s_setprio(1); _Pragma("unroll") for (int m = 0; m < 4; ++m) _Pragma("unroll") for (int n = 0; n < 2; ++n) _Pragma("unroll") for (int k = 0; k < 2; ++k) \
        acc[ai][bj][m][n] = __builtin_amdgcn_mfma_i32_16x16x64_i8(__builtin_bit_cast(i32x4, Bt[n][k]), __builtin_bit_cast(i32x4, At[m][k]), acc[ai][bj][m][n], 0, 0, 0); __builtin_amdgcn_s_setprio(0); } while (0)
#define PG8_WAIT_V(n) asm volatile("s_waitcnt vmcnt(" #n ")" ::: "memory")
#define PG8_WAIT_L(n) asm volatile("s_waitcnt lgkmcnt(" #n ")" ::: "memory")
#define PG8_BAR __builtin_amdgcn_s_barrier()
#define PG8_SCHED __builtin_amdgcn_sched_barrier(0)
    Unit cur, nxt; int ui = 0;
    if (!S.next(0, cur)) return;
    i32x4 acc[2][2][4][2];
#pragma unroll
    for (int a = 0; a < 2; ++a)
#pragma unroll
        for (int b = 0; b < 2; ++b)
#pragma unroll
            for (int m = 0; m < 4; ++m)
#pragma unroll
                for (int n = 0; n < 2; ++n) acc[a][b][m][n] = (i32x4){0, 0, 0, 0};
    bf16x8 At[4][2], B0[2][2], B1[2][2];
    const char* cA = (const char*)g.A + (size_t)cur.pm * tstep; const char* cB = (const char*)g.Bt + (size_t)cur.pn * tstep;
    S.a_ready(cur);
    PG8_STAGE(PG8_SB(0, 0), cB, voffB); PG8_STAGE(PG8_SA(0, 0), cA, voffA); PG8_STAGE(PG8_SB(0, 1), cB + hstep, voffB); PG8_STAGE(PG8_SA(0, 1), cA + hstep, voffA);
    if (wr == 1) PG8_BAR;
    PG8_WAIT_V(4); PG8_BAR;
    PG8_STAGE(PG8_SB(1, 0), cB + kstep, voffB); PG8_STAGE(PG8_SA(1, 0), cA + kstep, voffA); PG8_STAGE(PG8_SB(1, 1), cB + hstep + kstep, voffB);
    PG8_WAIT_V(6); PG8_BAR;
    for (;;) {
        const bool has_next = S.next(ui + 1, nxt);
        const char* nA = has_next ? (const char*)g.A + (size_t)nxt.pm * tstep : cA; const char* nB = has_next ? (const char*)g.Bt + (size_t)nxt.pn * tstep : cB;
        for (int t = 0; t < nt; t += 2) {
            const bool last = (t == nt - 2);
            const char* a1 = cA + (size_t)(t + 1) * kstep;
            const char* a2 = last ? nA : cA + (size_t)(t + 2) * kstep; const char* b2 = last ? nB : cB + (size_t)(t + 2) * kstep;
            const char* a3 = a2 + kstep; const char* b3 = b2 + kstep;
            if (last && has_next) S.a_ready(nxt);
            PG8_LDB(B0, 0, 0); PG8_SCHED; PG8_LDA(At, 0, 0); PG8_STAGE(PG8_SA(1, 1), a1 + hstep, voffA);
            PG8_WAIT_L(8); PG8_BAR; PG8_WAIT_L(0); PG8_MMA(0, 0, At, B0); PG8_BAR; PG8_SCHED;
            PG8_LDB(B1, 0, 1); PG8_STAGE(PG8_SB(0, 0), b2, voffB);
            PG8_BAR; PG8_WAIT_L(0); PG8_MMA(0, 1, At, B1); PG8_BAR;
            PG8_LDA(At, 0, 1); PG8_STAGE(PG8_SA(0, 0), a2, voffA);
            PG8_BAR; PG8_WAIT_L(0); PG8_MMA(1, 0, At, B0); PG8_BAR; PG8_SCHED;
            PG8_STAGE(PG8_SB(0, 1), b2 + hstep, voffB);
            PG8_WAIT_V(6); PG8_BAR; PG8_MMA(1, 1, At, B1); PG8_BAR;
            PG8_LDB(B0, 1, 0); PG8_SCHED; PG8_LDA(At, 1, 0); PG8_STAGE(PG8_SA(0, 1), a2 + hstep, voffA);
            PG8_WAIT_L(8); PG8_BAR; PG8_WAIT_L(0); PG8_MMA(0, 0, At, B0); PG8_BAR; PG8_SCHED;
            PG8_LDB(B1, 1, 1); PG8_STAGE(PG8_SB(1, 0), b3, voffB);
            PG8_BAR; PG8_WAIT_L(0); PG8_MMA(0, 1, At, B1); PG8_BAR;
            PG8_LDA(At, 1, 1); PG8_STAGE(PG8_SA(1, 0), a3, voffA);
            PG8_BAR; PG8_WAIT_L(0); PG8_MMA(1, 0, At, B0); PG8_BAR; PG8_SCHED;
            PG8_STAGE(PG8_SB(1, 1), b3 + hstep, voffB);
            PG8_WAIT_V(6); PG8_BAR; PG8_MMA(1, 1, At, B1); PG8_BAR;
        }
        if constexpr (!Epi::AFTER_DRAIN) { E(acc, cur, wr, wc, fr, fq); S.done(cur); }
        if (!has_next) break;
#pragma unroll
        for (int a = 0; a < 2; ++a)
#pragma unroll
            for (int b = 0; b < 2; ++b)
#pragma unroll
                for (int m = 0; m < 4; ++m)
#pragma unroll
                    for (int n = 0; n < 2; ++n) acc[a][b][m][n] = (i32x4){0, 0, 0, 0};
        cur = nxt; cA = nA; cB = nB; ++ui;
    }
    PG8_WAIT_V(0);
    if (wr == 0) PG8_BAR;
    PG8_BAR;
    if constexpr (Epi::AFTER_DRAIN) { E.fused(acc, cur, wr, wc, fr, fq, lds, wid, lane); S.done(cur); }
#undef PG8_SA
#undef PG8_SB
#undef PG8_STAGE
#undef PG8_LDA
#undef PG8_LDB
#undef PG8_MMA
#undef PG8_WAIT_V
#undef PG8_WAIT_L
#undef PG8_BAR
#undef PG8_SCHED
}

struct LinOrder {
  int nN, nunits, G, c;
  __device__ __forceinline__ bool next(int i, Unit& u) const { const int L = i * G + c; if (L >= nunits) return false; u.pm = L / nN; u.pn = L % nN; return true; }
  __device__ __forceinline__ void a_ready(const Unit&) const {}
  __device__ __forceinline__ void done(const Unit&) const {}
};
struct OneUnit {
  Unit u0;
  __device__ __forceinline__ bool next(int i, Unit& u) const { if (i) return false; u = u0; return true; }
  __device__ __forceinline__ void a_ready(const Unit&) const {}
  __device__ __forceinline__ void done(const Unit&) const {}
};
struct EpiZ {
  static constexpr bool PERM = true, AFTER_DRAIN = false;
  bf16_t* O; int ldc;
  __device__ __forceinline__ void operator()(const f32x4 (&acc)[2][2][4][2], const Unit& u, int wr, int wc, int fr, int fq) const {
    const int row0 = u.pm * BM + wr * 64 + fr, col0 = u.pn * BM + wc * 32 + 8 * fq;
#pragma unroll
    for (int ai = 0; ai < 2; ++ai)
#pragma unroll
      for (int m = 0; m < 4; ++m) { bf16_t* rowp = O + (size_t)(row0 + ai * HALF + m * 16) * ldc + col0;
#pragma unroll
        for (int bj = 0; bj < 2; ++bj) { const f32x4 v0 = acc[ai][bj][m][0], v1 = acc[ai][bj][m][1];
          u32x4 w; w.x = ::pack2(v0[0], v0[1]); w.y = ::pack2(v0[2], v0[3]); w.z = ::pack2(v1[0], v1[1]); w.w = ::pack2(v1[2], v1[3]);
          *(u32x4*)(rowp + bj * HALF) = w; } }
  }
};
struct EpiRes {
  static constexpr bool PERM = true, AFTER_DRAIN = false;
  bf16_t* xw; const float* modl;
  __device__ __forceinline__ void operator()(const f32x4 (&acc)[2][2][4][2], const Unit& u, int wr, int wc, int fr, int fq) const {
    const int row0 = u.pm * BM + wr * 64 + fr, col0 = u.pn * BM + wc * 32 + 8 * fq;
    const float* g1p = modl + (size_t)::row_cls(u.pm * BM) * 6144 + 2048 + col0;
    f32x4 gv[2][2];
#pragma unroll
    for (int bj = 0; bj < 2; ++bj)
#pragma unroll
      for (int n = 0; n < 2; ++n) gv[bj][n] = *(const f32x4*)(g1p + bj * HALF + 4 * n);
#pragma unroll
    for (int ai = 0; ai < 2; ++ai)
#pragma unroll
      for (int m = 0; m < 4; ++m) { bf16_t* rowp = xw + (size_t)(row0 + ai * HALF + m * 16) * 1024 + col0;
#pragma unroll
        for (int bj = 0; bj < 2; ++bj) { const f32x4 v0 = acc[ai][bj][m][0], v1 = acc[ai][bj][m][1];
          u32x4 w = *(const u32x4*)(rowp + bj * HALF);
          w.x = ::pack2(::bflo(w.x) + gv[bj][0][0] * v0[0], ::bfhi(w.x) + gv[bj][0][1] * v0[1]); w.y = ::pack2(::bflo(w.y) + gv[bj][0][2] * v0[2], ::bfhi(w.y) + gv[bj][0][3] * v0[3]);
          w.z = ::pack2(::bflo(w.z) + gv[bj][1][0] * v1[0], ::bfhi(w.z) + gv[bj][1][1] * v1[1]); w.w = ::pack2(::bflo(w.w) + gv[bj][1][2] * v1[2], ::bfhi(w.w) + gv[bj][1][3] * v1[3]);
          *(u32x4*)(rowp + bj * HALF) = w; } }
  }
};
struct EpiTopk {
  static constexpr bool PERM = false, AFTER_DRAIN = true;
  unsigned* topk;
  __device__ __forceinline__ void operator()(const f32x4 (&)[2][2][4][2], const Unit&, int, int, int, int) const {}
  __device__ __forceinline__ void fused(const f32x4 (&acc)[2][2][4][2], const Unit& u, int wr, int wc, int fr, int fq, PG8_LAS unsigned char* lds, int wid, int lane) const {
    PG8_LAS float* st = (PG8_LAS float*)lds;
    const int tid = wid * 64 + lane;
#pragma unroll 1
    for (int bj = 0; bj < 2; ++bj) {
#pragma unroll
      for (int ai = 0; ai < 2; ++ai)
#pragma unroll
        for (int m = 0; m < 4; ++m)
#pragma unroll
          for (int n = 0; n < 2; ++n) {
            PG8_LAS float* q = st + (ai * HALF + wr * 64 + m * 16 + fr) * 129 + wc * 32 + n * 16 + 4 * fq;
            const f32x4 v = bj == 0 ? acc[ai][0][m][n] : acc[ai][1][m][n];
            q[0] = v[0]; q[1] = v[1]; q[2] = v[2]; q[3] = v[3];
          }
      asm volatile("s_waitcnt lgkmcnt(0)" ::: "memory"); __builtin_amdgcn_s_barrier(); asm volatile("" ::: "memory");
      if (tid < 256) {
        float t16[16];
#pragma unroll
        for (int i = 0; i < 16; ++i) t16[i] = __uint_as_float(0xff800000u);
        for (int kk = 0; kk < 128; ++kk) {
          const float sv = st[tid * 129 + kk];
          const float x = __uint_as_float((__float_as_uint(sv) & ~0x7fu) | (unsigned)(127 - kk));
#pragma unroll
          for (int i = 15; i >= 1; --i) t16[i] = __builtin_amdgcn_fmed3f(x, t16[i - 1], t16[i]);
          t16[0] = fmaxf(t16[0], x);
        }
        unsigned* tk = topk + ((size_t)(u.pm * BM + tid) * 16 + (u.pn * 2 + bj)) * 16;
#pragma unroll
        for (int q = 0; q < 4; ++q) {
          u32x4 o; o.x = __float_as_uint(t16[q * 4]); o.y = __float_as_uint(t16[q * 4 + 1]); o.z = __float_as_uint(t16[q * 4 + 2]); o.w = __float_as_uint(t16[q * 4 + 3]);
          *(u32x4*)(tk + q * 4) = o;
        }
      }
      asm volatile("s_waitcnt lgkmcnt(0)" ::: "memory"); __builtin_amdgcn_s_barrier(); asm volatile("" ::: "memory");
    }
  }
};
struct EpiZI8 {
  static constexpr bool PERM = true, AFTER_DRAIN = false;
  bf16_t* O; int ldc; const float* rsc; const float* csc;
  __device__ __forceinline__ void operator()(const i32x4 (&acc)[2][2][4][2], const Unit& u, int wr, int wc, int fr, int fq) const {
    const int row0 = u.pm * BM + wr * 64 + fr, col0 = u.pn * BM + wc * 32 + 8 * fq;
    f32x4 cs[2][2];
#pragma unroll
    for (int bj = 0; bj < 2; ++bj)
#pragma unroll
      for (int n = 0; n < 2; ++n) cs[bj][n] = *(const f32x4*)(csc + col0 + bj * HALF + 4 * n);
#pragma unroll
    for (int ai = 0; ai < 2; ++ai)
#pragma unroll
      for (int m = 0; m < 4; ++m) { const int row = row0 + ai * HALF + m * 16; const float rs = rsc[row]; bf16_t* rowp = O + (size_t)row * ldc + col0;
#pragma unroll
        for (int bj = 0; bj < 2; ++bj) { const i32x4 a0 = acc[ai][bj][m][0], a1 = acc[ai][bj][m][1];
          u32x4 w;
          w.x = ::pack2((float)a0[0] * rs * cs[bj][0][0], (float)a0[1] * rs * cs[bj][0][1]); w.y = ::pack2((float)a0[2] * rs * cs[bj][0][2], (float)a0[3] * rs * cs[bj][0][3]);
          w.z = ::pack2((float)a1[0] * rs * cs[bj][1][0], (float)a1[1] * rs * cs[bj][1][1]); w.w = ::pack2((float)a1[2] * rs * cs[bj][1][2], (float)a1[3] * rs * cs[bj][1][3]);
          *(u32x4*)(rowp + bj * HALF) = w; } }
  }
};
struct EpiTopkI8 {
  static constexpr bool PERM = false, AFTER_DRAIN = true;
  unsigned* topk; const float* rsc; const float* csc;
  __device__ __forceinline__ void operator()(const i32x4 (&)[2][2][4][2], const Unit&, int, int, int, int) const {}
  __device__ __forceinline__ void fused(const i32x4 (&acc)[2][2][4][2], const Unit& u, int wr, int wc, int fr, int fq, PG8_LAS unsigned char* lds, int wid, int lane) const {
    PG8_LAS float* st = (PG8_LAS float*)lds;
    const int tid = wid * 64 + lane;
    float rs[2][4];
#pragma unroll
    for (int ai = 0; ai < 2; ++ai)
#pragma unroll
      for (int m = 0; m < 4; ++m) rs[ai][m] = rsc[u.pm * BM + ai * HALF + wr * 64 + m * 16 + fr];
#pragma unroll 1
    for (int bj = 0; bj < 2; ++bj) {
      f32x4 cs[2];
#pragma unroll
      for (int n = 0; n < 2; ++n) cs[n] = *(const f32x4*)(csc + u.pn * BM + bj * HALF + wc * 32 + n * 16 + 4 * fq);
#pragma unroll
      for (int ai = 0; ai < 2; ++ai)
#pragma unroll
        for (int m = 0; m < 4; ++m)
#pragma unroll
          for (int n = 0; n < 2; ++n) {
            PG8_LAS float* q = st + (ai * HALF + wr * 64 + m * 16 + fr) * 129 + wc * 32 + n * 16 + 4 * fq;
            const i32x4 v = bj == 0 ? acc[ai][0][m][n] : acc[ai][1][m][n];
            q[0] = (float)v[0] * rs[ai][m] * cs[n][0]; q[1] = (float)v[1] * rs[ai][m] * cs[n][1]; q[2] = (float)v[2] * rs[ai][m] * cs[n][2]; q[3] = (float)v[3] * rs[ai][m] * cs[n][3];
          }
      asm volatile("s_waitcnt lgkmcnt(0)" ::: "memory"); __builtin_amdgcn_s_barrier(); asm volatile("" ::: "memory");
      if (tid < 256) {
        float t16[16];
#pragma unroll
        for (int i = 0; i < 16; ++i) t16[i] = __uint_as_float(0xff800000u);
        for (int kk = 0; kk < 128; ++kk) {
          const float sv = st[tid * 129 + kk];
          const float x = __uint_as_float((__float_as_uint(sv) & ~0x7fu) | (unsigned)(127 - kk));
#pragma unroll
          for (int i = 15; i >= 1; --i) t16[i] = __builtin_amdgcn_fmed3f(x, t16[i - 1], t16[i]);
          t16[0] = fmaxf(t16[0], x);
        }
        unsigned* tk = topk + ((size_t)(u.pm * BM + tid) * 16 + (u.pn * 2 + bj)) * 16;
#pragma unroll
        for (int q = 0; q < 4; ++q) {
          u32x4 o; o.x = __float_as_uint(t16[q * 4]); o.y = __float_as_uint(t16[q * 4 + 1]); o.z = __float_as_uint(t16[q * 4 + 2]); o.w = __float_as_uint(t16[q * 4 + 3]);
          *(u32x4*)(tk + q * 4) = o;
        }
      }
      asm volatile("s_waitcnt lgkmcnt(0)" ::: "memory"); __builtin_amdgcn_s_barrier(); asm volatile("" ::: "memory");
    }
  }
};
}

enum { G8_Z = 0, G8_RES = 1, G8_TOPK = 2 };
template <int EPI>
DI void gemm8_phase(KP p, unsigned char* smem, const u16* A, const u16* Bt, int N, int K, int l, int bid, int nb, int m_tiles_active, int tid) {
  pg8::Gemm g{A, Bt, m_tiles_active * 256, N, K};
  const int nN = N / 256, nunits = m_tiles_active * nN;
  PG8_LAS unsigned char* lds = (PG8_LAS unsigned char*)smem;
  if constexpr (EPI == G8_Z) {
    pg8::LinOrder S{nN, nunits, nb, bid};
    pg8::Gemm g8{(const pg8::bf16_t*)(p.ws + WS_HXQ), (const pg8::bf16_t*)(p.ws + WS_WINQ + (size_t)l * 4096 * 1024), m_tiles_active * 256, N, K};
    pg8::EpiZI8 E{(pg8::bf16_t*)(p.ws + WS_Z), N, (const float*)(p.ws + WS_HXS), (const float*)(p.ws + WS_WINS) + (size_t)l * 4096};
    pg8::gemm_phase_i8<pg8::EpiZI8, pg8::LinOrder>(lds, g8, S, E, tid);
  } else if constexpr (EPI == G8_RES) {
    pg8::LinOrder S{nN, nunits, nb, bid};
    pg8::EpiRes E{(pg8::bf16_t*)(p.ws + WS_XW), (const float*)(p.ws + WS_MOD) + (size_t)l * 5 * 6144};
    pg8::gemm_phase<pg8::EpiRes, pg8::LinOrder>(lds, g, S, E, tid);
  } else {
    pg8::Gemm g8{(const pg8::bf16_t*)(p.ws + WS_HXQ), (const pg8::bf16_t*)(p.ws + WS_WSQ + (size_t)l * 2048 * 1024), m_tiles_active * 256, N, K};
    pg8::EpiTopkI8 E{(unsigned*)(p.ws + WS_TOPK), (const float*)(p.ws + WS_HXS), (const float*)(p.ws + WS_WSS) + (size_t)l * 2048};
#pragma unroll 1
    for (int L = bid; L < nunits; L += nb) {
      pg8::OneUnit S{pg8::Unit{L / nN, L % nN}};
      pg8::gemm_phase_i8<pg8::EpiTopkI8, pg8::OneUnit>(lds, g8, S, E, tid);
    }
  }
  __syncthreads();
  if constexpr (EPI == G8_Z) {
    const int rem = nunits % nb;
    if (l + 1 < DEPTH && rem != 0 && bid >= rem) p0_mod_groups(p, (float*)smem, 192 * (l + 1), bid - rem, nb - rem, tid);
  }
  if constexpr (EPI == G8_RES || EPI == G8_TOPK) {
    const int rem = nunits % nb;
    if (l + 1 < DEPTH && rem != 0 && bid >= rem) {
      const float* src = (EPI == G8_RES ? p.peer_u : p.peer_v);
      unsigned char* dst = p.ws + (EPI == G8_RES ? WS_UB : WS_VB);
      float* scl = (float*)(p.ws + (EPI == G8_RES ? WS_US : WS_VS));
#pragma unroll 1
      for (int it = bid - rem; it < 256; it += nb - rem) p0_quant_rows(src, dst, scl, (l + 1) * NEXP + it * 64, tid, 0.f);
    }
  }
}

constexpr float LOG2E = 1.4426950408889634f;
DI int seg_row0(int b, int j) { return j < 2 ? NLAT + b * CTXL + 128 * j : b * SEQ + 128 * (j - 2); }
DI int pi_bwd(int j) { return j < 2 ? 1 - j : 35 - j; }
DI float ex2(float x) { return __builtin_amdgcn_exp2f(x); }
DI unsigned sw32(int row, int col) { return (unsigned)(row * 64 + ((((col >> 3) ^ ((row >> 2) & 3))) << 4) + (col & 7) * 2); }
DI bf16x8 pack8(float a0, float a1, float a2, float a3, float a4, float a5, float a6, float a7) {
  u32x4 p; p[0] = pack2(a0, a1); p[1] = pack2(a2, a3); p[2] = pack2(a4, a5); p[3] = pack2(a6, a7);
  return __builtin_bit_cast(bf16x8, p);
}
DI bf16x8 cat8(u32x2 lo, u32x2 hi) { u32x4 p; p[0] = lo[0]; p[1] = lo[1]; p[2] = hi[0]; p[3] = hi[1]; return __builtin_bit_cast(bf16x8, p); }

DI void rec_pass1(KP p, unsigned char* smem, int l, int item, int tid) {
  const int j = item % 34, bh = item / 34, b = bh >> 2, hd = bh & 3;
  const int R0 = seg_row0(b, j);
  const int lane = tid & 63, wave = tid >> 6, r = lane & 31, h = lane >> 5;
  unsigned char* KOT = smem;
  unsigned char* VT = smem + 65536;
  float* TX = (float*)(smem + 98304);
  const u16* Z = (const u16*)(p.ws + WS_Z);
  const int k = tid & 127, qd = tid >> 7;
  unsigned char* STG = smem + 100352;
  u32x4 pre[4];
  auto gstage = [&](int colbase) {
#pragma unroll
    for (int u = 0; u < 4; ++u) { const int q = tid + NTHR * u; pre[u] = *(const u32x4*)(Z + (size_t)(R0 + (q >> 4)) * INC + colbase + (q & 15) * 8); }
  };
  auto wstage = [&]() {
#pragma unroll
    for (int u = 0; u < 4; ++u) { const int q = tid + NTHR * u; *(u32x4*)(STG + q * 16) = pre[u]; }
  };
  gstage(hd * 128);
  wstage();
  __syncthreads();
  gstage(512 + hd * 128);
  {
    u16 vv[32];
#pragma unroll
    for (int ii = 0; ii < 32; ++ii) vv[ii] = *(const u16*)(STG + (32 * qd + ii) * 256 + k * 2);
#pragma unroll
    for (int c4 = 0; c4 < 4; ++c4) {
      u32x4 o;
#pragma unroll
      for (int e = 0; e < 4; ++e) o[e] = (unsigned)vv[c4 * 8 + 2 * e] | ((unsigned)vv[c4 * 8 + 2 * e + 1] << 16);
      *(u32x4*)(VT + sw128(k, 32 * qd + 8 * c4)) = o;
    }
  }
  __syncthreads();
#pragma unroll 1
  for (int d = 0; d < 2; ++d) {
    wstage();
    __syncthreads();
    if (d == 0) gstage(1024 + hd * 128);
    const float lb = ((const float*)(p.ws + WS_LOWER))[((size_t)l * 2 + d) * 512 + hd * 128 + k];
    float lf[32], kk[32];
    float tot = 0.f;
#pragma unroll
    for (int ii = 0; ii < 32; ++ii) {
      const float z = bf2f(*(const u16*)(STG + (32 * qd + ii) * 256 + k * 2));
      const float sg = __builtin_amdgcn_rcpf(1.f + ex2(-z * LOG2E));
      const float f = fmaxf(lb + (1.f - lb) * sg, 1e-20f);
      lf[ii] = __builtin_amdgcn_logf(f);
      kk[ii] = (1.f - lb) * (1.f - sg);
      tot += lf[ii];
    }
    TX[qd * 128 + k] = tot;
    __syncthreads();
    const float t0 = TX[k], t1 = TX[128 + k], t2 = TX[256 + k], t3 = TX[384 + k];
    float run;
    if (d == 0) run = (qd == 0 ? t1 + t2 + t3 : qd == 1 ? t2 + t3 : qd == 2 ? t3 : 0.f);
    else run = (qd == 0 ? 0.f : qd == 1 ? t0 : qd == 2 ? t0 + t1 : t0 + t1 + t2);
    float ko[32];
    if (d == 0) {
#pragma unroll
      for (int ii = 31; ii >= 0; --ii) { ko[ii] = kk[ii] * ex2(run); run += lf[ii]; }
    } else {
#pragma unroll
      for (int ii = 0; ii < 32; ++ii) { ko[ii] = kk[ii] * ex2(run); run += lf[ii]; }
    }
#pragma unroll
    for (int c4 = 0; c4 < 4; ++c4) {
      u32x4 o;
#pragma unroll
      for (int e = 0; e < 4; ++e) o[e] = pack2(ko[c4 * 8 + 2 * e], ko[c4 * 8 + 2 * e + 1]);
      *(u32x4*)(KOT + d * 32768 + sw128(k, 32 * qd + 8 * c4)) = o;
    }
    if (qd == 0) {
      const int pi = d ? pi_bwd(j) : j;
      ((float*)(p.ws + WS_DT))[((size_t)(bh * 2 + d) * 34 + pi) * 128 + k] = ex2(t0 + t1 + t2 + t3);
    }
    __syncthreads();
  }
  {
    const int d = wave >> 2, w4 = wave & 3;
    f32x16 acc[4];
#pragma unroll
    for (int mt = 0; mt < 4; ++mt)
#pragma unroll
      for (int e = 0; e < 16; ++e) acc[mt][e] = 0.f;
#pragma unroll
    for (int ks = 0; ks < 8; ++ks) {
      const bf16x8 bv = *(const bf16x8*)(VT + sw128(32 * w4 + r, 16 * ks + 8 * h));
#pragma unroll
      for (int mt = 0; mt < 4; ++mt) {
        const bf16x8 av = *(const bf16x8*)(KOT + d * 32768 + sw128(32 * mt + r, 16 * ks + 8 * h));
        acc[mt] = __builtin_amdgcn_mfma_f32_32x32x16_bf16(av, bv, acc[mt], 0, 0, 0);
      }
    }
    const int pi = d ? pi_bwd(j) : j;
    u16* sl = (u16*)(p.ws + WS_SLOC) + ((size_t)(bh * 2 + d) * 34 + pi) * 16384;
#pragma unroll
    for (int mt = 0; mt < 4; ++mt)
#pragma unroll
      for (int g = 0; g < 4; ++g) {
        u32x2 o; o[0] = pack2(acc[mt][4 * g], acc[mt][4 * g + 1]); o[1] = pack2(acc[mt][4 * g + 2], acc[mt][4 * g + 3]);
        *(u32x2*)(sl + ((((w4 * 4 + mt) * 4 + g) * 64 + lane) * 4)) = o;
      }
  }
  __syncthreads();
}

DI void rec_pass2(KP p, int bid, int nb, int tid) {
  const u16* SL = (const u16*)(p.ws + WS_SLOC);
  u16* SS = (u16*)(p.ws + WS_SST);
  const float* DT = (const float*)(p.ws + WS_DT);
  for (int gid = bid * NTHR + tid; gid < 32 * 4096; gid += nb * NTHR) {
    const int seq = gid >> 12, grp = gid & 4095;
    const int lane = grp & 63, g = (grp >> 6) & 3, mt = (grp >> 8) & 3;
    const int k0 = 32 * mt + 8 * g + 4 * (lane >> 5);
    const u16* sl = SL + (size_t)seq * 34 * 16384 + grp * 4;
    u16* ss = SS + (size_t)seq * 34 * 16384 + grp * 4;
    const float* dt = DT + (size_t)seq * 34 * 128 + k0;
    float s0 = 0.f, s1 = 0.f, s2 = 0.f, s3 = 0.f;
#pragma unroll 3
    for (int pi = 0; pi < 33; ++pi) {
      const u32x2 w = *(const u32x2*)(sl + (size_t)pi * 16384);
      const float4 dd = *(const float4*)(dt + pi * 128);
      s0 = dd.x * s0 + bflo(w[0]); s1 = dd.y * s1 + bfhi(w[0]); s2 = dd.z * s2 + bflo(w[1]); s3 = dd.w * s3 + bfhi(w[1]);
      u32x2 o; o[0] = pack2(s0, s1); o[1] = pack2(s2, s3);
      *(u32x2*)(ss + (size_t)(pi + 1) * 16384) = o;
    }
  }
}

DI void rec_pass3(KP p, unsigned char* smem, int l, int item, int tid) {
  const int j = item % 34, bh = item / 34, b = bh >> 2, hd = bh & 3;
  const int R0 = seg_row0(b, j);
  const int lane = tid & 63, wave = tid >> 6, r = lane & 31, h = lane >> 5;
  const int d = tid >> 8, tt = tid & 255, w4 = wave & 3;
  unsigned char* base = smem + d * 67584;
  unsigned char* SZ = base, *SQ = base + 8192, *SV = base + 16384;
  unsigned char* QT = base + 24576, *KT = base + 32768, *QI = base + 40960, *KOT = base + 49152, *VT = base + 57344;
  float* DTc = (float*)(base + 65536);
  float* TX = (float*)(base + 66048);
  const u16* Z = (const u16*)(p.ws + WS_Z);
  u16* O = (u16*)(p.ws + (d ? WS_OB : WS_OF));
  const int pi = d ? pi_bwd(j) : j;
  f32x16 S[4];
  if (pi == 0) {
#pragma unroll
    for (int mt = 0; mt < 4; ++mt)
#pragma unroll
      for (int e = 0; e < 16; ++e) S[mt][e] = 0.f;
  } else {
    const u16* ss = (const u16*)(p.ws + WS_SST) + ((size_t)(bh * 2 + d) * 34 + pi) * 16384;
#pragma unroll
    for (int mt = 0; mt < 4; ++mt)
#pragma unroll
      for (int g = 0; g < 4; ++g) {
        const u32x2 w = *(const u32x2*)(ss + ((((w4 * 4 + mt) * 4 + g) * 64 + lane) * 4));
        S[mt][4 * g] = bflo(w[0]); S[mt][4 * g + 1] = bfhi(w[0]); S[mt][4 * g + 2] = bflo(w[1]); S[mt][4 * g + 3] = bfhi(w[1]);
      }
  }
  const int k = tt & 127, half = tt >> 7;
  const float lb = ((const float*)(p.ws + WS_LOWER))[((size_t)l * 2 + d) * 512 + hd * 128 + k];
  const int zg_col = (d ? 1024 : 512) + hd * 128, q_col = 1536 + hd * 128, v_col = hd * 128;
  u32x4 pz[2], pq[2], pv[2];
  auto gl = [&](int c) {
#pragma unroll
    for (int u = 0; u < 2; ++u) {
      const int q = tt + 256 * u, i = q >> 4, c16 = q & 15;
      const int n = d ? (127 - 32 * c - i) : (32 * c + i);
      const u16* zr = Z + (size_t)(R0 + n) * INC + c16 * 8;
      pz[u] = *(const u32x4*)(zr + zg_col); pq[u] = *(const u32x4*)(zr + q_col); pv[u] = *(const u32x4*)(zr + v_col);
    }
  };
  gl(0);
#pragma unroll 1
  for (int c = 0; c < 4; ++c) {
#pragma unroll
    for (int u = 0; u < 2; ++u) {
      const int q = tt + 256 * u;
      *(u32x4*)(SZ + q * 16) = pz[u]; *(u32x4*)(SQ + q * 16) = pq[u]; *(u32x4*)(SV + q * 16) = pv[u];
    }
    __syncthreads();
    if (c + 1 < 4) gl(c + 1);
    {
      float cc = 0.f;
#pragma unroll
      for (int ii = 0; ii < 16; ++ii) {
        const int i = 16 * half + ii;
        const float z = bf2f(*(const u16*)(SZ + i * 256 + k * 2));
        const float sg = __builtin_amdgcn_rcpf(1.f + ex2(-z * LOG2E));
        const float f = fmaxf(lb + (1.f - lb) * sg, 1e-20f);
        cc += __builtin_amdgcn_logf(f);
      }
      TX[half * 128 + k] = cc;
    }
    __syncthreads();
    {
      const float T0 = TX[k], T1 = TX[128 + k];
      const float e0 = ex2(T0), e1 = ex2(T1);
      float ko[16];
      float cc = 0.f;
#pragma unroll
      for (int ii = 0; ii < 16; ++ii) {
        const int i = 16 * half + ii;
        const float z = bf2f(*(const u16*)(SZ + i * 256 + k * 2));
        const float sg = __builtin_amdgcn_rcpf(1.f + ex2(-z * LOG2E));
        const float f = fmaxf(lb + (1.f - lb) * sg, 1e-20f);
        cc += __builtin_amdgcn_logf(f);
        const float kk = (1.f - lb) * (1.f - sg);
        const float qq = bf2f(*(const u16*)(SQ + i * 256 + k * 2));
        float qt, qi, kt;
        if (half == 0) {
          qt = qq * ex2(fminf(cc - T0, 120.f)); qi = qq * ex2(cc);
          kt = kk * ex2(T0 - cc); ko[ii] = kt * e1;
        } else {
          qt = qq * ex2(cc); qi = qt * e0;
          kt = kk * ex2(fminf(-cc, 120.f)); ko[ii] = kk * ex2(T1 - cc);
        }
        *(u16*)(QT + sw128(i, k)) = f2bf(qt); *(u16*)(KT + sw128(i, k)) = f2bf(kt); *(u16*)(QI + sw128(i, k)) = f2bf(qi);
      }
      if (half == 0) DTc[k] = e0 * e1;
      u32x4 o0, o1;
#pragma unroll
      for (int e = 0; e < 4; ++e) { o0[e] = pack2(ko[2 * e], ko[2 * e + 1]); o1[e] = pack2(ko[8 + 2 * e], ko[8 + 2 * e + 1]); }
      *(u32x4*)(KOT + sw32(k, 16 * half)) = o0; *(u32x4*)(KOT + sw32(k, 16 * half + 8)) = o1;
      u32x4 v0, v1;
#pragma unroll
      for (int e = 0; e < 4; ++e) {
        v0[e] = (unsigned)*(const u16*)(SV + (16 * half + 2 * e) * 256 + k * 2) | ((unsigned)*(const u16*)(SV + (16 * half + 2 * e + 1) * 256 + k * 2) << 16);
        v1[e] = (unsigned)*(const u16*)(SV + (16 * half + 8 + 2 * e) * 256 + k * 2) | ((unsigned)*(const u16*)(SV + (16 * half + 8 + 2 * e + 1) * 256 + k * 2) << 16);
      }
      *(u32x4*)(VT + sw32(k, 16 * half)) = v0; *(u32x4*)(VT + sw32(k, 16 * half + 8)) = v1;
    }
    __syncthreads();
    {
      f32x16 X;
#pragma unroll
      for (int e = 0; e < 16; ++e) X[e] = 0.f;
#pragma unroll 2
      for (int ks = 0; ks < 8; ++ks) {
        const bf16x8 a = *(const bf16x8*)(KT + sw128(r, 16 * ks + 8 * h));
        const bf16x8 bq = *(const bf16x8*)(QT + sw128(r, 16 * ks + 8 * h));
        X = __builtin_amdgcn_mfma_f32_32x32x16_bf16(a, bq, X, 0, 0, 0);
      }
#pragma unroll
      for (int e = 0; e < 16; ++e) { const int sidx = (e & 3) + 8 * (e >> 2) + 4 * h; if (sidx > r) X[e] = 0.f; }
      f32x16 o;
#pragma unroll
      for (int e = 0; e < 16; ++e) o[e] = 0.f;
#pragma unroll
      for (int s2 = 0; s2 < 2; ++s2) {
        const bf16x8 xa = pack8(X[8 * s2], X[8 * s2 + 1], X[8 * s2 + 2], X[8 * s2 + 3], X[8 * s2 + 4], X[8 * s2 + 5], X[8 * s2 + 6], X[8 * s2 + 7]);
        const u32x2 lo = *(const u32x2*)(VT + sw32(32 * w4 + r, 16 * s2 + 4 * h));
        const u32x2 hi = *(const u32x2*)(VT + sw32(32 * w4 + r, 16 * s2 + 8 + 4 * h));
        o = __builtin_amdgcn_mfma_f32_32x32x16_bf16(xa, cat8(lo, hi), o, 0, 0, 0);
      }
#pragma unroll
      for (int mt = 0; mt < 4; ++mt)
#pragma unroll
        for (int s2 = 0; s2 < 2; ++s2) {
          const bf16x8 sb = pack8(S[mt][8 * s2], S[mt][8 * s2 + 1], S[mt][8 * s2 + 2], S[mt][8 * s2 + 3], S[mt][8 * s2 + 4], S[mt][8 * s2 + 5], S[mt][8 * s2 + 6], S[mt][8 * s2 + 7]);
          const u32x2 lo = *(const u32x2*)(QI + sw128(r, 32 * mt + 16 * s2 + 4 * h));
          const u32x2 hi = *(const u32x2*)(QI + sw128(r, 32 * mt + 16 * s2 + 8 + 4 * h));
          o = __builtin_amdgcn_mfma_f32_32x32x16_bf16(cat8(lo, hi), sb, o, 0, 0, 0);
          if (s2 == 1) __builtin_amdgcn_sched_barrier(0);
        }
#pragma unroll
      for (int mt = 0; mt < 4; ++mt)
#pragma unroll
        for (int g = 0; g < 4; ++g) {
          const float4 dd = *(const float4*)(DTc + 32 * mt + 8 * g + 4 * h);
          S[mt][4 * g] *= dd.x; S[mt][4 * g + 1] *= dd.y; S[mt][4 * g + 2] *= dd.z; S[mt][4 * g + 3] *= dd.w;
        }
#pragma unroll
      for (int s2 = 0; s2 < 2; ++s2) {
        const bf16x8 bv = *(const bf16x8*)(VT + sw32(32 * w4 + r, 16 * s2 + 8 * h));
#pragma unroll
        for (int mt = 0; mt < 4; ++mt) {
          const bf16x8 av = *(const bf16x8*)(KOT + sw32(32 * mt + r, 16 * s2 + 8 * h));
          S[mt] = __builtin_amdgcn_mfma_f32_32x32x16_bf16(av, bv, S[mt], 0, 0, 0);
        }
      }
#pragma unroll
      for (int e = 0; e < 16; ++e) {
        const int i = (e & 3) + 8 * (e >> 2) + 4 * h;
        const int n = d ? (127 - 32 * c - i) : (32 * c + i);
        O[(size_t)(R0 + n) * 512 + hd * 128 + 32 * w4 + r] = f2bf(o[e]);
      }
    }
  }
  __syncthreads();
}

DI void conv_rows8(KP p, int l, int row0, int tid) {
  const int lane = tid & 63, row = row0 + (tid >> 6);
  const int ch = lane * 8;
  const u16* Z = (const u16*)(p.ws + WS_Z);
  u16* cat = (u16*)(p.ws + WS_CAT);
  const float* cw = p.conv_w + (size_t)l * 3 * 512 + ch;
  int rm, rp; bool hm, hp_;
  if (row < NLAT) {
    const int t = row & 4095, gr = t >> 6, gc = t & 63;
    if (ch < 256) { hm = gc > 0; hp_ = gc < 63; rm = row - 1; rp = row + 1; }
    else { hm = gr > 0; hp_ = gr < 63; rm = row - 64; rp = row + 64; }
  } else {
    const int t = (row - NLAT) & 255;
    hm = t > 0; hp_ = t < 255; rm = row - 1; rp = row + 1;
  }
  if (!hm) rm = row;
  if (!hp_) rp = row;
  const u32x4 c0 = *(const u32x4*)(Z + (size_t)row * INC + 2560 + ch), h0 = *(const u32x4*)(Z + (size_t)row * INC + 3584 + ch);
  const u32x4 cm = *(const u32x4*)(Z + (size_t)rm * INC + 2560 + ch), hmv = *(const u32x4*)(Z + (size_t)rm * INC + 3584 + ch);
  const u32x4 cp = *(const u32x4*)(Z + (size_t)rp * INC + 2560 + ch), hpv = *(const u32x4*)(Z + (size_t)rp * INC + 3584 + ch);
  const u32x4 bgv = *(const u32x4*)(Z + (size_t)row * INC + 3072 + ch);
  const float4 w0a = *(const float4*)cw, w0b = *(const float4*)(cw + 4);
  const float4 w1a = *(const float4*)(cw + 512), w1b = *(const float4*)(cw + 516);
  const float4 w2a = *(const float4*)(cw + 1024), w2b = *(const float4*)(cw + 1028);
  const float w0[8] = {w0a.x, w0a.y, w0a.z, w0a.w, w0b.x, w0b.y, w0b.z, w0b.w};
  const float w1[8] = {w1a.x, w1a.y, w1a.z, w1a.w, w1b.x, w1b.y, w1b.z, w1b.w};
  const float w2[8] = {w2a.x, w2a.y, w2a.z, w2a.w, w2b.x, w2b.y, w2b.z, w2b.w};
  const float fm = hm ? 1.f : 0.f, fp = hp_ ? 1.f : 0.f;
  u32x4 o;
#pragma unroll
  for (int e = 0; e < 4; ++e) {
    float r2[2];
#pragma unroll
    for (int hh = 0; hh < 2; ++hh) {
      const float uc = (hh ? bfhi(c0[e]) : bflo(c0[e])) * (hh ? bfhi(h0[e]) : bflo(h0[e]));
      const float um = (hh ? bfhi(cm[e]) : bflo(cm[e])) * (hh ? bfhi(hmv[e]) : bflo(hmv[e]));
      const float up = (hh ? bfhi(cp[e]) : bflo(cp[e])) * (hh ? bfhi(hpv[e]) : bflo(hpv[e]));
      const float bg = hh ? bfhi(bgv[e]) : bflo(bgv[e]);
      r2[hh] = bg * (w1[2 * e + hh] * uc + fm * w0[2 * e + hh] * um + fp * w2[2 * e + hh] * up);
    }
    o[e] = pack2(r2[0], r2[1]);
  }
  *(u32x4*)(cat + (size_t)row * D + 512 + ch) = o;
}

DI void phase_rec1(KP p, unsigned char* smem, int l, int bid, int nb, int tid) {
  const int nitems = 544 + NTOK / 8;
  for (int it = bid; it < nitems; it += nb) {
    if (it < 544) rec_pass1(p, smem, l, it, tid);
    else conv_rows8(p, l, (it - 544) * 8, tid);
  }
}
DI void phase_rec3(KP p, unsigned char* smem, int l, int bid, int nb, int tid) {
  for (int it = bid; it < 544; it += nb) {
    if (l == DEPTH - 1 && (it % 34) < 2) continue;
    rec_pass3(p, smem, l, it, tid);
  }
}

DI void phase_recpost(KP p, int l, int bid, int nb, int tid) {
  const int lane = tid & 63, wave = tid >> 6;
  const u16* OF = (const u16*)(p.ws + WS_OF);
  const u16* OB = (const u16*)(p.ws + WS_OB);
  const u16* Z = (const u16*)(p.ws + WS_Z);
  u16* cat = (u16*)(p.ws + WS_CAT);
  for (int row = bid * 8 + wave; row < NTOK; row += nb * 8) {
    const u32x4 af = *(const u32x4*)(OF + (size_t)row * 512 + lane * 8), ab = *(const u32x4*)(OB + (size_t)row * 512 + lane * 8);
    float o[8];
#pragma unroll
    for (int e = 0; e < 4; ++e) { o[2 * e] = bflo(af[e]) + bflo(ab[e]); o[2 * e + 1] = bfhi(af[e]) + bfhi(ab[e]); }
    float ss = 0.f;
#pragma unroll
    for (int e = 0; e < 8; ++e) ss += o[e] * o[e];
    ss += __shfl_xor(ss, 1); ss += __shfl_xor(ss, 2); ss += __shfl_xor(ss, 4); ss += __shfl_xor(ss, 8);
    const float rs = rsqrtf(ss * (1.f / 128.f) + EPS);
    const u32x4 gw = *(const u32x4*)(Z + (size_t)row * INC + 2048 + lane * 8);
    u32x4 ow;
#pragma unroll
    for (int e = 0; e < 4; ++e) {
      const float g0 = bflo(gw[e]), g1 = bfhi(gw[e]);
      ow[e] = pack2(o[2 * e] * rs * siluf_(g0), o[2 * e + 1] * rs * siluf_(g1));
    }
    *(u32x4*)(cat + (size_t)row * D + lane * 8) = ow;
  }
}

DI float gelu_erf(float x) { return 0.5f * x * (1.f + erff(x * 0.70710678118654752f)); }

using i32x4 = __attribute__((ext_vector_type(4))) int;
constexpr int PM_CF = 0, PM_WG = 32768, PM_HQ = 65536, PM_CM = 65536, PM_IB = 65536, PM_MISC = 133120;
DI unsigned pm_perm(unsigned hi, unsigned lo, unsigned sel) { return __builtin_amdgcn_perm(hi, lo, sel); }

DI void peer_mfma_pass(KP p, unsigned char* smem, int l, int row0, int ntok, int tid) {
  const int lane = tid & 63, wave = __builtin_amdgcn_readfirstlane(tid >> 6);
  const int ngroups = (ntok + 15) >> 4;
  const int nwg = ngroups >= 4 ? 2 : 8;
  const int tg = ngroups >= 4 ? (wave >> 1) : 0, ch = ngroups >= 4 ? (wave & 1) : wave;
  float* CF = (float*)(smem + PM_CF);
  unsigned* WG = (unsigned*)(smem + PM_WG);
  unsigned char* HQ = smem + PM_HQ;
  unsigned short* CM = (unsigned short*)(smem + PM_CM);
  unsigned* CNT = (unsigned*)(smem + PM_MISC);
  float* HS = (float*)(smem + PM_MISC) + 128;
  unsigned* CMAX = (unsigned*)(smem + PM_MISC) + 192;
  float* SS = (float*)(smem + PM_MISC) + 256;
  const unsigned char* UB = p.ws + WS_UB + (size_t)l * NEXP * D;
  const unsigned char* VB = p.ws + WS_VB + (size_t)l * NEXP * D;
  const float* US = (const float*)(p.ws + WS_US) + (size_t)l * NEXP;
  const float* VS = (const float*)(p.ws + WS_VS) + (size_t)l * NEXP;
  const float* mod = (const float*)(p.ws + WS_MOD);
#ifdef PROBE_ABC
#pragma unroll 1
  for (int arep = 0; arep < 2; ++arep) {
#endif
  if (tid < 128) CNT[tid] = 0u;
  if (tid < 64) { CMAX[tid] = 0u; SS[tid] = 0.f; }
  __syncthreads();
  unsigned ent[16], slot[16];
  const bool actA = tid < ntok * 8;
  if (actA) {
    const int t = tid >> 3, head = tid & 7;
    unsigned char* IB = smem + PM_IB + tid * 32;
    const unsigned* t1 = (const unsigned*)(p.ws + WS_TOPK) + ((size_t)(row0 + t) * 16 + head * 2) * 16;
    float s1[16], s2[16];
#pragma unroll
    for (int q = 0; q < 4; ++q) {
      const u32x4 a = *(const u32x4*)(t1 + q * 4), b = *(const u32x4*)(t1 + 16 + q * 4);
#pragma unroll
      for (int e = 0; e < 4; ++e) {
        s1[q * 4 + e] = __uint_as_float(a[e]); s2[q * 4 + e] = __uint_as_float(b[e]);
        IB[q * 4 + e] = (unsigned char)(127u - (a[e] & 127u));
        IB[16 + q * 4 + e] = (unsigned char)(127u - (b[e] & 127u));
      }
    }
    float t16[16];
#pragma unroll
    for (int i = 0; i < 16; ++i) t16[i] = __uint_as_float(0xff800000u);
#pragma unroll
    for (int i = 0; i < 16; ++i)
#pragma unroll
      for (int j = 0; j < 16; ++j)
        if ((i + 1) * (j + 1) <= 16) {
          const float sm = s1[i] + s2[j];
          const float x = __uint_as_float((__float_as_uint(sm) & ~0xffu) | (unsigned)(255 - (i * 16 + j)));
#pragma unroll
          for (int q = 15; q >= 1; --q) t16[q] = __builtin_amdgcn_fmed3f(x, t16[q - 1], t16[q]);
          t16[0] = fmaxf(t16[0], x);
        }
    float den = 0.f;
#pragma unroll
    for (int i = 0; i < 16; ++i) den += __expf(t16[i] - t16[0]);
    const float inv = 16383.f / den;
    const unsigned mtag = (unsigned)(t & 15) << 14;
    unsigned* cg = CNT + (t >> 4) * 32;
#pragma unroll
    for (int i = 0; i < 16; ++i) {
      const unsigned ci = 255u - (__float_as_uint(t16[i]) & 255u);
      const unsigned i1 = IB[ci >> 4], i2 = IB[16 + (ci & 15)];
      const unsigned gq = (unsigned)(int)rintf(__expf(t16[i] - t16[0]) * inv);
      const unsigned en = ((i1 * 128u + i2) << 18) | mtag | gq;
      ent[i] = en;
      slot[i] = atomicAdd(&cg[en >> 27], 1u);
    }
  }
  __syncthreads();
  if (tid < 128) {
    const unsigned c = CNT[tid];
    unsigned inc = c;
#pragma unroll
    for (int o = 1; o < 32; o <<= 1) { const unsigned v = __shfl_up(inc, o); if ((lane & 31) >= o) inc += v; }
    CNT[tid] = inc - c;
  }
  __syncthreads();
  if (actA) {
    const int t = tid >> 3;
    unsigned* wg = WG + (t >> 4) * 2048;
    const unsigned* cg = CNT + (t >> 4) * 32;
#pragma unroll
    for (int i = 0; i < 16; ++i) wg[cg[ent[i] >> 27] + slot[i]] = ent[i];
  }
  __syncthreads();
#pragma unroll 1
  for (int i = 0; i < 8; ++i) {
    const int t = wave * 8 + i;
    if (t < ntok) {
      const u32x4 pk = *(const u32x4*)(p.ws + WS_HXQ + (size_t)(row0 + t) * D + lane * 16);
      const float sc = ((const float*)(p.ws + WS_HXS))[row0 + t];
      *(u32x4*)(HQ + t * 1024 + lane * 16) = pk;
      if (lane == 0) HS[t] = sc;
    }
  }
  __syncthreads();
#ifdef PROBE_ABC
  }
#endif
  const bool gact = tg < ngroups;
  const int nt_g = gact ? ((ntok - tg * 16) < 16 ? (ntok - tg * 16) : 16) : 0;
  const int nent = nt_g * 128;
  const unsigned* wg = WG + tg * 2048;
  float* cfg = CF + tg * 2048;
  const int mrow = lane & 15, kq = lane >> 4;
  i32x4 areg[16];
  if (gact) {
    const int tsrc = (mrow < nt_g) ? (tg * 16 + mrow) : (tg * 16);
#pragma unroll
    for (int s2 = 0; s2 < 16; ++s2) areg[s2] = *(const i32x4*)(HQ + tsrc * 1024 + 64 * s2 + 16 * kq);
  }
  __syncthreads();
#ifdef PROBE_U2
#pragma unroll 1
  for (int urep = 0; urep < 2; ++urep)
#endif
  if (gact) {
#ifdef PROBE_U2
    const unsigned uemask = urep == 0 ? PROBE_EMASK : 0xffffffffu;
#else
    const unsigned uemask = 0xffffffffu;
#endif
    unsigned char* ust = smem + PM_HQ + wave * 8320;
    const int nch = nent >> 4;
    u32x4 rr[8];
    auto gl8 = [&](int k0) {
#pragma unroll
      for (int j = 0; j < 8; ++j) {
        const unsigned en = (unsigned)__builtin_amdgcn_readfirstlane((int)wg[k0 + j]) & uemask;
        rr[j] = *(const u32x4*)(UB + (size_t)(en >> 18) * D + lane * 16);
      }
    };
    if (ch < nch) gl8(16 * ch);
#pragma unroll 1
    for (int c = ch; c < nch; c += nwg) {
      const unsigned en_cur = wg[16 * c + mrow];
      const unsigned e = en_cur >> 18;
      const float us = US[e], vs = VS[e];
      i32x4 d0 = {0, 0, 0, 0}, d1 = {0, 0, 0, 0};
#pragma unroll
      for (int j = 0; j < 8; ++j) *(u32x4*)(ust + j * 1040 + lane * 16) = rr[j];
      gl8(16 * c + 8);
#pragma unroll
      for (int s2 = 0; s2 < 16; ++s2) {
        const i32x4 b = *(const i32x4*)(ust + (mrow & 7) * 1040 + 64 * s2 + 16 * kq);
        d0 = __builtin_amdgcn_mfma_i32_16x16x64_i8(areg[s2], b, d0, 0, 0, 0);
        if ((s2 & 3) == 3) __builtin_amdgcn_sched_barrier(0);
      }
#pragma unroll
      for (int j = 0; j < 8; ++j) *(u32x4*)(ust + j * 1040 + lane * 16) = rr[j];
      if (c + nwg < nch) gl8(16 * (c + nwg));
#pragma unroll
      for (int s2 = 0; s2 < 16; ++s2) {
        const i32x4 b = *(const i32x4*)(ust + (mrow & 7) * 1040 + 64 * s2 + 16 * kq);
        d1 = __builtin_amdgcn_mfma_i32_16x16x64_i8(areg[s2], b, d1, 0, 0, 0);
        if ((s2 & 3) == 3) __builtin_amdgcn_sched_barrier(0);
      }
      const int mp = (int)((en_cur >> 14) & 15u);
      if ((mp >> 2) == kq) {
        const int r = mp & 3;
        const i32x4 dd = mrow < 8 ? d0 : d1;
        const int dv = r == 0 ? dd[0] : r == 1 ? dd[1] : r == 2 ? dd[2] : dd[3];
        const float dot = us * HS[tg * 16 + mp] * (float)dv;
        const float cf = (float)(en_cur & 0x3fffu) * (1.f / 16383.f) * gelu_erf(dot) * vs;
        cfg[16 * c + mrow] = cf;
        atomicMax(&CMAX[tg * 16 + mp], __float_as_uint(fabsf(cf)));
      }
    }
  }
  __syncthreads();
  for (int k = tid; k < ngroups * 2048; k += NTHR) {
    const int g2 = k >> 11;
    const int ntg = (ntok - g2 * 16) < 16 ? (ntok - g2 * 16) : 16;
    if ((k & 2047) < ntg * 128) {
      const unsigned en = WG[k];
      const unsigned m = (en >> 14) & 15u;
      const float cmx = __uint_as_float(CMAX[g2 * 16 + m]);
      const float q = cmx > 0.f ? rintf(CF[k] * (127.f / cmx)) : 0.f;
      CM[k] = (unsigned short)((m << 8) | (((unsigned)(int)q) & 0xffu));
    }
  }
  __syncthreads();
  if (gact) {
    const int i16 = lane & 15, kq = lane >> 4;
    const unsigned short* cmg = CM + tg * 2048;
    const int nch = nent >> 5;
    float csc[4];
#pragma unroll
    for (int r = 0; r < 4; ++r) csc[r] = __uint_as_float(CMAX[tg * 16 + 4 * kq + r]) * (1.f / 127.f);
#pragma unroll 1
    for (int cbp = 0; cbp < 8 / nwg; ++cbp) {
      const int colb = (1024 / nwg) * ch + 128 * cbp + 8 * i16;
      i32x4 acc[8];
#ifdef PROBE_V2
#pragma unroll 1
      for (int vrep = 0; vrep < 2; ++vrep) {
      const unsigned vemask = vrep == 0 ? PROBE_EMASK : 0xffffffffu;
#else
      const unsigned vemask = 0xffffffffu;
#endif
#pragma unroll
      for (int c = 0; c < 8; ++c) acc[c] = (i32x4){0, 0, 0, 0};
      u32x2 x[8];
      if (nch > 0) {
        const u32x4 w0 = *(const u32x4*)(wg + 8 * kq), w1 = *(const u32x4*)(wg + 8 * kq + 4);
#pragma unroll
        for (int j = 0; j < 4; ++j) {
          x[j] = *(const u32x2*)(VB + (size_t)((w0[j] & vemask) >> 18) * D + colb);
          x[4 + j] = *(const u32x2*)(VB + (size_t)((w1[j] & vemask) >> 18) * D + colb);
        }
      }
#pragma unroll 1
      for (int c = 0; c < nch; ++c) {
        unsigned ylo[8], yhi[8];
#pragma unroll
        for (int w = 0; w < 2; ++w) {
          {
            const unsigned t0 = pm_perm(x[1][w], x[0][w], 0x05010400u), t1 = pm_perm(x[1][w], x[0][w], 0x07030602u);
            const unsigned t2 = pm_perm(x[3][w], x[2][w], 0x05010400u), t3 = pm_perm(x[3][w], x[2][w], 0x07030602u);
            ylo[4 * w + 0] = pm_perm(t2, t0, 0x05040100u); ylo[4 * w + 1] = pm_perm(t2, t0, 0x07060302u);
            ylo[4 * w + 2] = pm_perm(t3, t1, 0x05040100u); ylo[4 * w + 3] = pm_perm(t3, t1, 0x07060302u);
          }
          {
            const unsigned t0 = pm_perm(x[5][w], x[4][w], 0x05010400u), t1 = pm_perm(x[5][w], x[4][w], 0x07030602u);
            const unsigned t2 = pm_perm(x[7][w], x[6][w], 0x05010400u), t3 = pm_perm(x[7][w], x[6][w], 0x07030602u);
            yhi[4 * w + 0] = pm_perm(t2, t0, 0x05040100u); yhi[4 * w + 1] = pm_perm(t2, t0, 0x07060302u);
            yhi[4 * w + 2] = pm_perm(t3, t1, 0x05040100u); yhi[4 * w + 3] = pm_perm(t3, t1, 0x07060302u);
          }
        }
        const u32x4 cmv = *(const u32x4*)(cmg + 32 * c + 8 * kq);
        unsigned alo = 0, ahi = 0;
#pragma unroll
        for (int j = 0; j < 8; ++j) {
          const unsigned hw = (cmv[j >> 1] >> (16 * (j & 1))) & 0xffffu;
          const unsigned bv = ((hw >> 8) == (unsigned)i16) ? (hw & 0xffu) : 0u;
          if (j < 4) alo |= bv << (8 * j); else ahi |= bv << (8 * (j - 4));
        }
        if (c + 1 < nch) {
          const u32x4 w0 = *(const u32x4*)(wg + 32 * (c + 1) + 8 * kq), w1 = *(const u32x4*)(wg + 32 * (c + 1) + 8 * kq + 4);
#pragma unroll
          for (int j = 0; j < 4; ++j) {
            x[j] = *(const u32x2*)(VB + (size_t)((w0[j] & vemask) >> 18) * D + colb);
            x[4 + j] = *(const u32x2*)(VB + (size_t)((w1[j] & vemask) >> 18) * D + colb);
          }
        }
        const i32x4 av = {(int)alo, (int)ahi, 0, 0};
#pragma unroll
        for (int cc = 0; cc < 8; ++cc) {
          const i32x4 bv = {(int)ylo[cc], (int)yhi[cc], 0, 0};
          acc[cc] = __builtin_amdgcn_mfma_i32_16x16x64_i8(av, bv, acc[cc], 0, 0, 0);
        }
      }
#ifdef PROBE_V2
      }
#endif
#pragma unroll
      for (int r = 0; r < 4; ++r) {
        const int m = 4 * kq + r;
        if (m < nt_g) {
          const int row = row0 + tg * 16 + m;
          const float* g2p = mod + ((size_t)l * 5 + row_cls(row)) * 6144 + 5120 + colb;
          u16* xr = (u16*)(p.ws + WS_XW) + (size_t)row * D + colb;
          u32x4 xw4 = *(const u32x4*)xr;
#pragma unroll
          for (int q = 0; q < 2; ++q) {
            const float4 gv = *(const float4*)(g2p + q * 4);
            xw4[2 * q] = pack2(bflo(xw4[2 * q]) + gv.x * csc[r] * (float)acc[q * 4 + 0][r], bfhi(xw4[2 * q]) + gv.y * csc[r] * (float)acc[q * 4 + 1][r]);
            xw4[2 * q + 1] = pack2(bflo(xw4[2 * q + 1]) + gv.z * csc[r] * (float)acc[q * 4 + 2][r], bfhi(xw4[2 * q + 1]) + gv.w * csc[r] * (float)acc[q * 4 + 3][r]);
          }
          *(u32x4*)xr = xw4;
        }
      }
    }
  }
  asm volatile("s_waitcnt vmcnt(0)" ::: "memory");
  __syncthreads();
  __builtin_amdgcn_fence(__ATOMIC_ACQUIRE, "agent");
  asm volatile("s_waitcnt vmcnt(0)" ::: "memory");
#ifdef PROBE_E2
#pragma unroll 1
  for (int erep = 0; erep < 2; ++erep)
#endif
#pragma unroll 1
  for (int i = 0; i < 8; ++i) {
    const int t = wave * 8 + i;
    if (t < ntok) {
      const int row = row0 + t;
      const int cls = row_cls(row);
      const u16* xr = (const u16*)(p.ws + WS_XW) + (size_t)row * D + lane * 16;
      float xn[16];
      float ssq = 0.f;
      {
        const u32x4 w0 = *(const u32x4*)xr, w1 = *(const u32x4*)(xr + 8);
#pragma unroll
        for (int e = 0; e < 4; ++e) { xn[2 * e] = bflo(w0[e]); xn[2 * e + 1] = bfhi(w0[e]); xn[8 + 2 * e] = bflo(w1[e]); xn[8 + 2 * e + 1] = bfhi(w1[e]); }
#pragma unroll
        for (int e = 0; e < 16; ++e) ssq += xn[e] * xn[e];
      }
      ssq = wave_sum(ssq);
      const float rs = rsqrtf(ssq * (1.f / 1024.f) + EPS);
      if (l < DEPTH - 1) {
        const float* ng = p.norm1_g + (size_t)(l + 1) * D + lane * 16;
        const float* mr = mod + ((size_t)(l + 1) * 5 + cls) * 6144 + lane * 16;
        float y[16];
#pragma unroll
        for (int q = 0; q < 4; ++q) {
          const float4 n4 = *(const float4*)(ng + q * 4), sc4 = *(const float4*)(mr + 1024 + q * 4), sh4 = *(const float4*)(mr + q * 4);
          y[q * 4 + 0] = xn[q * 4 + 0] * rs * n4.x * (1.f + sc4.x) + sh4.x; y[q * 4 + 1] = xn[q * 4 + 1] * rs * n4.y * (1.f + sc4.y) + sh4.y;
          y[q * 4 + 2] = xn[q * 4 + 2] * rs * n4.z * (1.f + sc4.z) + sh4.z; y[q * 4 + 3] = xn[q * 4 + 3] * rs * n4.w * (1.f + sc4.w) + sh4.w;
        }
        {
          float am = 0.f;
#pragma unroll
          for (int e = 0; e < 16; ++e) am = fmaxf(am, fabsf(y[e]));
#pragma unroll
          for (int o2 = 32; o2 >= 1; o2 >>= 1) am = fmaxf(am, __shfl_xor(am, o2));
          const float qs = am > 0.f ? am * (1.f / 127.f) : 1.f, qi = 1.f / qs;
          u32x4 oq;
#pragma unroll
          for (int q = 0; q < 4; ++q) {
            unsigned w = 0;
#pragma unroll
            for (int e = 0; e < 4; ++e) w |= (((unsigned)(int)rintf(y[q * 4 + e] * qi)) & 0xffu) << (8 * e);
            oq[q] = w;
          }
          *(u32x4*)(p.ws + WS_HXQ + (size_t)row * D + lane * 16) = oq;
          if (lane == 0) ((float*)(p.ws + WS_HXS))[row] = qs;
        }
      } else {
        const float* fg = p.final_g + lane * 16;
        float* orow = p.out + (size_t)row * D + lane * 16;
#pragma unroll
        for (int q = 0; q < 4; ++q) {
          const float4 f4 = *(const float4*)(fg + q * 4);
          *(float4*)(orow + q * 4) = make_float4(xn[q * 4] * rs * f4.x, xn[q * 4 + 1] * rs * f4.y, xn[q * 4 + 2] * rs * f4.z, xn[q * 4 + 3] * rs * f4.w);
        }
      }
    }
  }
  __syncthreads();
}

DI void phase_peer_mfma(KP p, unsigned char* smem, int l, int bid, int nb, int tid) {
  const int npass = (l < DEPTH - 1) ? 2 : 1;
#pragma unroll 1
  for (int ps = 0; ps < npass; ++ps) {
    const int nt = ps == 0 ? 64 : 4;
    const int base = ps == 0 ? 0 : NLAT, lim = ps == 0 ? NLAT : NTOK;
#pragma unroll 1
    for (int r0 = base + bid * nt; r0 < lim; r0 += nb * nt) peer_mfma_pass(p, smem, l, r0, nt, tid);
  }
}

constexpr int PH_PER_LAYER = 9;
constexpr int N_PHASES = 2 + DEPTH * PH_PER_LAYER;
constexpr int SMEM_BYTES = 256 * 132 * 4;

#ifndef ONLYMASK
#define ONLYMASK 0xffff
#endif
#define PHON(x) ((ONLYMASK >> (x)) & 1)
DI void run_phase(KP p, unsigned char* smem, int ph, int bid, int nb, int tid) {
  if (ph == 0) { if (PHON(10)) phase_p0a(p, (float*)smem, bid, nb, tid); return; }
  if (ph == 1) { if (PHON(4)) { phase_norm<true>(p, p.norm1_g, 0, 0, 1024, bid, nb, NTOK, tid, true); phase_rowq(p, WS_WS, WS_WSQ, WS_WSS, 4 * 2048, bid, nb, tid); phase_rowq(p, WS_WIN, WS_WINQ, WS_WINS, 4 * 4096, bid, nb, tid); } return; }
  const int l = (ph - 2) / PH_PER_LAYER, s = (ph - 2) % PH_PER_LAYER;
  const bool last = (l == DEPTH - 1);
  switch (s) {
    case 0: if (PHON(0)) gemm8_phase<G8_Z>(p, smem, (const u16*)(p.ws + WS_HX), (const u16*)(p.ws + WS_WIN) + (size_t)l * 4096 * 1024, 4096, 1024, l, bid, nb, NTOK / 256, tid); break;
    case 1: if (PHON(7)) phase_rec1(p, smem, l, bid, nb, tid); break;
    case 2: if (PHON(8)) rec_pass2(p, bid, nb, tid); break;
    case 3: if (PHON(9)) phase_rec3(p, smem, l, bid, nb, tid); break;
    case 4: if (PHON(2)) phase_recpost(p, l, bid, nb, tid); break;
    case 5: if (PHON(3)) gemm8_phase<G8_RES>(p, smem, (const u16*)(p.ws + WS_CAT), (const u16*)(p.ws + WS_WOUT) + (size_t)l * 1024 * 1024, 1024, 1024, l, bid, nb, last ? NLAT / 256 : NTOK / 256, tid); break;
    case 6: if (PHON(4)) phase_norm(p, p.norm2_g + (size_t)l * D, l, 3072, 4096, bid, nb, last ? NLAT : NTOK, tid, true); break;
    case 7: if (PHON(5)) gemm8_phase<G8_TOPK>(p, smem, (const u16*)(p.ws + WS_HX), (const u16*)(p.ws + WS_WS) + (size_t)l * 2048 * 1024, 2048, 1024, l, bid, nb, last ? NLAT / 256 : NTOK / 256, tid); break;
    case 8: if (PHON(6)) phase_peer_mfma(p, smem, l, bid, nb, tid); break;
  }
}


#define XB_TMO      128
#define XB_XCNT(j)  (256  + 64 * (j))
#define XB_XSUB(j)  (1280 + 64 * (j))
#define XB_XGEN(j)  (2304 + 64 * (j))
#define XB_TOP      3328
#define XB_TOPGEN   3392
#define XCD_BAR_WORDS 3456
#define XB_SPIN_CAP (1u << 22)
#define LAS __attribute__((address_space(3)))
DI unsigned xb_ld(unsigned* p)              { return __hip_atomic_load(p, __ATOMIC_RELAXED, __HIP_MEMORY_SCOPE_AGENT); }
DI unsigned xb_add(unsigned* p, unsigned v) { return __hip_atomic_fetch_add(p, v, __ATOMIC_RELAXED, __HIP_MEMORY_SCOPE_AGENT); }
DI unsigned xb_xcc_id() { return (unsigned)__builtin_amdgcn_s_getreg((3 << 11) | 20) & 0xFu; }
#define XB_SPIN(cond, bar) do { unsigned _sp = 0; while (cond) { __builtin_amdgcn_s_sleep(1); \
    if ((++_sp & 255u) == 0u) { if (xb_ld(&(bar)[XB_TMO])) break; if (_sp > XB_SPIN_CAP) { atomicAdd(&(bar)[XB_TMO], 1u); break; } } } } while (0)
struct XcdBarrier { unsigned* bar; unsigned x; volatile LAS unsigned* st; };
DI XcdBarrier xcd_barrier_post(unsigned* bar, volatile LAS unsigned* st) {
  XcdBarrier b; b.bar = bar; b.x = xb_xcc_id(); b.st = st;
  if (threadIdx.x == 0) (void)xb_add(&bar[XB_XCNT(b.x)], 1u);
  return b;
}
DI void xcd_barrier_complete(unsigned* bar, unsigned x, unsigned& nloc, unsigned& nx) {
  const unsigned G = gridDim.x * gridDim.y * gridDim.z;
  unsigned sum, cnt, mine, sp = 0u;
  for (;;) {
    sum = 0u; cnt = 0u; mine = 0u;
#pragma unroll
    for (unsigned j = 0; j < 16; ++j) { const unsigned c = xb_ld(&bar[XB_XCNT(j)]); sum += c; cnt += (c > 0u) ? 1u : 0u; mine = (j == x) ? c : mine; }
    if (sum == G) break;
    __builtin_amdgcn_s_sleep(1);
    if ((++sp & 255u) == 0u) { if (xb_ld(&bar[XB_TMO])) break; if (sp > XB_SPIN_CAP) { atomicAdd(&bar[XB_TMO], 1u); break; } }
  }
  nloc = mine > 0u ? mine : 1u; nx = cnt > 0u ? cnt : 1u;
}
DI void xcd_barrier(const XcdBarrier& b) {
  asm volatile("s_waitcnt vmcnt(0)" ::: "memory");
  __syncthreads();
  if (threadIdx.x == 0) {
    unsigned* bar = b.bar;
    __builtin_amdgcn_s_waitcnt(0);
    unsigned nloc = b.st[0], nx = b.st[1];
    if (nloc == 0u) { xcd_barrier_complete(bar, b.x, nloc, nx); b.st[0] = nloc; b.st[1] = nx; }
    const unsigned old = xb_add(&bar[XB_XSUB(b.x)], 1u);
    const unsigned gen = old / nloc;
    if (old + 1u == (gen + 1u) * nloc) {
      __builtin_amdgcn_fence(__ATOMIC_RELEASE, "agent");
      asm volatile("s_waitcnt vmcnt(0)" ::: "memory");
      const unsigned og = xb_add(&bar[XB_TOP], 1u);
      const unsigned tg = og / nx;
      if (og + 1u == (tg + 1u) * nx) xb_add(&bar[XB_TOPGEN], 1u);
      else XB_SPIN(xb_ld(&bar[XB_TOPGEN]) == tg, bar);
      __builtin_amdgcn_fence(__ATOMIC_ACQUIRE, "agent");
      xb_add(&bar[XB_XGEN(b.x)], 1u);
      asm volatile("s_waitcnt vmcnt(0)" ::: "memory");
    } else {
      XB_SPIN(xb_ld(&bar[XB_XGEN(b.x)]) == gen, bar);
      __builtin_amdgcn_fence(__ATOMIC_ACQUIRE, "agent");
      asm volatile("s_waitcnt vmcnt(0)" ::: "memory");
    }
  }
  __syncthreads();
}

typedef const Params __attribute__((address_space(4)))* KArgs;

__global__ void __launch_bounds__(NTHR, 2) mega_kernel(Params p_unused) {
#if defined(__HIP_DEVICE_COMPILE__)
  __shared__ __attribute__((aligned(16))) unsigned char smem[SMEM_BYTES + 16];
  KArgs ka = (KArgs)__builtin_amdgcn_kernarg_segment_ptr();
  const int ph_lo = ka->ph_lo, ph_hi = ka->ph_hi;
#if !MULTI_LAUNCH
  cg::grid_group grid = cg::this_grid();
  volatile LAS unsigned* xbw = (volatile LAS unsigned*)(smem + SMEM_BYTES);
  if (threadIdx.x == 0) { xbw[0] = 0u; xbw[1] = 0u; }
  __syncthreads();
  XcdBarrier xb = xcd_barrier_post((unsigned*)(ka->ws + WS_BAR), xbw);
#endif
  int rep = 0;
  for (int ph = ph_lo; ph < ph_hi;) {
    int tid = threadIdx.x, bid = blockIdx.x, nb = gridDim.x;
    KArgs kq = ka;
    asm volatile("" : "+v"(tid), "+s"(bid), "+s"(nb), "+s"(kq));
#ifdef AMP_K
    if (AMP_COND(ph) && threadIdx.x == 0) *(volatile LAS unsigned long long*)(smem + SMEM_BYTES + 8) = wall_clock64();
#endif
    run_phase(*kq, smem, ph, bid, nb, tid);
    bool again = false;
#ifdef REPEAT_S
    if (rep == 0 && ((ph >= 2 && (ph - 2) % PH_PER_LAYER == REPEAT_S) || (REPEAT_S == 100 && ph == 0))) again = true;
#endif
#if !MULTI_LAUNCH
    if (again || ph + 1 < ph_hi) { if (ph == 0 && !again) grid.sync(); else xcd_barrier(xb); }
#endif
#ifdef AMP_K
    if (AMP_COND(ph)) {
      if (threadIdx.x == 0) {
        const unsigned long long t0 = *(volatile LAS unsigned long long*)(smem + SMEM_BYTES + 8), t1 = wall_clock64();
        const unsigned long long dt = (t1 - t0) * AMP_K;
        while (wall_clock64() - t1 < dt) __builtin_amdgcn_s_sleep(8);
      }
      __syncthreads();
    }
#endif
    if (again) rep = 1; else { rep = 0; ++ph; }
  }
#endif
}

extern "C" void kernel_launch(void* const* d_in, const int* in_sizes, int n_in, void* d_out, int out_size, void* d_ws, size_t ws_size, hipStream_t stream) {
  static int grid = 0;
  if (grid == 0) {
    if (n_in != 17 || ws_size < WS_END) { fprintf(stderr, "kernel_launch: unexpected n_in %d or ws_size %zu (need %zu)\n", n_in, ws_size, (size_t)WS_END); grid = -1; return; }
    int dev = 0, cus = 0, per_cu = 0;
    hipGetDevice(&dev);
    hipDeviceGetAttribute(&cus, hipDeviceAttributeMultiprocessorCount, dev);
    hipOccupancyMaxActiveBlocksPerMultiprocessor(&per_cu, (const void*)mega_kernel, NTHR, 0);
    if (per_cu < 1) { fprintf(stderr, "kernel_launch: occupancy query says %d blocks per CU\n", per_cu); grid = -1; return; }
    grid = cus;
  }
  if (grid < 0) return;
  Params p{};
  p.x = (const float*)d_in[0]; p.c = (const float*)d_in[1]; p.ctx = (const float*)d_in[2]; p.c_ctx = (const float*)d_in[3];
  p.w_mod = (const float*)d_in[4]; p.b_mod = (const float*)d_in[5]; p.norm1_g = (const float*)d_in[6]; p.norm2_g = (const float*)d_in[7];
  p.w_in = (const float*)d_in[8]; p.conv_w = (const float*)d_in[9]; p.w_out = (const float*)d_in[10]; p.lb_logits = (const float*)d_in[11];
  p.peer_wq = (const float*)d_in[12]; p.peer_subkeys = (const float*)d_in[13]; p.peer_u = (const float*)d_in[14]; p.peer_v = (const float*)d_in[15];
  p.final_g = (const float*)d_in[16]; p.out = (float*)d_out; p.ws = (unsigned char*)d_ws;
#if MULTI_LAUNCH
  for (int ph = 0; ph < N_PHASES; ++ph) {
    p.ph_lo = ph; p.ph_hi = ph + 1;
    hipLaunchKernelGGL(mega_kernel, dim3(grid), dim3(NTHR), 0, stream, p);
  }
#else
  p.ph_lo = 0; p.ph_hi = N_PHASES;
  if (hipMemsetAsync((char*)d_ws + WS_BAR, 0, 16384, stream) != hipSuccess) { fprintf(stderr, "kernel_launch: memset of barrier words failed\n"); return; }
  void* args[] = {&p};
  hipError_t e = hipLaunchCooperativeKernel((const void*)mega_kernel, dim3(grid), dim3(NTHR), args, 0, stream);
  if (e != hipSuccess) fprintf(stderr, "cooperative launch failed: %s (grid %d)\n", hipGetErrorString(e), grid);
#endif
}
```

```cpp
#include <hip/hip_runtime.h>
#include <hip/hip_cooperative_groups.h>
#include <stdint.h>
#include <stdio.h>
namespace cg = cooperative_groups;

#ifndef MULTI_LAUNCH
#define MULTI_LAUNCH 0
#endif

#define DI __device__ __forceinline__
typedef unsigned short u16;
using bf16x8 = __attribute__((ext_vector_type(8))) short;
using f32x16 = __attribute__((ext_vector_type(16))) float;
using u32x4  = __attribute__((ext_vector_type(4))) unsigned;
using u32x2  = __attribute__((ext_vector_type(2))) unsigned;
using f32x4  = __attribute__((ext_vector_type(4))) float;

constexpr int D = 1024, NLAT = 16384, NCTX = 1024, NTOK = 17408, DEPTH = 4, INC = 4096;
constexpr int SEQ = 4096, CTXL = 256, BATCH = 4;
constexpr int NTHR = 512;
constexpr int NEXP = 16384;
constexpr float EPS = 1e-6f;

constexpr size_t al256(size_t x) { return (x + 255) & ~(size_t)255; }
constexpr size_t WS_BAR   = 0;
constexpr size_t WS_MOD   = 16384;
constexpr size_t WS_LOWER = WS_MOD + al256((size_t)4 * 5 * 6144 * 4);
constexpr size_t WS_XW    = WS_LOWER + al256((size_t)4 * 2 * 512 * 4);
constexpr size_t WS_HX    = WS_XW + (size_t)NTOK * D * 4;
constexpr size_t WS_Z     = WS_HX + (size_t)NTOK * D * 2;
constexpr size_t WS_CAT   = WS_Z + (size_t)NTOK * INC * 2;
constexpr size_t WS_OF    = WS_CAT + (size_t)NTOK * D * 2;
constexpr size_t WS_OB    = WS_OF + (size_t)NTOK * 512 * 4;
constexpr size_t WS_TOPK  = WS_OB + (size_t)NTOK * 512 * 4;
constexpr size_t WS_WIN   = WS_TOPK + (size_t)NTOK * 256 * 4;
constexpr size_t WS_WOUT  = WS_WIN + (size_t)4 * 4096 * 1024 * 2;
constexpr size_t WS_WS    = WS_WOUT + (size_t)4 * 1024 * 1024 * 2;
constexpr size_t WS_UB    = WS_WS + (size_t)4 * 2048 * 1024 * 2;
constexpr size_t WS_VB    = WS_UB + (size_t)4 * NEXP * D;
constexpr size_t WS_US    = WS_VB + (size_t)4 * NEXP * D;
constexpr size_t WS_VS    = WS_US + (size_t)4 * NEXP * 4;
constexpr size_t WS_SLOC  = WS_VS + (size_t)4 * NEXP * 4;
constexpr size_t WS_SST   = WS_SLOC + (size_t)32 * 34 * 16384 * 2;
constexpr size_t WS_DT    = WS_SST + (size_t)32 * 34 * 16384 * 2;
constexpr size_t WS_HXQ   = WS_DT + (size_t)32 * 34 * 128 * 4;
constexpr size_t WS_HXS   = WS_HXQ + (size_t)NTOK * D;
constexpr size_t WS_WSQ   = WS_HXS + al256((size_t)NTOK * 4);
constexpr size_t WS_WSS   = WS_WSQ + (size_t)4 * 2048 * 1024;
constexpr size_t WS_WINQ  = WS_WSS + (size_t)4 * 2048 * 4;
constexpr size_t WS_WINS  = WS_WINQ + (size_t)4 * 4096 * 1024;
constexpr size_t WS_END   = WS_WINS + (size_t)4 * 4096 * 4;

struct Params {
  const float* x; const float* c; const float* ctx; const float* c_ctx; const float* w_mod; const float* b_mod;
  const float* norm1_g; const float* norm2_g; const float* w_in; const float* conv_w; const float* w_out;
  const float* lb_logits; const float* peer_wq; const float* peer_subkeys; const float* peer_u; const float* peer_v;
  const float* final_g; float* out; unsigned char* ws;
  int ph_lo, ph_hi;
};

typedef __attribute__((ext_vector_type(2))) __bf16 bf16v2;
typedef __attribute__((ext_vector_type(2))) float f32v2;
typedef const Params __attribute__((address_space(4)))& KP;

DI u16 f2bf(float x) { return __builtin_bit_cast(u16, (__bf16)x); }
DI float bf2f(u16 b) { return __uint_as_float(((unsigned)b) << 16); }
DI unsigned pack2(float a, float b) { f32v2 v = {a, b}; return __builtin_bit_cast(unsigned, __builtin_convertvector(v, bf16v2)); }
DI float bflo(unsigned w) { return __uint_as_float(w << 16); }
DI float bfhi(unsigned w) { return __uint_as_float(w & 0xffff0000u); }
DI float sigmoidf_(float x) { return 1.f / (1.f + __expf(-x)); }
DI float siluf_(float x) { return x / (1.f + __expf(-x)); }
DI float wave_sum(float v) {
#pragma unroll
  for (int o = 32; o >= 1; o >>= 1) v += __shfl_xor(v, o);
  return v;
}
DI int row_cls(int row) { return row < NLAT ? (row >> 12) : 4; }
DI unsigned sw128(int row, int col) { return (unsigned)(row * 256 + ((((col >> 3) ^ (row & 15))) << 4) + (col & 7) * 2); }

DI void p0_mod_groups(KP p, float* smem, int gb, int vb, int nvb, int tid) {
  const int ge = gb + 192;
  float* cond = smem;
  float* red = smem + 5 * 1024;
  for (int i = tid; i < 5 * 1024; i += NTHR) {
    const int r = i >> 10, k = i & 1023;
    const float v = r < 4 ? p.c[r * 1024 + k] : p.c_ctx[k];
    cond[i] = siluf_(v);
  }
  __syncthreads();
  const int col = tid & 31, ks = tid >> 5;
  const float* cd0 = cond + ks * 64;
  float* mod = (float*)(p.ws + WS_MOD);
  for (int g0 = gb + vb; g0 < ge; g0 += 3 * nvb) {
    float wa[16], wb[16];
    const unsigned vo = (unsigned)((ks * 64 * 6144 + col) * 4);
    auto wbase = [&](int g) { return (const char*)(p.w_mod + (size_t)(g / 192) * 1024 * 6144 + (g % 192) * 32); };
    {
      const char* w = wbase(g0);
#pragma unroll
      for (int u = 0; u < 16; ++u) wa[u] = *(const float*)(w + (size_t)u * 24576 + vo);
    }
#pragma unroll 1
    for (int q = 0; q < 3; ++q) {
      const int g = g0 + q * nvb;
      if (g >= ge) break;
      float a0 = 0, a1 = 0, a2 = 0, a3 = 0, a4 = 0;
#pragma unroll 1
      for (int hb = 0; hb < 2; ++hb) {
        const float* cd = cd0 + 32 * hb;
        asm volatile("" : "+v"(cd));
        {
          const char* w = wbase(g) + (size_t)(32 * hb + 16) * 24576;
#pragma unroll
          for (int u = 0; u < 16; ++u) wb[u] = *(const float*)(w + (size_t)u * 24576 + vo);
        }
#pragma unroll
        for (int u = 0; u < 16; ++u) { a0 += cd[u] * wa[u]; a1 += cd[1024 + u] * wa[u]; a2 += cd[2048 + u] * wa[u]; a3 += cd[3072 + u] * wa[u]; a4 += cd[4096 + u] * wa[u]; }
        __builtin_amdgcn_sched_barrier(0);
        if (hb == 0 || (q + 1 < 3 && g + nvb < ge)) {
          const char* w = hb == 0 ? wbase(g) + (size_t)32 * 24576 : wbase(g + nvb);
#pragma unroll
          for (int u = 0; u < 16; ++u) wa[u] = *(const float*)(w + (size_t)u * 24576 + vo);
        }
#pragma unroll
        for (int u = 0; u < 16; ++u) { a0 += cd[16 + u] * wb[u]; a1 += cd[1040 + u] * wb[u]; a2 += cd[2064 + u] * wb[u]; a3 += cd[3088 + u] * wb[u]; a4 += cd[4112 + u] * wb[u]; }
        __builtin_amdgcn_sched_barrier(0);
      }
      float* rq = red + q * 2560;
      rq[(ks * 5 + 0) * 32 + col] = a0; rq[(ks * 5 + 1) * 32 + col] = a1; rq[(ks * 5 + 2) * 32 + col] = a2;
      rq[(ks * 5 + 3) * 32 + col] = a3; rq[(ks * 5 + 4) * 32 + col] = a4;
    }
    __syncthreads();
    if (tid < 480) {
      const int q = tid / 160, rr = tid % 160, r = rr >> 5, cc = rr & 31, g = g0 + q * nvb;
      if (g < ge) {
        const float* rq = red + q * 2560;
        float sacc = 0.f;
#pragma unroll
        for (int t = 0; t < 16; ++t) sacc += rq[(t * 5 + r) * 32 + cc];
        const int l = g / 192, ng = g % 192;
        mod[((size_t)l * 5 + r) * 6144 + ng * 32 + cc] = sacc + p.b_mod[l * 6144 + ng * 32 + cc];
      }
    }
    __syncthreads();
  }
}

DI void p0_transpose_waves(KP p, float* smem, int bid, int nb, int tid) {
  const int lane = tid & 63, wave = tid >> 6;
  float* t = smem + wave * (64 * 33);
  const int kr = lane >> 3, c4 = (lane & 7) * 4;
  const int j = lane >> 1, hf = lane & 1;
  float4 v[8];
  const float* src = nullptr; u16* dst = nullptr; int K = 1024, N = 0, k0 = 0, n0 = 0;
  auto decode = [&](int it) {
    if (it < 8192) { const int l = it >> 11, r = it & 2047; k0 = (r >> 7) * 64; n0 = (r & 127) * 32; N = 4096; src = p.w_in + (size_t)l * 1024 * 4096; dst = (u16*)(p.ws + WS_WIN) + (size_t)l * 4096 * 1024; }
    else { const int i2 = it - 8192, l = i2 >> 9, r = i2 & 511; k0 = (r >> 5) * 64; n0 = (r & 31) * 32; N = 1024; src = p.w_out + (size_t)l * 1024 * 1024; dst = (u16*)(p.ws + WS_WOUT) + (size_t)l * 1024 * 1024; }
  };
  auto gload = [&]() {
#pragma unroll
    for (int pp = 0; pp < 8; ++pp) v[pp] = *(const float4*)(src + (size_t)(k0 + kr + 8 * pp) * N + n0 + c4);
  };
  int it = bid * 8 + wave;
  const int step = nb * 8;
  if (it < 10240) { decode(it); gload(); }
#pragma unroll 1
  while (it < 10240) {
#pragma unroll
    for (int pp = 0; pp < 8; ++pp) {
      float* tt = t + (kr + 8 * pp) * 33 + c4;
      tt[0] = v[pp].x; tt[1] = v[pp].y; tt[2] = v[pp].z; tt[3] = v[pp].w;
    }
    u16* drow = dst + (size_t)(n0 + j) * K + k0 + 32 * hf;
    const int nxt = it + step;
    if (nxt < 10240) { decode(nxt); gload(); }
    __builtin_amdgcn_fence(__ATOMIC_ACQ_REL, "wavefront");
    __builtin_amdgcn_wave_barrier();
#pragma unroll
    for (int q = 0; q < 4; ++q) {
      const float* tt = t + (32 * hf + 8 * q) * 33 + j;
      u32x4 o;
      o[0] = pack2(tt[0 * 33], tt[1 * 33]); o[1] = pack2(tt[2 * 33], tt[3 * 33]);
      o[2] = pack2(tt[4 * 33], tt[5 * 33]); o[3] = pack2(tt[6 * 33], tt[7 * 33]);
      *(u32x4*)(drow + 8 * q) = o;
    }
    __builtin_amdgcn_fence(__ATOMIC_ACQ_REL, "wavefront");
    __builtin_amdgcn_wave_barrier();
    it = nxt;
  }
}

DI void p0_ws_item(KP p, float* smemf, int item, int tid) {
  const int l = item >> 8, hp = (item >> 4) & 15, kt = item & 15;
  unsigned char* smem = (unsigned char*)smemf;
  unsigned char* SK = smem;
  unsigned char* WQ = smem + 32768;
  const float* skg = p.peer_subkeys + ((size_t)l * 16 + hp) * 128 * 128;
#pragma unroll
  for (int u = 0; u < 4; ++u) {
    const int q = tid + NTHR * u, row = q >> 4, c8 = (q & 15) * 8;
    const float4 a = *(const float4*)(skg + row * 128 + c8), b = *(const float4*)(skg + row * 128 + c8 + 4);
    u32x4 o; o[0] = pack2(a.x, a.y); o[1] = pack2(a.z, a.w); o[2] = pack2(b.x, b.y); o[3] = pack2(b.z, b.w);
    *(u32x4*)(SK + sw128(row, c8)) = o;
  }
  const float* wqg = p.peer_wq + (size_t)l * 1024 * 2048 + (size_t)(kt * 64) * 2048 + hp * 128;
#pragma unroll
  for (int u = 0; u < 2; ++u) {
    const int q = tid + NTHR * u, row = q >> 4, c8 = (q & 15) * 8;
    const float4 a = *(const float4*)(wqg + (size_t)row * 2048 + c8), b = *(const float4*)(wqg + (size_t)row * 2048 + c8 + 4);
    u32x4 o; o[0] = pack2(a.x, a.y); o[1] = pack2(a.z, a.w); o[2] = pack2(b.x, b.y); o[3] = pack2(b.z, b.w);
    *(u32x4*)(WQ + sw128(row, c8)) = o;
  }
  __syncthreads();
  const int lane = tid & 63, wave = tid >> 6, r = lane & 31, h = lane >> 5;
  const int km = wave >> 2, kn = wave & 3;
  f32x16 acc;
#pragma unroll
  for (int e = 0; e < 16; ++e) acc[e] = 0.f;
#pragma unroll
  for (int ks = 0; ks < 8; ++ks) {
    const bf16x8 av = *(const bf16x8*)(WQ + sw128(32 * km + r, 16 * ks + 8 * h));
    const bf16x8 bv = *(const bf16x8*)(SK + sw128(32 * kn + r, 16 * ks + 8 * h));
    acc = __builtin_amdgcn_mfma_f32_32x32x16_bf16(av, bv, acc, 0, 0, 0);
  }
  u16* dst = (u16*)(p.ws + WS_WS) + ((size_t)l * 2048 + hp * 128 + 32 * kn + r) * 1024 + kt * 64 + 32 * km + 4 * h;
#pragma unroll
  for (int g = 0; g < 4; ++g) {
    u32x2 o; o[0] = pack2(acc[4 * g], acc[4 * g + 1]); o[1] = pack2(acc[4 * g + 2], acc[4 * g + 3]);
    *(u32x2*)(dst + 8 * g) = o;
  }
  __syncthreads();
}

DI void p0_quant_rows(const float* src, unsigned char* dst, float* scl, int row0, int tid, float off) {
  const int lane = tid & 63, wave = tid >> 6;
  auto qrow = [&](int row, const float4& x0, const float4& x1, const float4& x2, const float4& x3) {
    float v[16] = {x0.x, x0.y, x0.z, x0.w, x1.x, x1.y, x1.z, x1.w, x2.x, x2.y, x2.z, x2.w, x3.x, x3.y, x3.z, x3.w};
    float am = 0.f;
#pragma unroll
    for (int e = 0; e < 16; ++e) am = fmaxf(am, fabsf(v[e]));
#pragma unroll
    for (int o = 32; o >= 1; o >>= 1) am = fmaxf(am, __shfl_xor(am, o));
    const float sc = am > 0.f ? am * (1.f / 127.f) : 1.f;
    const float inv = 1.f / sc;
    u32x4 o4;
#pragma unroll
    for (int q = 0; q < 4; ++q) {
      unsigned w = 0;
#pragma unroll
      for (int e = 0; e < 4; ++e) {
        const float qv = fminf(fmaxf(rintf(v[q * 4 + e] * inv), -127.f), 127.f) + off;
        w |= (((unsigned)(int)qv) & 0xffu) << (8 * e);
      }
      o4[q] = w;
    }
    *(u32x4*)(dst + (size_t)row * D + lane * 16) = o4;
    if (lane == 0) scl[row] = sc;
  };
#pragma unroll 1
  for (int i = 0; i < 8; i += 2) {
    const int rA = row0 + i * 8 + wave, rB = rA + 8;
    const float* sa = src + (size_t)rA * D + lane * 16;
    const float* sb = src + (size_t)rB * D + lane * 16;
    const float4 a0 = *(const float4*)(sa), a1 = *(const float4*)(sa + 4), a2 = *(const float4*)(sa + 8), a3 = *(const float4*)(sa + 12);
    const float4 b0 = *(const float4*)(sb), b1 = *(const float4*)(sb + 4), b2 = *(const float4*)(sb + 8), b3 = *(const float4*)(sb + 12);
    qrow(rA, a0, a1, a2, a3);
    qrow(rB, b0, b1, b2, b3);
  }
}

DI void p0_quant_waves(KP p, int bid, int nb, int tid) {
  const int lane = tid & 63, wave = tid >> 6;
  auto qrow = [&](int rr, const float4& x0, const float4& x1, const float4& x2, const float4& x3) {
    unsigned char* dst = p.ws + (rr < NEXP ? WS_UB : WS_VB);
    float* scl = (float*)(p.ws + (rr < NEXP ? WS_US : WS_VS));
    const int row = rr & (NEXP - 1);
    float v[16] = {x0.x, x0.y, x0.z, x0.w, x1.x, x1.y, x1.z, x1.w, x2.x, x2.y, x2.z, x2.w, x3.x, x3.y, x3.z, x3.w};
    float am = 0.f;
#pragma unroll
    for (int e = 0; e < 16; ++e) am = fmaxf(am, fabsf(v[e]));
#pragma unroll
    for (int o = 32; o >= 1; o >>= 1) am = fmaxf(am, __shfl_xor(am, o));
    const float sc = am > 0.f ? am * (1.f / 127.f) : 1.f;
    const float inv = 1.f / sc;
    u32x4 o4;
#pragma unroll
    for (int q = 0; q < 4; ++q) {
      unsigned w = 0;
#pragma unroll
      for (int e = 0; e < 4; ++e) {
        const float qv = fminf(fmaxf(rintf(v[q * 4 + e] * inv), -127.f), 127.f);
        w |= (((unsigned)(int)qv) & 0xffu) << (8 * e);
      }
      o4[q] = w;
    }
    *(u32x4*)(dst + (size_t)row * D + lane * 16) = o4;
    if (lane == 0) scl[row] = sc;
  };
  auto srow = [&](int rr) { return (rr < NEXP ? p.peer_u + (size_t)rr * D : p.peer_v + (size_t)(rr - NEXP) * D) + lane * 16; };
  const int step = nb * 8;
  int rA = bid * 8 + wave, rB = rA + step;
  float4 a0, a1, a2, a3, b0, b1, b2, b3;
  if (rA < 2 * NEXP) { const float* sa = srow(rA); a0 = *(const float4*)(sa); a1 = *(const float4*)(sa + 4); a2 = *(const float4*)(sa + 8); a3 = *(const float4*)(sa + 12); }
  if (rB < 2 * NEXP) { const float* sb = srow(rB); b0 = *(const float4*)(sb); b1 = *(const float4*)(sb + 4); b2 = *(const float4*)(sb + 8); b3 = *(const float4*)(sb + 12); }
#pragma unroll 1
  while (rA < 2 * NEXP) {
    qrow(rA, a0, a1, a2, a3);
    const int nA = rA + 2 * step;
    if (nA < 2 * NEXP) { const float* sa = srow(nA); a0 = *(const float4*)(sa); a1 = *(const float4*)(sa + 4); a2 = *(const float4*)(sa + 8); a3 = *(const float4*)(sa + 12); }
    if (rB < 2 * NEXP) qrow(rB, b0, b1, b2, b3);
    const int nB = rB + 2 * step;
    if (nB < 2 * NEXP) { const float* sb = srow(nB); b0 = *(const float4*)(sb); b1 = *(const float4*)(sb + 4); b2 = *(const float4*)(sb + 8); b3 = *(const float4*)(sb + 12); }
    rA = nA; rB = nB;
  }
}

constexpr int P0_N_WS = 1024;

DI void phase_p0a(KP p, float* smem, int bid, int nb, int tid) {
  if (bid == nb - 1) {
    float* lower = (float*)(p.ws + WS_LOWER);
    for (int e = tid; e < 1024; e += NTHR) {
      const float a0 = p.lb_logits[e], a1 = p.lb_logits[1024 + e], a2 = p.lb_logits[2048 + e], a3 = p.lb_logits[3072 + e];
      const float m = fmaxf(fmaxf(a0, a1), fmaxf(a2, a3));
      const float e0 = expf(a0 - m), e1 = expf(a1 - m), e2 = expf(a2 - m), e3 = expf(a3 - m);
      const float inv = 1.f / (e0 + e1 + e2 + e3);
      lower[e] = 0.f; lower[1024 + e] = e1 * inv; lower[2048 + e] = (e1 + e2) * inv; lower[3072 + e] = (e1 + e2 + e3) * inv;
    }
  }
  p0_mod_groups(p, smem, 0, bid, nb, tid);
  for (int i = bid; i < P0_N_WS; i += nb) p0_ws_item(p, smem, i, tid);
  p0_transpose_waves(p, smem, bid, nb, tid);
  p0_quant_waves(p, bid, nb, tid);
}

template <bool FIRST = false>
DI void phase_norm(KP p, const float* g, int l, int sh_off, int sc_off, int bid, int nb, int row_end, int tid, bool wq = false) {
  const int lane = tid & 63, wave = tid >> 6;
  u16* xw = (u16*)(p.ws + WS_XW);
  const float* mod = (const float*)(p.ws + WS_MOD) + (size_t)l * 5 * 6144;
  for (int row = bid * 8 + wave; row < row_end; row += nb * 8) {
    float v[16];
    if (FIRST) {
      const float* xr = (row < NLAT ? p.x + (size_t)row * D : p.ctx + (size_t)(row - NLAT) * D) + lane * 16;
      u32x4 w0, w1;
#pragma unroll
      for (int q = 0; q < 4; ++q) {
        const float4 a = *(const float4*)(xr + q * 4);
        const unsigned lo = pack2(a.x, a.y), hi = pack2(a.z, a.w);
        if (q < 2) { w0[2 * q] = lo; w0[2 * q + 1] = hi; } else { w1[2 * (q - 2)] = lo; w1[2 * (q - 2) + 1] = hi; }
      }
      *(u32x4*)(xw + (size_t)row * D + lane * 16) = w0; *(u32x4*)(xw + (size_t)row * D + lane * 16 + 8) = w1;
#pragma unroll
      for (int e = 0; e < 4; ++e) { v[2 * e] = bflo(w0[e]); v[2 * e + 1] = bfhi(w0[e]); v[8 + 2 * e] = bflo(w1[e]); v[8 + 2 * e + 1] = bfhi(w1[e]); }
    } else {
      const u32x4 w0 = *(const u32x4*)(xw + (size_t)row * D + lane * 16), w1 = *(const u32x4*)(xw + (size_t)row * D + lane * 16 + 8);
#pragma unroll
      for (int e = 0; e < 4; ++e) { v[2 * e] = bflo(w0[e]); v[2 * e + 1] = bfhi(w0[e]); v[8 + 2 * e] = bflo(w1[e]); v[8 + 2 * e + 1] = bfhi(w1[e]); }
    }
    float ss = 0.f;
#pragma unroll
    for (int e = 0; e < 16; ++e) ss += v[e] * v[e];
    ss = wave_sum(ss);
    const float rs = rsqrtf(ss * (1.f / 1024.f) + EPS);
    const float* mr = mod + (size_t)row_cls(row) * 6144;
#pragma unroll
    for (int q = 0; q < 4; ++q) {
      const int c0 = lane * 16 + q * 4;
      const float4 gg = *(const float4*)(g + c0);
      const float4 sh = *(const float4*)(mr + sh_off + c0);
      const float4 sc = *(const float4*)(mr + sc_off + c0);
      v[q * 4 + 0] = v[q * 4 + 0] * rs * gg.x * (1.f + sc.x) + sh.x; v[q * 4 + 1] = v[q * 4 + 1] * rs * gg.y * (1.f + sc.y) + sh.y;
      v[q * 4 + 2] = v[q * 4 + 2] * rs * gg.z * (1.f + sc.z) + sh.z; v[q * 4 + 3] = v[q * 4 + 3] * rs * gg.w * (1.f + sc.w) + sh.w;
    }
    {
      float am = 0.f;
#pragma unroll
      for (int e = 0; e < 16; ++e) am = fmaxf(am, fabsf(v[e]));
#pragma unroll
      for (int o2 = 32; o2 >= 1; o2 >>= 1) am = fmaxf(am, __shfl_xor(am, o2));
      const float sc = am > 0.f ? am * (1.f / 127.f) : 1.f, inv = 1.f / sc;
      u32x4 oq;
#pragma unroll
      for (int q = 0; q < 4; ++q) {
        unsigned w = 0;
#pragma unroll
        for (int e = 0; e < 4; ++e) w |= (((unsigned)(int)rintf(v[q * 4 + e] * inv)) & 0xffu) << (8 * e);
        oq[q] = w;
      }
      *(u32x4*)(p.ws + WS_HXQ + (size_t)row * D + lane * 16) = oq;
      if (lane == 0) ((float*)(p.ws + WS_HXS))[row] = sc;
    }
  }
}

DI void phase_rowq(KP p, size_t src_off, size_t dst_off, size_t scl_off, int nrows, int bid, int nb, int tid) {
  const int lane = tid & 63, wave = tid >> 6;
  const u16* src = (const u16*)(p.ws + src_off);
  for (int row = bid * 8 + wave; row < nrows; row += nb * 8) {
    const u32x4 a = *(const u32x4*)(src + (size_t)row * 1024 + lane * 16), b = *(const u32x4*)(src + (size_t)row * 1024 + lane * 16 + 8);
    float v[16];
#pragma unroll
    for (int e = 0; e < 4; ++e) { v[2 * e] = bflo(a[e]); v[2 * e + 1] = bfhi(a[e]); v[8 + 2 * e] = bflo(b[e]); v[8 + 2 * e + 1] = bfhi(b[e]); }
    float am = 0.f;
#pragma unroll
    for (int e = 0; e < 16; ++e) am = fmaxf(am, fabsf(v[e]));
#pragma unroll
    for (int o2 = 32; o2 >= 1; o2 >>= 1) am = fmaxf(am, __shfl_xor(am, o2));
    const float sc = am > 0.f ? am * (1.f / 127.f) : 1.f, inv = 1.f / sc;
    u32x4 o;
#pragma unroll
    for (int q = 0; q < 4; ++q) {
      unsigned w = 0;
#pragma unroll
      for (int e = 0; e < 4; ++e) w |= (((unsigned)(int)rintf(v[q * 4 + e] * inv)) & 0xffu) << (8 * e);
      o[q] = w;
    }
    *(u32x4*)(p.ws + dst_off + (size_t)row * 1024 + lane * 16) = o;
    if (lane == 0) ((float*)(p.ws + scl_off))[row] = sc;
  }
}

constexpr int GEMM_LDS_STAGE = 256 * 128 + 128 * 128;
enum { EPI_Z = 0, EPI_RES = 1, EPI_TOPK = 2 };

DI unsigned lds_off(int row, int c) { return (unsigned)(row * 128 + ((c ^ ((row >> 1) & 7)) << 4)); }

template <int EPI, int BN, bool DEEP = false>
DI void gemm_tile(KP p, unsigned char* smem, const u16* A, const u16* Bt, int N, int K, int l, int m0, int n0, int tid) {
  constexpr int WN = BN / 64, WM = 8 / WN, IM = 256 / WM / 32, NB = BN / 64;
  constexpr int STAGE = 32768 + BN * 128;
  const int lane = tid & 63, wave = tid >> 6;
  const int wm = wave / WN, wn = wave % WN, r = lane & 31, h = lane >> 5;
  f32x16 acc[IM][2];
#pragma unroll
  for (int i = 0; i < IM; ++i)
#pragma unroll
    for (int j = 0; j < 2; ++j)
#pragma unroll
      for (int e = 0; e < 16; ++e) acc[i][j][e] = 0.f;
  u32x4 ra[4], rb[NB];
  const int nk = K / 64;
  const unsigned voff = (unsigned)(((tid >> 3) * K + (tid & 7) * 8) * 2);
  auto gload = [&](int kt) {
#pragma unroll
    for (int i = 0; i < 4; ++i) {
      const char* base = (const char*)(A + (size_t)(m0 + 64 * i) * K + kt * 64);
      ra[i] = *(const u32x4*)(base + voff);
    }
#pragma unroll
    for (int i = 0; i < NB; ++i) {
      const char* base = (const char*)(Bt + (size_t)(n0 + 64 * i) * K + kt * 64);
      rb[i] = *(const u32x4*)(base + voff);
    }
  };
  auto lstore = [&](int buf) {
    unsigned char* sa = smem + buf * STAGE;
    unsigned char* sb = sa + 32768;
#pragma unroll
    for (int i = 0; i < 4; ++i) {
      const int q = tid + i * NTHR, row = q >> 3, c = q & 7;
      *(u32x4*)(sa + lds_off(row, c)) = ra[i];
    }
#pragma unroll
    for (int i = 0; i < NB; ++i) {
      const int q = tid + i * NTHR, row = q >> 3, c = q & 7;
      *(u32x4*)(sb + lds_off(row, c)) = rb[i];
    }
  };
  auto compute = [&](int kt) {
    const unsigned char* sa = smem + (kt & 1) * STAGE;
    const unsigned char* sb = sa + 32768;
#pragma unroll
    for (int s = 0; s < 4; ++s) {
      bf16x8 fa[IM], fb[2];
#pragma unroll
      for (int i = 0; i < IM; ++i) fa[i] = *(const bf16x8*)(sa + lds_off(wm * (IM * 32) + i * 32 + r, 2 * s + h));
#pragma unroll
      for (int j = 0; j < 2; ++j) fb[j] = *(const bf16x8*)(sb + lds_off(wn * 64 + j * 32 + r, 2 * s + h));
#pragma unroll
      for (int i = 0; i < IM; ++i)
#pragma unroll
        for (int j = 0; j < 2; ++j) acc[i][j] = __builtin_amdgcn_mfma_f32_32x32x16_bf16(fa[i], fb[j], acc[i][j], 0, 0, 0);
      if constexpr (BN == 256) __builtin_amdgcn_sched_barrier(0);
    }
  };
  if constexpr (!DEEP) {
    gload(0);
    lstore(0);
    __syncthreads();
    for (int kt = 0; kt < nk; ++kt) {
      if (kt + 1 < nk) gload(kt + 1);
      compute(kt);
      if (kt + 1 < nk) lstore((kt + 1) & 1);
      __syncthreads();
    }
  } else {
    u32x4 ra2[4], rb2[NB];
    auto gload2 = [&](int kt) {
#pragma unroll
      for (int i = 0; i < 4; ++i) ra2[i] = *(const u32x4*)((const char*)(A + (size_t)(m0 + 64 * i) * K + kt * 64) + voff);
#pragma unroll
      for (int i = 0; i < NB; ++i) rb2[i] = *(const u32x4*)((const char*)(Bt + (size_t)(n0 + 64 * i) * K + kt * 64) + voff);
    };
    auto lstore2 = [&](int buf) {
      unsigned char* sa = smem + buf * STAGE;
      unsigned char* sb = sa + 32768;
#pragma unroll
      for (int i = 0; i < 4; ++i) { const int q = tid + i * NTHR; *(u32x4*)(sa + lds_off(q >> 3, q & 7)) = ra2[i]; }
#pragma unroll
      for (int i = 0; i < NB; ++i) { const int q = tid + i * NTHR; *(u32x4*)(sb + lds_off(q >> 3, q & 7)) = rb2[i]; }
    };
    gload(0);
    gload2(1);
    lstore(0);
    if (2 < nk) gload(2);
    __syncthreads();
    for (int kt = 0; kt < nk; kt += 2) {
      if (kt + 1 < nk) { lstore2(1); if (kt + 3 < nk) gload2(kt + 3); }
      compute(kt);
      __syncthreads();
      if (kt + 2 < nk) { lstore(0); if (kt + 4 < nk) gload(kt + 4); }
      compute(kt + 1);
      __syncthreads();
    }
  }
#pragma unroll 1
  for (int hf = 0; hf < BN / 128; ++hf) {
    const bool mine = (wn >> 1) == hf;
    const int n0h = n0 + hf * 128, lc = (wn & 1) * 64 + r, lr = wm * (IM * 32) + 4 * h;
    if constexpr (EPI == EPI_Z) {
      u16* st = (u16*)smem;
      if (mine) {
        u16* lb = st + lr * 136 + lc;
#pragma unroll
        for (int i = 0; i < IM; ++i)
#pragma unroll
          for (int j = 0; j < 2; ++j)
#pragma unroll
            for (int e = 0; e < 16; ++e) lb[(i * 32 + (e & 3) + 8 * (e >> 2)) * 136 + j * 32] = f2bf(acc[i][j][e]);
      }
      __syncthreads();
      u16* Z = (u16*)(p.ws + WS_Z) + (size_t)m0 * N + n0h;
#pragma unroll 2
      for (int i = 0; i < 8; ++i) {
        const int q = tid + i * NTHR, row = q >> 4, c = q & 15;
        *(u32x4*)(Z + (size_t)row * N + c * 8) = *(const u32x4*)(st + row * 136 + c * 8);
      }
      __syncthreads();
    } else if constexpr (EPI == EPI_RES) {
      float* st = (float*)smem;
      if (mine) {
        float* lb = st + lr * 132 + lc;
#pragma unroll
        for (int i = 0; i < IM; ++i)
#pragma unroll
          for (int j = 0; j < 2; ++j)
#pragma unroll
            for (int e = 0; e < 16; ++e) lb[(i * 32 + (e & 3) + 8 * (e >> 2)) * 132 + j * 32] = acc[i][j][e];
      }
      __syncthreads();
      float* xw = (float*)(p.ws + WS_XW) + (size_t)m0 * D + n0h;
      const float* g1p = (const float*)(p.ws + WS_MOD) + ((size_t)l * 5 + row_cls(m0)) * 6144 + 2048 + n0h;
      const int c = tid & 31;
      const float4 g1 = *(const float4*)(g1p + c * 4);
#pragma unroll 2
      for (int i = 0; i < 16; ++i) {
        const int row = (tid >> 5) + i * 16;
        const float4 a = *(const float4*)(st + row * 132 + c * 4);
        float4 xv = *(const float4*)(xw + (size_t)row * D + c * 4);
        xv.x += g1.x * a.x; xv.y += g1.y * a.y; xv.z += g1.z * a.z; xv.w += g1.w * a.w;
        *(float4*)(xw + (size_t)row * D + c * 4) = xv;
      }
      __syncthreads();
    } else {
      float* st = (float*)smem;
      if (mine) {
        float* lb = st + lr * 129 + lc;
#pragma unroll
        for (int i = 0; i < IM; ++i)
#pragma unroll
          for (int j = 0; j < 2; ++j)
#pragma unroll
            for (int e = 0; e < 16; ++e) lb[(i * 32 + (e & 3) + 8 * (e >> 2)) * 129 + j * 32] = acc[i][j][e];
      }
      __syncthreads();
      if (tid < 256) {
        float t16[16];
#pragma unroll
        for (int i = 0; i < 16; ++i) t16[i] = __uint_as_float(0xff800000u);
        for (int kk = 0; kk < 128; ++kk) {
          const float sv = st[tid * 129 + kk];
          const float x = __uint_as_float((__float_as_uint(sv) & ~0x7fu) | (unsigned)(127 - kk));
#pragma unroll
          for (int i = 15; i >= 1; --i) t16[i] = __builtin_amdgcn_fmed3f(x, t16[i - 1], t16[i]);
          t16[0] = fmaxf(t16[0], x);
        }
        unsigned* tk = (unsigned*)(p.ws + WS_TOPK) + ((size_t)(m0 + tid) * 16 + (n0h >> 7)) * 16;
#pragma unroll
        for (int q = 0; q < 4; ++q) {
          u32x4 o; o[0] = __float_as_uint(t16[q * 4]); o[1] = __float_as_uint(t16[q * 4 + 1]); o[2] = __float_as_uint(t16[q * 4 + 2]); o[3] = __float_as_uint(t16[q * 4 + 3]);
          *(u32x4*)(tk + q * 4) = o;
        }
      }
      __syncthreads();
    }
  }
}

template <int EPI>
DI void gemm_phase(KP p, unsigned char* smem, const u16* A, const u16* Bt, int M, int N, int K, int l, int bid, int nb, int m_tiles_active, int tid) {
  const int ntn = N / 128;
  const int ntiles = m_tiles_active * ntn;
#pragma unroll 1
  for (int tile = bid; tile < ntiles; tile += nb)
    gemm_tile<EPI, 128, true>(p, smem, A, Bt, N, K, l, (tile / ntn) * 256, (tile % ntn) * 128, tid);
}

namespace pg8 {
#define PG8_LAS __attribute__((address_space(3)))
typedef unsigned short bf16_t;
typedef short bf16x8 __attribute__((ext_vector_type(8)));
typedef float f32x4 __attribute__((ext_vector_type(4)));
typedef unsigned u32x4 __attribute__((ext_vector_type(4)));
constexpr int BM = 256, BK = 64, HALF = 128, HTB = HALF * BK * 2  , STAGE_BYTES = 8 * HTB, NXCD = 8, WGM = 8;

__host__ __device__ __forceinline__ int lds_byte(int r, int c) { const int st = (r >> 4) * 2 + (c >> 5), rr = r & 15, cc = c & 31, ob = rr * 64 + cc * 2; return st * 1024 + (ob ^ (((ob >> 9) & 1) << 5)); }
__host__ __device__ __forceinline__ void stage_rc(int b, int& R, int& C) { const int st = b / 1024, sb = b % 1024, swz = sb ^ (((sb >> 9) & 1) << 5); R = (st >> 1) * 16 + swz / 64; C = (st & 1) * 32 + (swz % 64) / 2; }
__host__ __device__ __forceinline__ int perm32(int rho) { const int n = rho >> 4, i = rho & 15; return 8 * (i >> 2) + 4 * n + (i & 3); }

struct Unit { int pm, pn; };
struct Gemm { const bf16_t* A; const bf16_t* Bt; int M, N, K; };

template <class Epi, class Sched>
__device__ __forceinline__ void gemm_phase(PG8_LAS unsigned char* lds, const Gemm g, const Sched& S, const Epi& E, const int tid) {
    const int wid = __builtin_amdgcn_readfirstlane(tid >> 6), lane = tid & 63, wr = wid >> 2, wc = wid & 3, fr = lane & 15, fq = lane >> 4;
    const int K = g.K, nt = K / BK;
    unsigned voffA[2], voffB[2];
#pragma unroll
    for (int i = 0; i < 2; ++i) { int R, C; stage_rc(tid * 16 + i * 8192, R, C); const int Rb = Epi::PERM ? ((R & ~31) + perm32(R & 31)) : R;
        voffA[i] = (unsigned)(R * K + C) * 2u; voffB[i] = (unsigned)(Rb * K + C) * 2u; }
    const size_t kstep = (size_t)(BK * 2);
    const size_t hstep = (size_t)HALF * K * 2;
    const size_t tstep = 2 * hstep;
    const unsigned ldsw = (unsigned)wid * 1024u;
    const int aoff = lds_byte(wr * 64 + fr, fq * 8), boff = lds_byte(wc * 32 + fr, fq * 8);
#define PG8_SA(b, h) (((b) * 2 + (h)) * HTB)
#define PG8_SB(b, h) ((4 + (b) * 2 + (h)) * HTB)
#define PG8_STAGE(bufoff, gbase, voff) do { _Pragma("unroll") for (int _i = 0; _i < 2; ++_i) \
        __builtin_amdgcn_global_load_lds((const unsigned*)((const char*)(gbase) + (voff)[_i]), (PG8_LAS unsigned*)(lds + (bufoff) + ldsw + _i * 8192), 16, 0, 0); } while (0)
#define PG8_LDA(dst, b, h) do { _Pragma("unroll") for (int m = 0; m < 4; ++m) _Pragma("unroll") for (int k = 0; k < 2; ++k) dst[m][k] = *(const PG8_LAS bf16x8*)(lds + PG8_SA(b, h) + aoff + m * 2048 + k * 1024); } while (0)
#define PG8_LDB(dst, b, h) do { _Pragma("unroll") for (int n = 0; n < 2; ++n) _Pragma("unroll") for (int k = 0; k < 2; ++k) dst[n][k] = *(const PG8_LAS bf16x8*)(lds + PG8_SB(b, h) + boff + n * 2048 + k * 1024); } while (0)
#define PG8_MMA(ai, bj, At, Bt) do { __builtin_amdgcn_s_setprio(1); _Pragma("unroll") for (int m = 0; m < 4; ++m) _Pragma("unroll") for (int n = 0; n < 2; ++n) _Pragma("unroll") for (int k = 0; k < 2; ++k) \
        acc[ai][bj][m][n] = __builtin_amdgcn_mfma_f32_16x16x32_bf16(Bt[n][k], At[m][k], acc[ai][bj][m][n], 0, 0, 0); __builtin_amdgcn_s_setprio(0); } while (0)
#define PG8_WAIT_V(n) asm volatile("s_waitcnt vmcnt(" #n ")" ::: "memory")
#define PG8_WAIT_L(n) asm volatile("s_waitcnt lgkmcnt(" #n ")" ::: "memory")
#define PG8_BAR __builtin_amdgcn_s_barrier()
#define PG8_SCHED __builtin_amdgcn_sched_barrier(0)
    Unit cur, nxt; int ui = 0;
    if (!S.next(0, cur)) return;
    f32x4 acc[2][2][4][2];
#pragma unroll
    for (int a = 0; a < 2; ++a)
#pragma unroll
        for (int b = 0; b < 2; ++b)
#pragma unroll
            for (int m = 0; m < 4; ++m)
#pragma unroll
                for (int n = 0; n < 2; ++n) acc[a][b][m][n] = (f32x4){0.f, 0.f, 0.f, 0.f};
    bf16x8 At[4][2], B0[2][2], B1[2][2];
    const char* cA = (const char*)g.A + (size_t)cur.pm * tstep; const char* cB = (const char*)g.Bt + (size_t)cur.pn * tstep;
    S.a_ready(cur);
    PG8_STAGE(PG8_SB(0, 0), cB, voffB); PG8_STAGE(PG8_SA(0, 0), cA, voffA); PG8_STAGE(PG8_SB(0, 1), cB + hstep, voffB); PG8_STAGE(PG8_SA(0, 1), cA + hstep, voffA);
    if (wr == 1) PG8_BAR;
    PG8_WAIT_V(4); PG8_BAR;
    PG8_STAGE(PG8_SB(1, 0), cB + kstep, voffB); PG8_STAGE(PG8_SA(1, 0), cA + kstep, voffA); PG8_STAGE(PG8_SB(1, 1), cB + hstep + kstep, voffB);
    PG8_WAIT_V(6); PG8_BAR;
    for (;;) {
        const bool has_next = S.next(ui + 1, nxt);
        const char* nA = has_next ? (const char*)g.A + (size_t)nxt.pm * tstep : cA; const char* nB = has_next ? (const char*)g.Bt + (size_t)nxt.pn * tstep : cB;
        for (int t = 0; t < nt; t += 2) {
            const bool last = (t == nt - 2);
            const char* a1 = cA + (size_t)(t + 1) * kstep;
            const char* a2 = last ? nA : cA + (size_t)(t + 2) * kstep; const char* b2 = last ? nB : cB + (size_t)(t + 2) * kstep;
            const char* a3 = a2 + kstep; const char* b3 = b2 + kstep;
            if (last && has_next) S.a_ready(nxt);
            PG8_LDB(B0, 0, 0); PG8_SCHED; PG8_LDA(At, 0, 0); PG8_STAGE(PG8_SA(1, 1), a1 + hstep, voffA);
            PG8_WAIT_L(8); PG8_BAR; PG8_WAIT_L(0); PG8_MMA(0, 0, At, B0); PG8_BAR; PG8_SCHED;
            PG8_LDB(B1, 0, 1); PG8_STAGE(PG8_SB(0, 0), b2, voffB);
            PG8_BAR; PG8_WAIT_L(0); PG8_MMA(0, 1, At, B1); PG8_BAR;
            PG8_LDA(At, 0, 1); PG8_STAGE(PG8_SA(0, 0), a2, voffA);
            PG8_BAR; PG8_WAIT_L(0); PG8_MMA(1, 0, At, B0); PG8_BAR; PG8_SCHED;
            PG8_STAGE(PG8_SB(0, 1), b2 + hstep, voffB);
            PG8_WAIT_V(6); PG8_BAR; PG8_MMA(1, 1, At, B1); PG8_BAR;
            PG8_LDB(B0, 1, 0); PG8_SCHED; PG8_LDA(At, 1, 0); PG8_STAGE(PG8_SA(0, 1), a2 + hstep, voffA);
            PG8_WAIT_L(8); PG8_BAR; PG8_WAIT_L(0); PG8_MMA(0, 0, At, B0); PG8_BAR; PG8_SCHED;
            PG8_LDB(B1, 1, 1); PG8_STAGE(PG8_SB(1, 0), b3, voffB);
            PG8_BAR; PG8_WAIT_L(0); PG8_MMA(0, 1, At, B1); PG8_BAR;
            PG8_LDA(At, 1, 1); PG8_STAGE(PG8_SA(1, 0), a3, voffA);
            PG8_BAR; PG8_WAIT_L(0); PG8_MMA(1, 0, At, B0); PG8_BAR; PG8_SCHED;
            PG8_STAGE(PG8_SB(1, 1), b3 + hstep, voffB);
            PG8_WAIT_V(6); PG8_BAR; PG8_MMA(1, 1, At, B1); PG8_BAR;
        }
        if constexpr (!Epi::AFTER_DRAIN) { E(acc, cur, wr, wc, fr, fq); S.done(cur); }
        if (!has_next) break;
#pragma unroll
        for (int a = 0; a < 2; ++a)
#pragma unroll
            for (int b = 0; b < 2; ++b)
#pragma unroll
                for (int m = 0; m < 4; ++m)
#pragma unroll
                    for (int n = 0; n < 2; ++n) acc[a][b][m][n] = (f32x4){0.f, 0.f, 0.f, 0.f};
        cur = nxt; cA = nA; cB = nB; ++ui;
    }
    PG8_WAIT_V(0);
    if (wr == 0) PG8_BAR;
    PG8_BAR;
    if constexpr (Epi::AFTER_DRAIN) { E.fused(acc, cur, wr, wc, fr, fq, lds, wid, lane); S.done(cur); }
#undef PG8_SA
#undef PG8_SB
#undef PG8_STAGE
#undef PG8_LDA
#undef PG8_LDB
#undef PG8_MMA
#undef PG8_WAIT_V
#undef PG8_WAIT_L
#undef PG8_BAR
#undef PG8_SCHED
}

typedef int i32x4 __attribute__((ext_vector_type(4)));
template <class Epi, class Sched>
__device__ __forceinline__ void gemm_phase_i8(PG8_LAS unsigned char* lds, const Gemm g, const Sched& S, const Epi& E, const int tid) {
    const int wid = __builtin_amdgcn_readfirstlane(tid >> 6), lane = tid & 63, wr = wid >> 2, wc = wid & 3, fr = lane & 15, fq = lane >> 4;
    const int K = g.K  , nt = K / (2 * BK);
    unsigned voffA[2], voffB[2];
#pragma unroll
    for (int i = 0; i < 2; ++i) { int R, C; stage_rc(tid * 16 + i * 8192, R, C); const int Rb = Epi::PERM ? ((R & ~31) + perm32(R & 31)) : R;
        voffA[i] = (unsigned)(R * K + 2 * C); voffB[i] = (unsigned)(Rb * K + 2 * C); }
    const size_t kstep = (size_t)(BK * 2);
    const size_t hstep = (size_t)HALF * K;
    const size_t tstep = 2 * hstep;
    const unsigned ldsw = (unsigned)wid * 1024u;
    const int aoff = lds_byte(wr * 64 + fr, fq * 8), boff = lds_byte(wc * 32 + fr, fq * 8);
#define PG8_SA(b, h) (((b) * 2 + (h)) * HTB)
#define PG8_SB(b, h) ((4 + (b) * 2 + (h)) * HTB)
#define PG8_STAGE(bufoff, gbase, voff) do { _Pragma("unroll") for (int _i = 0; _i < 2; ++_i) \
        __builtin_amdgcn_global_load_lds((const unsigned*)((const char*)(gbase) + (voff)[_i]), (PG8_LAS unsigned*)(lds + (bufoff) + ldsw + _i * 8192), 16, 0, 0); } while (0)
#define PG8_LDA(dst, b, h) do { _Pragma("unroll") for (int m = 0; m < 4; ++m) _Pragma("unroll") for (int k = 0; k < 2; ++k) dst[m][k] = *(const PG8_LAS bf16x8*)(lds + PG8_SA(b, h) + aoff + m * 2048 + k * 1024); } while (0)
#define PG8_LDB(dst, b, h) do { _Pragma("unroll") for (int n = 0; n < 2; ++n) _Pragma("unroll") for (int k = 0; k < 2; ++k) dst[n][k] = *(const PG8_LAS bf16x8*)(lds + PG8_SB(b, h) + boff + n * 2048 + k * 1024); } while (0)
#define PG8_MMA(ai, bj, At, Bt) do { __builtin_amdgcn_s_setprio(1); _Pragma("unroll") for (int m = 0; m < 4; ++m) _Pragma("unroll") for (int n = 0; n < 2; ++n) _Pragma("unroll") for (int k = 0; k < 2; ++k) \
        acc[ai][bj][m][n] = __builtin_amdgcn_mfma_i32_16x16x64_i8(__builtin_bit_cast(i32x4, Bt[n][k]), __builtin_bit_cast(i32x4, At[m][k]), acc[ai][bj][m][n], 0, 0, 0); __builtin_amdgcn_s_setprio(0); } while (0)
#define PG8_WAIT_V(n) asm volatile("s_waitcnt vmcnt(" #n ")" ::: "memory")
#define PG8_WAIT_L(n) asm volatile("s_waitcnt lgkmcnt(" #n ")" ::: "memory")
#define PG8_BAR __builtin_amdgcn_s_barrier()
#define PG8_SCHED __builtin_amdgcn_sched_barrier(0)
    Unit cur, nxt; int ui = 0;
    if (!S.next(0, cur)) return;
    i32x4 acc[2][2][4][2];
#pragma unroll
    for (int a = 0; a < 2; ++a)
#pragma unroll
        for (int b = 0; b < 2; ++b)
#pragma unroll
            for (int m = 0; m < 4; ++m)
#pragma unroll
                for (int n = 0; n < 2; ++n) acc[a][b][m][n] = (i32x4){0, 0, 0, 0};
    bf16x8 At[4][2], B0[2][2], B1[2][2];
    const char* cA = (const char*)g.A + (size_t)cur.pm * tstep; const char* cB = (const char*)g.Bt + (size_t)cur.pn * tstep;
    S.a_ready(cur);
    PG8_STAGE(PG8_SB(0, 0), cB, voffB); PG8_STAGE(PG8_SA(0, 0), cA, voffA); PG8_STAGE(PG8_SB(0, 1), cB + hstep, voffB); PG8_STAGE(PG8_SA(0, 1), cA + hstep, voffA);
    if (wr == 1) PG8_BAR;
    PG8_WAIT_V(4); PG8_BAR;
    PG8_STAGE(PG8_SB(1, 0), cB + kstep, voffB); PG8_STAGE(PG8_SA(1, 0), cA + kstep, voffA); PG8_STAGE(PG8_SB(1, 1), cB + hstep + kstep, voffB);
    PG8_WAIT_V(6); PG8_BAR;
    for (;;) {
        const bool has_next = S.next(ui + 1, nxt);
        const char* nA = has_next ? (const char*)g.A + (size_t)nxt.pm * tstep : cA; const char* nB = has_next ? (const char*)g.Bt + (size_t)nxt.pn * tstep : cB;
        for (int t = 0; t < nt; t += 2) {
            const bool last = (t == nt - 2);
            const char* a1 = cA + (size_t)(t + 1) * kstep;
            const char* a2 = last ? nA : cA + (size_t)(t + 2) * kstep; const char* b2 = last ? nB : cB + (size_t)(t + 2) * kstep;
            const char* a3 = a2 + kstep; const char* b3 = b2 + kstep;
            if (last && has_next) S.a_ready(nxt);
            PG8_LDB(B0, 0, 0); PG8_SCHED; PG8_LDA(At, 0, 0); PG8_STAGE(PG8_SA(1, 1), a1 + hstep, voffA);
            PG8_WAIT_L(8); PG8_BAR; PG8_WAIT_L(0); PG8_MMA(0, 0, At, B0); PG8_BAR; PG8_SCHED;
            PG8_LDB(B1, 0, 1); PG8_STAGE(PG8_SB(0, 0), b2, voffB);
            PG8_BAR; PG8_WAIT_L(0); PG8_MMA(0, 1, At, B1); PG8_BAR;
            PG8_LDA(At, 0, 1); PG8_STAGE(PG8_SA(0, 0), a2, voffA);
            PG8_BAR; PG8_WAIT_L(0); PG8_MMA(1, 0, At, B0); PG8_BAR; PG8_SCHED;
            PG8_STAGE(PG8_SB(0, 1), b2 + hstep, voffB);
            PG8_WAIT_V(6); PG8_BAR; PG8_MMA(1, 1, At, B1); PG8_BAR;
            PG8_LDB(B0, 1, 0); PG8_SCHED; PG8_LDA(At, 1, 0); PG8_STAGE(PG8_SA(0, 1), a2 + hstep, voffA);
            PG8_WAIT_L(8); PG8_BAR; PG8_WAIT_L(0); PG8_MMA(0, 0, At, B0); PG8_BAR; PG8_SCHED;
            PG8_LDB(B1, 1, 1); PG8_STAGE(PG8_SB(1, 0), b3, voffB);
            PG8_BAR; PG8_WAIT_L(0); PG8_MMA(0, 1, At, B1); PG8_BAR;
            PG8_LDA(At, 1, 1); PG8_STAGE(PG8_SA(1, 0), a3, voffA);
            PG8_BAR; PG8_WAIT_L(0); PG8_MMA(1, 0, At, B0); PG8_BAR; PG8_SCHED;
            PG8_STAGE(PG8_SB(1, 1), b3 + hstep, voffB);
            PG8_WAIT_V(6); PG8_BAR; PG8_MMA(1, 1, At, B1); PG8_BAR;
        }
        if constexpr (!Epi::AFTER_DRAIN) { E(acc, cur, wr, wc, fr, fq); S.done(cur); }
        if (!has_next) break;
#pragma unroll
        for (int a = 0; a < 2; ++a)
#pragma unroll
            for (int b = 0; b < 2; ++b)
#pragma unroll
                for (int m = 0; m < 4; ++m)
#pragma unroll
                    for (int n = 0; n < 2; ++n) acc[a][b][m][n] = (i32x4){0, 0, 0, 0};
        cur = nxt; cA = nA; cB = nB; ++ui;
    }
    PG8_WAIT_V(0);
    if (wr == 0) PG8_BAR;
    PG8_BAR;
    if constexpr (Epi::AFTER_DRAIN) { E.fused(acc, cur, wr, wc, fr, fq, lds, wid, lane); S.done(cur); }
#undef PG8_SA
#undef PG8_SB
#undef PG8_STAGE
#undef PG8_LDA
#undef PG8_LDB
#undef PG8_MMA
#undef PG8_WAIT_V
#undef PG8_WAIT_L
#undef PG8_BAR
#undef PG8_SCHED
}

struct LinOrder {
  int nN, nunits, G, c;
  __device__ __forceinline__ bool next(int i, Unit& u) const { const int L = i * G + c; if (L >= nunits) return false; u.pm = L / nN; u.pn = L % nN; return true; }
  __device__ __forceinline__ void a_ready(const Unit&) const {}
  __device__ __forceinline__ void done(const Unit&) const {}
};
struct OneUnit {
  Unit u0;
  __device__ __forceinline__ bool next(int i, Unit& u) const { if (i) return false; u = u0; return true; }
  __device__ __forceinline__ void a_ready(const Unit&) const {}
  __device__ __forceinline__ void done(const Unit&) const {}
};
struct EpiZ {
  static constexpr bool PERM = true, AFTER_DRAIN = false;
  bf16_t* O; int ldc;
  __device__ __forceinline__ void operator()(const f32x4 (&acc)[2][2][4][2], const Unit& u, int wr, int wc, int fr, int fq) const {
    const int row0 = u.pm * BM + wr * 64 + fr, col0 = u.pn * BM + wc * 32 + 8 * fq;
#pragma unroll
    for (int ai = 0; ai < 2; ++ai)
#pragma unroll
      for (int m = 0; m < 4; ++m) { bf16_t* rowp = O + (size_t)(row0 + ai * HALF + m * 16) * ldc + col0;
#pragma unroll
        for (int bj = 0; bj < 2; ++bj) { const f32x4 v0 = acc[ai][bj][m][0], v1 = acc[ai][bj][m][1];
          u32x4 w; w.x = ::pack2(v0[0], v0[1]); w.y = ::pack2(v0[2], v0[3]); w.z = ::pack2(v1[0], v1[1]); w.w = ::pack2(v1[2], v1[3]);
          *(u32x4*)(rowp + bj * HALF) = w; } }
  }
};
struct EpiRes {
  static constexpr bool PERM = true, AFTER_DRAIN = false;
  bf16_t* xw; const float* modl;
  __device__ __forceinline__ void operator()(const f32x4 (&acc)[2][2][4][2], const Unit& u, int wr, int wc, int fr, int fq) const {
    const int row0 = u.pm * BM + wr * 64 + fr, col0 = u.pn * BM + wc * 32 + 8 * fq;
    const float* g1p = modl + (size_t)::row_cls(u.pm * BM) * 6144 + 2048 + col0;
    f32x4 gv[2][2];
#pragma unroll
    for (int bj = 0; bj < 2; ++bj)
#pragma unroll
      for (int n = 0; n < 2; ++n) gv[bj][n] = *(const f32x4*)(g1p + bj * HALF + 4 * n);
#pragma unroll
    for (int ai = 0; ai < 2; ++ai)
#pragma unroll
      for (int m = 0; m < 4; ++m) { bf16_t* rowp = xw + (size_t)(row0 + ai * HALF + m * 16) * 1024 + col0;
#pragma unroll
        for (int bj = 0; bj < 2; ++bj) { const f32x4 v0 = acc[ai][bj][m][0], v1 = acc[ai][bj][m][1];
          u32x4 w = *(const u32x4*)(rowp + bj * HALF);
          w.x = ::pack2(::bflo(w.x) + gv[bj][0][0] * v0[0], ::bfhi(w.x) + gv[bj][0][1] * v0[1]); w.y = ::pack2(::bflo(w.y) + gv[bj][0][2] * v0[2], ::bfhi(w.y) + gv[bj][0][3] * v0[3]);
          w.z = ::pack2(::bflo(w.z) + gv[bj][1][0] * v1[0], ::bfhi(w.z) + gv[bj][1][1] * v1[1]); w.w = ::pack2(::bflo(w.w) + gv[bj][1][2] * v1[2], ::bfhi(w.w) + gv[bj][1][3] * v1[3]);
          *(u32x4*)(rowp + bj * HALF) = w; } }
  }
};
struct EpiTopk {
  static constexpr bool PERM = false, AFTER_DRAIN = true;
  unsigned* topk;
  __device__ __forceinline__ void operator()(const f32x4 (&)[2][2][4][2], const Unit&, int, int, int, int) const {}
  __device__ __forceinline__ void fused(const f32x4 (&acc)[2][2][4][2], const Unit& u, int wr, int wc, int fr, int fq, PG8_LAS unsigned char* lds, int wid, int lane) const {
    PG8_LAS float* st = (PG8_LAS float*)lds;
    const int tid = wid * 64 + lane;
#pragma unroll 1
    for (int bj = 0; bj < 2; ++bj) {
#pragma unroll
      for (int ai = 0; ai < 2; ++ai)
#pragma unroll
        for (int m = 0; m < 4; ++m)
#pragma unroll
          for (int n = 0; n < 2; ++n) {
            PG8_LAS float* q = st + (ai * HALF + wr * 64 + m * 16 + fr) * 129 + wc * 32 + n * 16 + 4 * fq;
            const f32x4 v = bj == 0 ? acc[ai][0][m][n] : acc[ai][1][m][n];
            q[0] = v[0]; q[1] = v[1]; q[2] = v[2]; q[3] = v[3];
          }
      asm volatile("s_waitcnt lgkmcnt(0)" ::: "memory"); __builtin_amdgcn_s_barrier(); asm volatile("" ::: "memory");
      if (tid < 256) {
        float t16[16];
#pragma unroll
        for (int i = 0; i < 16; ++i) t16[i] = __uint_as_float(0xff800000u);
        for (int kk = 0; kk < 128; ++kk) {
          const float sv = st[tid * 129 + kk];
          const float x = __uint_as_float((__float_as_uint(sv) & ~0x7fu) | (unsigned)(127 - kk));
#pragma unroll
          for (int i = 15; i >= 1; --i) t16[i] = __builtin_amdgcn_fmed3f(x, t16[i - 1], t16[i]);
          t16[0] = fmaxf(t16[0], x);
        }
        unsigned* tk = topk + ((size_t)(u.pm * BM + tid) * 16 + (u.pn * 2 + bj)) * 16;
#pragma unroll
        for (int q = 0; q < 4; ++q) {
          u32x4 o; o.x = __float_as_uint(t16[q * 4]); o.y = __float_as_uint(t16[q * 4 + 1]); o.z = __float_as_uint(t16[q * 4 + 2]); o.w = __float_as_uint(t16[q * 4 + 3]);
          *(u32x4*)(tk + q * 4) = o;
        }
      }
      asm volatile("s_waitcnt lgkmcnt(0)" ::: "memory"); __builtin_amdgcn_s_barrier(); asm volatile("" ::: "memory");
    }
  }
};
struct EpiZI8 {
  static constexpr bool PERM = true, AFTER_DRAIN = false;
  bf16_t* O; int ldc; const float* rsc; const float* csc;
  __device__ __forceinline__ void operator()(const i32x4 (&acc)[2][2][4][2], const Unit& u, int wr, int wc, int fr, int fq) const {
    const int row0 = u.pm * BM + wr * 64 + fr, col0 = u.pn * BM + wc * 32 + 8 * fq;
    f32x4 cs[2][2];
#pragma unroll
    for (int bj = 0; bj < 2; ++bj)
#pragma unroll
      for (int n = 0; n < 2; ++n) cs[bj][n] = *(const f32x4*)(csc + col0 + bj * HALF + 4 * n);
#pragma unroll
    for (int ai = 0; ai < 2; ++ai)
#pragma unroll
      for (int m = 0; m < 4; ++m) { const int row = row0 + ai * HALF + m * 16; const float rs = rsc[row]; bf16_t* rowp = O + (size_t)row * ldc + col0;
#pragma unroll
        for (int bj = 0; bj < 2; ++bj) { const i32x4 a0 = acc[ai][bj][m][0], a1 = acc[ai][bj][m][1];
          u32x4 w;
          w.x = ::pack2((float)a0[0] * rs * cs[bj][0][0], (float)a0[1] * rs * cs[bj][0][1]); w.y = ::pack2((float)a0[2] * rs * cs[bj][0][2], (float)a0[3] * rs * cs[bj][0][3]);
          w.z = ::pack2((float)a1[0] * rs * cs[bj][1][0], (float)a1[1] * rs * cs[bj][1][1]); w.w = ::pack2((float)a1[2] * rs * cs[bj][1][2], (float)a1[3] * rs * cs[bj][1][3]);
          *(u32x4*)(rowp + bj * HALF) = w; } }
  }
};
struct EpiTopkI8 {
  static constexpr bool PERM = false, AFTER_DRAIN = true;
  unsigned* topk; const float* rsc; const float* csc;
  __device__ __forceinline__ void operator()(const i32x4 (&)[2][2][4][2], const Unit&, int, int, int, int) const {}
  __device__ __forceinline__ void fused(const i32x4 (&acc)[2][2][4][2], const Unit& u, int wr, int wc, int fr, int fq, PG8_LAS unsigned char* lds, int wid, int lane) const {
    PG8_LAS float* st = (PG8_LAS float*)lds;
    const int tid = wid * 64 + lane;
    float rs[2][4];
#pragma unroll
    for (int ai = 0; ai < 2; ++ai)
#pragma unroll
      for (int m = 0; m < 4; ++m) rs[ai][m] = rsc[u.pm * BM + ai * HALF + wr * 64 + m * 16 + fr];
#pragma unroll 1
    for (int bj = 0; bj < 2; ++bj) {
      f32x4 cs[2];
#pragma unroll
      for (int n = 0; n < 2; ++n) cs[n] = *(const f32x4*)(csc + u.pn * BM + bj * HALF + wc * 32 + n * 16 + 4 * fq);
#pragma unroll
      for (int ai = 0; ai < 2; ++ai)
#pragma unroll
        for (int m = 0; m < 4; ++m)
#pragma unroll
          for (int n = 0; n < 2; ++n) {
            PG8_LAS float* q = st + (ai * HALF + wr * 64 + m * 16 + fr) * 129 + wc * 32 + n * 16 + 4 * fq;
            const i32x4 v = bj == 0 ? acc[ai][0][m][n] : acc[ai][1][m][n];
            q[0] = (float)v[0] * rs[ai][m] * cs[n][0]; q[1] = (float)v[1] * rs[ai][m] * cs[n][1]; q[2] = (float)v[2] * rs[ai][m] * cs[n][2]; q[3] = (float)v[3] * rs[ai][m] * cs[n][3];
          }
      asm volatile("s_waitcnt lgkmcnt(0)" ::: "memory"); __builtin_amdgcn_s_barrier(); asm volatile("" ::: "memory");
      if (tid < 256) {
        float t16[16];
#pragma unroll
        for (int i = 0; i < 16; ++i) t16[i] = __uint_as_float(0xff800000u);
        for (int kk = 0; kk < 128; ++kk) {
          const float sv = st[tid * 129 + kk];
          const float x = __uint_as_float((__float_as_uint(sv) & ~0x7fu) | (unsigned)(127 - kk));
#pragma unroll
          for (int i = 15; i >= 1; --i) t16[i] = __builtin_amdgcn_fmed3f(x, t16[i - 1], t16[i]);
          t16[0] = fmaxf(t16[0], x);
        }
        unsigned* tk = topk + ((size_t)(u.pm * BM + tid) * 16 + (u.pn * 2 + bj)) * 16;
#pragma unroll
        for (int q = 0; q < 4; ++q) {
          u32x4 o; o.x = __float_as_uint(t16[q * 4]); o.y = __float_as_uint(t16[q * 4 + 1]); o.z = __float_as_uint(t16[q * 4 + 2]); o.w = __float_as_uint(t16[q * 4 + 3]);
          *(u32x4*)(tk + q * 4) = o;
        }
      }
      asm volatile("s_waitcnt lgkmcnt(0)" ::: "memory"); __builtin_amdgcn_s_barrier(); asm volatile("" ::: "memory");
    }
  }
};
}

enum { G8_Z = 0, G8_RES = 1, G8_TOPK = 2 };
template <int EPI>
DI void gemm8_phase(KP p, unsigned char* smem, const u16* A, const u16* Bt, int N, int K, int l, int bid, int nb, int m_tiles_active, int tid) {
  pg8::Gemm g{A, Bt, m_tiles_active * 256, N, K};
  const int nN = N / 256, nunits = m_tiles_active * nN;
  PG8_LAS unsigned char* lds = (PG8_LAS unsigned char*)smem;
  if constexpr (EPI == G8_Z) {
    pg8::LinOrder S{nN, nunits, nb, bid};
    pg8::Gemm g8{(const pg8::bf16_t*)(p.ws + WS_HXQ), (const pg8::bf16_t*)(p.ws + WS_WINQ + (size_t)l * 4096 * 1024), m_tiles_active * 256, N, K};
    pg8::EpiZI8 E{(pg8::bf16_t*)(p.ws + WS_Z), N, (const float*)(p.ws + WS_HXS), (const float*)(p.ws + WS_WINS) + (size_t)l * 4096};
    pg8::gemm_phase_i8<pg8::EpiZI8, pg8::LinOrder>(lds, g8, S, E, tid);
  } else if constexpr (EPI == G8_RES) {
    pg8::LinOrder S{nN, nunits, nb, bid};
    pg8::EpiRes E{(pg8::bf16_t*)(p.ws + WS_XW), (const float*)(p.ws + WS_MOD) + (size_t)l * 5 * 6144};
    pg8::gemm_phase<pg8::EpiRes, pg8::LinOrder>(lds, g, S, E, tid);
  } else {
    pg8::Gemm g8{(const pg8::bf16_t*)(p.ws + WS_HXQ), (const pg8::bf16_t*)(p.ws + WS_WSQ + (size_t)l * 2048 * 1024), m_tiles_active * 256, N, K};
    pg8::EpiTopkI8 E{(unsigned*)(p.ws + WS_TOPK), (const float*)(p.ws + WS_HXS), (const float*)(p.ws + WS_WSS) + (size_t)l * 2048};
#pragma unroll 1
    for (int L = bid; L < nunits; L += nb) {
      pg8::OneUnit S{pg8::Unit{L / nN, L % nN}};
      pg8::gemm_phase_i8<pg8::EpiTopkI8, pg8::OneUnit>(lds, g8, S, E, tid);
    }
  }
  __syncthreads();
  if constexpr (EPI == G8_Z) {
    const int rem = nunits % nb;
    if (l + 1 < DEPTH && rem != 0 && bid >= rem) p0_mod_groups(p, (float*)smem, 192 * (l + 1), bid - rem, nb - rem, tid);
  }
  if constexpr (EPI == G8_RES || EPI == G8_TOPK) {
    const int rem = nunits % nb;
    if (l + 1 < DEPTH && rem != 0 && bid >= rem) {
      const float* src = (EPI == G8_RES ? p.peer_u : p.peer_v);
      unsigned char* dst = p.ws + (EPI == G8_RES ? WS_UB : WS_VB);
      float* scl = (float*)(p.ws + (EPI == G8_RES ? WS_US : WS_VS));
#pragma unroll 1
      for (int it = bid - rem; it < 256; it += nb - rem) p0_quant_rows(src, dst, scl, (l + 1) * NEXP + it * 64, tid, 0.f);
    }
  }
}

constexpr float LOG2E = 1.4426950408889634f;
DI int seg_row0(int b, int j) { return j < 2 ? NLAT + b * CTXL + 128 * j : b * SEQ + 128 * (j - 2); }
DI int pi_bwd(int j) { return j < 2 ? 1 - j : 35 - j; }
DI float ex2(float x) { return __builtin_amdgcn_exp2f(x); }
DI unsigned sw32(int row, int col) { return (unsigned)(row * 64 + ((((col >> 3) ^ ((row >> 2) & 3))) << 4) + (col & 7) * 2); }
DI bf16x8 pack8(float a0, float a1, float a2, float a3, float a4, float a5, float a6, float a7) {
  u32x4 p; p[0] = pack2(a0, a1); p[1] = pack2(a2, a3); p[2] = pack2(a4, a5); p[3] = pack2(a6, a7);
  return __builtin_bit_cast(bf16x8, p);
}
DI bf16x8 cat8(u32x2 lo, u32x2 hi) { u32x4 p; p[0] = lo[0]; p[1] = lo[1]; p[2] = hi[0]; p[3] = hi[1]; return __builtin_bit_cast(bf16x8, p); }

DI void rec_pass1(KP p, unsigned char* smem, int l, int item, int tid) {
  const int j = item % 34, bh = item / 34, b = bh >> 2, hd = bh & 3;
  const int R0 = seg_row0(b, j);
  const int lane = tid & 63, wave = tid >> 6, r = lane & 31, h = lane >> 5;
  unsigned char* KOT = smem;
  unsigned char* VT = smem + 65536;
  float* TX = (float*)(smem + 98304);
  const u16* Z = (const u16*)(p.ws + WS_Z);
  const int k = tid & 127, qd = tid >> 7;
  unsigned char* STG = smem + 100352;
  u32x4 pre[4];
  auto gstage = [&](int colbase) {
#pragma unroll
    for (int u = 0; u < 4; ++u) { const int q = tid + NTHR * u; pre[u] = *(const u32x4*)(Z + (size_t)(R0 + (q >> 4)) * INC + colbase + (q & 15) * 8); }
  };
  auto wstage = [&]() {
#pragma unroll
    for (int u = 0; u < 4; ++u) { const int q = tid + NTHR * u; *(u32x4*)(STG + q * 16) = pre[u]; }
  };
  gstage(hd * 128);
  wstage();
  __syncthreads();
  gstage(512 + hd * 128);
  {
    u16 vv[32];
#pragma unroll
    for (int ii = 0; ii < 32; ++ii) vv[ii] = *(const u16*)(STG + (32 * qd + ii) * 256 + k * 2);
#pragma unroll
    for (int c4 = 0; c4 < 4; ++c4) {
      u32x4 o;
#pragma unroll
      for (int e = 0; e < 4; ++e) o[e] = (unsigned)vv[c4 * 8 + 2 * e] | ((unsigned)vv[c4 * 8 + 2 * e + 1] << 16);
      *(u32x4*)(VT + sw128(k, 32 * qd + 8 * c4)) = o;
    }
  }
  __syncthreads();
#pragma unroll 1
  for (int d = 0; d < 2; ++d) {
    wstage();
    __syncthreads();
    if (d == 0) gstage(1024 + hd * 128);
    const float lb = ((const float*)(p.ws + WS_LOWER))[((size_t)l * 2 + d) * 512 + hd * 128 + k];
    float lf[32], kk[32];
    float tot = 0.f;
#pragma unroll
    for (int ii = 0; ii < 32; ++ii) {
      const float z = bf2f(*(const u16*)(STG + (32 * qd + ii) * 256 + k * 2));
      const float sg = __builtin_amdgcn_rcpf(1.f + ex2(-z * LOG2E));
      const float f = fmaxf(lb + (1.f - lb) * sg, 1e-20f);
      lf[ii] = __builtin_amdgcn_logf(f);
      kk[ii] = (1.f - lb) * (1.f - sg);
      tot += lf[ii];
    }
    TX[qd * 128 + k] = tot;
    __syncthreads();
    const float t0 = TX[k], t1 = TX[128 + k], t2 = TX[256 + k], t3 = TX[384 + k];
    float run;
    if (d == 0) run = (qd == 0 ? t1 + t2 + t3 : qd == 1 ? t2 + t3 : qd == 2 ? t3 : 0.f);
    else run = (qd == 0 ? 0.f : qd == 1 ? t0 : qd == 2 ? t0 + t1 : t0 + t1 + t2);
    float ko[32];
    if (d == 0) {
#pragma unroll
      for (int ii = 31; ii >= 0; --ii) { ko[ii] = kk[ii] * ex2(run); run += lf[ii]; }
    } else {
#pragma unroll
      for (int ii = 0; ii < 32; ++ii) { ko[ii] = kk[ii] * ex2(run); run += lf[ii]; }
    }
#pragma unroll
    for (int c4 = 0; c4 < 4; ++c4) {
      u32x4 o;
#pragma unroll
      for (int e = 0; e < 4; ++e) o[e] = pack2(ko[c4 * 8 + 2 * e], ko[c4 * 8 + 2 * e + 1]);
      *(u32x4*)(KOT + d * 32768 + sw128(k, 32 * qd + 8 * c4)) = o;
    }
    if (qd == 0) {
      const int pi = d ? pi_bwd(j) : j;
      ((float*)(p.ws + WS_DT))[((size_t)(bh * 2 + d) * 34 + pi) * 128 + k] = ex2(t0 + t1 + t2 + t3);
    }
    __syncthreads();
  }
  {
    const int d = wave >> 2, w4 = wave & 3;
    f32x16 acc[4];
#pragma unroll
    for (int mt = 0; mt < 4; ++mt)
#pragma unroll
      for (int e = 0; e < 16; ++e) acc[mt][e] = 0.f;
#pragma unroll
    for (int ks = 0; ks < 8; ++ks) {
      const bf16x8 bv = *(const bf16x8*)(VT + sw128(32 * w4 + r, 16 * ks + 8 * h));
#pragma unroll
      for (int mt = 0; mt < 4; ++mt) {
        const bf16x8 av = *(const bf16x8*)(KOT + d * 32768 + sw128(32 * mt + r, 16 * ks + 8 * h));
        acc[mt] = __builtin_amdgcn_mfma_f32_32x32x16_bf16(av, bv, acc[mt], 0, 0, 0);
      }
    }
    const int pi = d ? pi_bwd(j) : j;
    u16* sl = (u16*)(p.ws + WS_SLOC) + ((size_t)(bh * 2 + d) * 34 + pi) * 16384;
#pragma unroll
    for (int mt = 0; mt < 4; ++mt)
#pragma unroll
      for (int g = 0; g < 4; ++g) {
        u32x2 o; o[0] = pack2(acc[mt][4 * g], acc[mt][4 * g + 1]); o[1] = pack2(acc[mt][4 * g + 2], acc[mt][4 * g + 3]);
        *(u32x2*)(sl + ((((w4 * 4 + mt) * 4 + g) * 64 + lane) * 4)) = o;
      }
  }
  __syncthreads();
}

DI void rec_pass2(KP p, int bid, int nb, int tid) {
  const u16* SL = (const u16*)(p.ws + WS_SLOC);
  u16* SS = (u16*)(p.ws + WS_SST);
  const float* DT = (const float*)(p.ws + WS_DT);
  for (int gid = bid * NTHR + tid; gid < 32 * 4096; gid += nb * NTHR) {
    const int seq = gid >> 12, grp = gid & 4095;
    const int lane = grp & 63, g = (grp >> 6) & 3, mt = (grp >> 8) & 3;
    const int k0 = 32 * mt + 8 * g + 4 * (lane >> 5);
    const u16* sl = SL + (size_t)seq * 34 * 16384 + grp * 4;
    u16* ss = SS + (size_t)seq * 34 * 16384 + grp * 4;
    const float* dt = DT + (size_t)seq * 34 * 128 + k0;
    float s0 = 0.f, s1 = 0.f, s2 = 0.f, s3 = 0.f;
#pragma unroll 3
    for (int pi = 0; pi < 33; ++pi) {
      const u32x2 w = *(const u32x2*)(sl + (size_t)pi * 16384);
      const float4 dd = *(const float4*)(dt + pi * 128);
      s0 = dd.x * s0 + bflo(w[0]); s1 = dd.y * s1 + bfhi(w[0]); s2 = dd.z * s2 + bflo(w[1]); s3 = dd.w * s3 + bfhi(w[1]);
      u32x2 o; o[0] = pack2(s0, s1); o[1] = pack2(s2, s3);
      *(u32x2*)(ss + (size_t)(pi + 1) * 16384) = o;
    }
  }
}

DI void rec_pass3(KP p, unsigned char* smem, int l, int item, int tid) {
  const int j = item % 34, bh = item / 34, b = bh >> 2, hd = bh & 3;
  const int R0 = seg_row0(b, j);
  const int lane = tid & 63, wave = tid >> 6, r = lane & 31, h = lane >> 5;
  const int d = tid >> 8, tt = tid & 255, w4 = wave & 3;
  unsigned char* base = smem + d * 67584;
  unsigned char* SZ = base, *SQ = base + 8192, *SV = base + 16384;
  unsigned char* QT = base + 24576, *KT = base + 32768, *QI = base + 40960, *KOT = base + 49152, *VT = base + 57344;
  float* DTc = (float*)(base + 65536);
  float* TX = (float*)(base + 66048);
  const u16* Z = (const u16*)(p.ws + WS_Z);
  u16* O = (u16*)(p.ws + (d ? WS_OB : WS_OF));
  const int pi = d ? pi_bwd(j) : j;
  f32x16 S[4];
  if (pi == 0) {
#pragma unroll
    for (int mt = 0; mt < 4; ++mt)
#pragma unroll
      for (int e = 0; e < 16; ++e) S[mt][e] = 0.f;
  } else {
    const u16* ss = (const u16*)(p.ws + WS_SST) + ((size_t)(bh * 2 + d) * 34 + pi) * 16384;
#pragma unroll
    for (int mt = 0; mt < 4; ++mt)
#pragma unroll
      for (int g = 0; g < 4; ++g) {
        const u32x2 w = *(const u32x2*)(ss + ((((w4 * 4 + mt) * 4 + g) * 64 + lane) * 4));
        S[mt][4 * g] = bflo(w[0]); S[mt][4 * g + 1] = bfhi(w[0]); S[mt][4 * g + 2] = bflo(w[1]); S[mt][4 * g + 3] = bfhi(w[1]);
      }
  }
  const int k = tt & 127, half = tt >> 7;
  const float lb = ((const float*)(p.ws + WS_LOWER))[((size_t)l * 2 + d) * 512 + hd * 128 + k];
  const int zg_col = (d ? 1024 : 512) + hd * 128, q_col = 1536 + hd * 128, v_col = hd * 128;
  u32x4 pz[2], pq[2], pv[2];
  auto gl = [&](int c) {
#pragma unroll
    for (int u = 0; u < 2; ++u) {
      const int q = tt + 256 * u, i = q >> 4, c16 = q & 15;
      const int n = d ? (127 - 32 * c - i) : (32 * c + i);
      const u16* zr = Z + (size_t)(R0 + n) * INC + c16 * 8;
      pz[u] = *(const u32x4*)(zr + zg_col); pq[u] = *(const u32x4*)(zr + q_col); pv[u] = *(const u32x4*)(zr + v_col);
    }
  };
  gl(0);
#pragma unroll 1
  for (int c = 0; c < 4; ++c) {
#pragma unroll
    for (int u = 0; u < 2; ++u) {
      const int q = tt + 256 * u;
      *(u32x4*)(SZ + q * 16) = pz[u]; *(u32x4*)(SQ + q * 16) = pq[u]; *(u32x4*)(SV + q * 16) = pv[u];
    }
    __syncthreads();
    if (c + 1 < 4) gl(c + 1);
    {
      float cc = 0.f;
#pragma unroll
      for (int ii = 0; ii < 16; ++ii) {
        const int i = 16 * half + ii;
        const float z = bf2f(*(const u16*)(SZ + i * 256 + k * 2));
        const float sg = __builtin_amdgcn_rcpf(1.f + ex2(-z * LOG2E));
        const float f = fmaxf(lb + (1.f - lb) * sg, 1e-20f);
        cc += __builtin_amdgcn_logf(f);
      }
      TX[half * 128 + k] = cc;
    }
    __syncthreads();
    {
      const float T0 = TX[k], T1 = TX[128 + k];
      const float e0 = ex2(T0), e1 = ex2(T1);
      float ko[16];
      float cc = 0.f;
#pragma unroll
      for (int ii = 0; ii < 16; ++ii) {
        const int i = 16 * half + ii;
        const float z = bf2f(*(const u16*)(SZ + i * 256 + k * 2));
        const float sg = __builtin_amdgcn_rcpf(1.f + ex2(-z * LOG2E));
        const float f = fmaxf(lb + (1.f - lb) * sg, 1e-20f);
        cc += __builtin_amdgcn_logf(f);
        const float kk = (1.f - lb) * (1.f - sg);
        const float qq = bf2f(*(const u16*)(SQ + i * 256 + k * 2));
        float qt, qi, kt;
        if (half == 0) {
          qt = qq * ex2(fminf(cc - T0, 120.f)); qi = qq * ex2(cc);
          kt = kk * ex2(T0 - cc); ko[ii] = kt * e1;
        } else {
          qt = qq * ex2(cc); qi = qt * e0;
          kt = kk * ex2(fminf(-cc, 120.f)); ko[ii] = kk * ex2(T1 - cc);
        }
        *(u16*)(QT + sw128(i, k)) = f2bf(qt); *(u16*)(KT + sw128(i, k)) = f2bf(kt); *(u16*)(QI + sw128(i, k)) = f2bf(qi);
      }
      if (half == 0) DTc[k] = e0 * e1;
      u32x4 o0, o1;
#pragma unroll
      for (int e = 0; e < 4; ++e) { o0[e] = pack2(ko[2 * e], ko[2 * e + 1]); o1[e] = pack2(ko[8 + 2 * e], ko[8 + 2 * e + 1]); }
      *(u32x4*)(KOT + sw32(k, 16 * half)) = o0; *(u32x4*)(KOT + sw32(k, 16 * half + 8)) = o1;
      u32x4 v0, v1;
#pragma unroll
      for (int e = 0; e < 4; ++e) {
        v0[e] = (unsigned)*(const u16*)(SV + (16 * half + 2 * e) * 256 + k * 2) | ((unsigned)*(const u16*)(SV + (16 * half + 2 * e + 1) * 256 + k * 2) << 16);
        v1[e] = (unsigned)*(const u16*)(SV + (16 * half + 8 + 2 * e) * 256 + k * 2) | ((unsigned)*(const u16*)(SV + (16 * half + 8 + 2 * e + 1) * 256 + k * 2) << 16);
      }
      *(u32x4*)(VT + sw32(k, 16 * half)) = v0; *(u32x4*)(VT + sw32(k, 16 * half + 8)) = v1;
    }
    __syncthreads();
    {
      f32x16 X;
#pragma unroll
      for (int e = 0; e < 16; ++e) X[e] = 0.f;
#pragma unroll 2
      for (int ks = 0; ks < 8; ++ks) {
        const bf16x8 a = *(const bf16x8*)(KT + sw128(r, 16 * ks + 8 * h));
        const bf16x8 bq = *(const bf16x8*)(QT + sw128(r, 16 * ks + 8 * h));
        X = __builtin_amdgcn_mfma_f32_32x32x16_bf16(a, bq, X, 0, 0, 0);
      }
#pragma unroll
      for (int e = 0; e < 16; ++e) { const int sidx = (e & 3) + 8 * (e >> 2) + 4 * h; if (sidx > r) X[e] = 0.f; }
      f32x16 o;
#pragma unroll
      for (int e = 0; e < 16; ++e) o[e] = 0.f;
#pragma unroll
      for (int s2 = 0; s2 < 2; ++s2) {
        const bf16x8 xa = pack8(X[8 * s2], X[8 * s2 + 1], X[8 * s2 + 2], X[8 * s2 + 3], X[8 * s2 + 4], X[8 * s2 + 5], X[8 * s2 + 6], X[8 * s2 + 7]);
        const u32x2 lo = *(const u32x2*)(VT + sw32(32 * w4 + r, 16 * s2 + 4 * h));
        const u32x2 hi = *(const u32x2*)(VT + sw32(32 * w4 + r, 16 * s2 + 8 + 4 * h));
        o = __builtin_amdgcn_mfma_f32_32x32x16_bf16(xa, cat8(lo, hi), o, 0, 0, 0);
      }
#pragma unroll
      for (int mt = 0; mt < 4; ++mt)
#pragma unroll
        for (int s2 = 0; s2 < 2; ++s2) {
          const bf16x8 sb = pack8(S[mt][8 * s2], S[mt][8 * s2 + 1], S[mt][8 * s2 + 2], S[mt][8 * s2 + 3], S[mt][8 * s2 + 4], S[mt][8 * s2 + 5], S[mt][8 * s2 + 6], S[mt][8 * s2 + 7]);
          const u32x2 lo = *(const u32x2*)(QI + sw128(r, 32 * mt + 16 * s2 + 4 * h));
          const u32x2 hi = *(const u32x2*)(QI + sw128(r, 32 * mt + 16 * s2 + 8 + 4 * h));
          o = __builtin_amdgcn_mfma_f32_32x32x16_bf16(cat8(lo, hi), sb, o, 0, 0, 0);
          if (s2 == 1) __builtin_amdgcn_sched_barrier(0);
        }
#pragma unroll
      for (int mt = 0; mt < 4; ++mt)
#pragma unroll
        for (int g = 0; g < 4; ++g) {
          const float4 dd = *(const float4*)(DTc + 32 * mt + 8 * g + 4 * h);
          S[mt][4 * g] *= dd.x; S[mt][4 * g + 1] *= dd.y; S[mt][4 * g + 2] *= dd.z; S[mt][4 * g + 3] *= dd.w;
        }
#pragma unroll
      for (int s2 = 0; s2 < 2; ++s2) {
        const bf16x8 bv = *(const bf16x8*)(VT + sw32(32 * w4 + r, 16 * s2 + 8 * h));
#pragma unroll
        for (int mt = 0; mt < 4; ++mt) {
          const bf16x8 av = *(const bf16x8*)(KOT + sw32(32 * mt + r, 16 * s2 + 8 * h));
          S[mt] = __builtin_amdgcn_mfma_f32_32x32x16_bf16(av, bv, S[mt], 0, 0, 0);
        }
      }
#pragma unroll
      for (int e = 0; e < 16; ++e) {
        const int i = (e & 3) + 8 * (e >> 2) + 4 * h;
        const int n = d ? (127 - 32 * c - i) : (32 * c + i);
        O[(size_t)(R0 + n) * 512 + hd * 128 + 32 * w4 + r] = f2bf(o[e]);
      }
    }
  }
  __syncthreads();
}

DI void conv_rows8(KP p, int l, int row0, int tid) {
  const int lane = tid & 63, row = row0 + (tid >> 6);
  const int ch = lane * 8;
  const u16* Z = (const u16*)(p.ws + WS_Z);
  u16* cat = (u16*)(p.ws + WS_CAT);
  const float* cw = p.conv_w + (size_t)l * 3 * 512 + ch;
  int rm, rp; bool hm, hp_;
  if (row < NLAT) {
    const int t = row & 4095, gr = t >> 6, gc = t & 63;
    if (ch < 256) { hm = gc > 0; hp_ = gc < 63; rm = row - 1; rp = row + 1; }
    else { hm = gr > 0; hp_ = gr < 63; rm = row - 64; rp = row + 64; }
  } else {
    const int t = (row - NLAT) & 255;
    hm = t > 0; hp_ = t < 255; rm = row - 1; rp = row + 1;
  }
  if (!hm) rm = row;
  if (!hp_) rp = row;
  const u32x4 c0 = *(const u32x4*)(Z + (size_t)row * INC + 2560 + ch), h0 = *(const u32x4*)(Z + (size_t)row * INC + 3584 + ch);
  const u32x4 cm = *(const u32x4*)(Z + (size_t)rm * INC + 2560 + ch), hmv = *(const u32x4*)(Z + (size_t)rm * INC + 3584 + ch);
  const u32x4 cp = *(const u32x4*)(Z + (size_t)rp * INC + 2560 + ch), hpv = *(const u32x4*)(Z + (size_t)rp * INC + 3584 + ch);
  const u32x4 bgv = *(const u32x4*)(Z + (size_t)row * INC + 3072 + ch);
  const float4 w0a = *(const float4*)cw, w0b = *(const float4*)(cw + 4);
  const float4 w1a = *(const float4*)(cw + 512), w1b = *(const float4*)(cw + 516);
  const float4 w2a = *(const float4*)(cw + 1024), w2b = *(const float4*)(cw + 1028);
  const float w0[8] = {w0a.x, w0a.y, w0a.z, w0a.w, w0b.x, w0b.y, w0b.z, w0b.w};
  const float w1[8] = {w1a.x, w1a.y, w1a.z, w1a.w, w1b.x, w1b.y, w1b.z, w1b.w};
  const float w2[8] = {w2a.x, w2a.y, w2a.z, w2a.w, w2b.x, w2b.y, w2b.z, w2b.w};
  const float fm = hm ? 1.f : 0.f, fp = hp_ ? 1.f : 0.f;
  u32x4 o;
#pragma unroll
  for (int e = 0; e < 4; ++e) {
    float r2[2];
#pragma unroll
    for (int hh = 0; hh < 2; ++hh) {
      const float uc = (hh ? bfhi(c0[e]) : bflo(c0[e])) * (hh ? bfhi(h0[e]) : bflo(h0[e]));
      const float um = (hh ? bfhi(cm[e]) : bflo(cm[e])) * (hh ? bfhi(hmv[e]) : bflo(hmv[e]));
      const float up = (hh ? bfhi(cp[e]) : bflo(cp[e])) * (hh ? bfhi(hpv[e]) : bflo(hpv[e]));
      const float bg = hh ? bfhi(bgv[e]) : bflo(bgv[e]);
      r2[hh] = bg * (w1[2 * e + hh] * uc + fm * w0[2 * e + hh] * um + fp * w2[2 * e + hh] * up);
    }
    o[e] = pack2(r2[0], r2[1]);
  }
  *(u32x4*)(cat + (size_t)row * D + 512 + ch) = o;
}

DI void phase_rec1(KP p, unsigned char* smem, int l, int bid, int nb, int tid) {
  const int nitems = 544 + NTOK / 8;
  for (int it = bid; it < nitems; it += nb) {
    if (it < 544) rec_pass1(p, smem, l, it, tid);
    else conv_rows8(p, l, (it - 544) * 8, tid);
  }
}
DI void phase_rec3(KP p, unsigned char* smem, int l, int bid, int nb, int tid) {
  for (int it = bid; it < 544; it += nb) {
    if (l == DEPTH - 1 && (it % 34) < 2) continue;
    rec_pass3(p, smem, l, it, tid);
  }
}

DI void phase_recpost(KP p, int l, int bid, int nb, int tid) {
  const int lane = tid & 63, wave = tid >> 6;
  const u16* OF = (const u16*)(p.ws + WS_OF);
  const u16* OB = (const u16*)(p.ws + WS_OB);
  const u16* Z = (const u16*)(p.ws + WS_Z);
  u16* cat = (u16*)(p.ws + WS_CAT);
  for (int row = bid * 8 + wave; row < NTOK; row += nb * 8) {
    const u32x4 af = *(const u32x4*)(OF + (size_t)row * 512 + lane * 8), ab = *(const u32x4*)(OB + (size_t)row * 512 + lane * 8);
    float o[8];
#pragma unroll
    for (int e = 0; e < 4; ++e) { o[2 * e] = bflo(af[e]) + bflo(ab[e]); o[2 * e + 1] = bfhi(af[e]) + bfhi(ab[e]); }
    float ss = 0.f;
#pragma unroll
    for (int e = 0; e < 8; ++e) ss += o[e] * o[e];
    ss += __shfl_xor(ss, 1); ss += __shfl_xor(ss, 2); ss += __shfl_xor(ss, 4); ss += __shfl_xor(ss, 8);
    const float rs = rsqrtf(ss * (1.f / 128.f) + EPS);
    const u32x4 gw = *(const u32x4*)(Z + (size_t)row * INC + 2048 + lane * 8);
    u32x4 ow;
#pragma unroll
    for (int e = 0; e < 4; ++e) {
      const float g0 = bflo(gw[e]), g1 = bfhi(gw[e]);
      ow[e] = pack2(o[2 * e] * rs * siluf_(g0), o[2 * e + 1] * rs * siluf_(g1));
    }
    *(u32x4*)(cat + (size_t)row * D + lane * 8) = ow;
  }
}

DI float gelu_erf(float x) { return 0.5f * x * (1.f + erff(x * 0.70710678118654752f)); }

using i32x4 = __attribute__((ext_vector_type(4))) int;
constexpr int PM_CF = 0, PM_WG = 32768, PM_HQ = 65536, PM_CM = 65536, PM_IB = 65536, PM_MISC = 133120;
DI unsigned pm_perm(unsigned hi, unsigned lo, unsigned sel) { return __builtin_amdgcn_perm(hi, lo, sel); }

DI void peer_mfma_pass(KP p, unsigned char* smem, int l, int row0, int ntok, int tid) {
  const int lane = tid & 63, wave = __builtin_amdgcn_readfirstlane(tid >> 6);
  const int ngroups = (ntok + 15) >> 4;
  const int nwg = ngroups >= 4 ? 2 : 8;
  const int tg = ngroups >= 4 ? (wave >> 1) : 0, ch = ngroups >= 4 ? (wave & 1) : wave;
  float* CF = (float*)(smem + PM_CF);
  unsigned* WG = (unsigned*)(smem + PM_WG);
  unsigned char* HQ = smem + PM_HQ;
  unsigned short* CM = (unsigned short*)(smem + PM_CM);
  unsigned* CNT = (unsigned*)(smem + PM_MISC);
  float* HS = (float*)(smem + PM_MISC) + 128;
  unsigned* CMAX = (unsigned*)(smem + PM_MISC) + 192;
  float* SS = (float*)(smem + PM_MISC) + 256;
  const unsigned char* UB = p.ws + WS_UB + (size_t)l * NEXP * D;
  const unsigned char* VB = p.ws + WS_VB + (size_t)l * NEXP * D;
  const float* US = (const float*)(p.ws + WS_US) + (size_t)l * NEXP;
  const float* VS = (const float*)(p.ws + WS_VS) + (size_t)l * NEXP;
  const float* mod = (const float*)(p.ws + WS_MOD);
#ifdef PROBE_ABC
#pragma unroll 1
  for (int arep = 0; arep < 2; ++arep) {
#endif
  if (tid < 128) CNT[tid] = 0u;
  if (tid < 64) { CMAX[tid] = 0u; SS[tid] = 0.f; }
  __syncthreads();
  unsigned ent[16], slot[16];
  const bool actA = tid < ntok * 8;
  if (actA) {
    const int t = tid >> 3, head = tid & 7;
    unsigned char* IB = smem + PM_IB + tid * 32;
    const unsigned* t1 = (const unsigned*)(p.ws + WS_TOPK) + ((size_t)(row0 + t) * 16 + head * 2) * 16;
    float s1[16], s2[16];
#pragma unroll
    for (int q = 0; q < 4; ++q) {
      const u32x4 a = *(const u32x4*)(t1 + q * 4), b = *(const u32x4*)(t1 + 16 + q * 4);
#pragma unroll
      for (int e = 0; e < 4; ++e) {
        s1[q * 4 + e] = __uint_as_float(a[e]); s2[q * 4 + e] = __uint_as_float(b[e]);
        IB[q * 4 + e] = (unsigned char)(127u - (a[e] & 127u));
        IB[16 + q * 4 + e] = (unsigned char)(127u - (b[e] & 127u));
      }
    }
    float t16[16];
#pragma unroll
    for (int i = 0; i < 16; ++i) t16[i] = __uint_as_float(0xff800000u);
#pragma unroll
    for (int i = 0; i < 16; ++i)
#pragma unroll
      for (int j = 0; j < 16; ++j)
        if ((i + 1) * (j + 1) <= 16) {
          const float sm = s1[i] + s2[j];
          const float x = __uint_as_float((__float_as_uint(sm) & ~0xffu) | (unsigned)(255 - (i * 16 + j)));
#pragma unroll
          for (int q = 15; q >= 1; --q) t16[q] = __builtin_amdgcn_fmed3f(x, t16[q - 1], t16[q]);
          t16[0] = fmaxf(t16[0], x);
        }
    float den = 0.f;
#pragma unroll
    for (int i = 0; i < 16; ++i) den += __expf(t16[i] - t16[0]);
    const float inv = 16383.f / den;
    const unsigned mtag = (unsigned)(t & 15) << 14;
    unsigned* cg = CNT + (t >> 4) * 32;
#pragma unroll
    for (int i = 0; i < 16; ++i) {
      const unsigned ci = 255u - (__float_as_uint(t16[i]) & 255u);
      const unsigned i1 = IB[ci >> 4], i2 = IB[16 + (ci & 15)];
      const unsigned gq = (unsigned)(int)rintf(__expf(t16[i] - t16[0]) * inv);
      const unsigned en = ((i1 * 128u + i2) << 18) | mtag | gq;
      ent[i] = en;
      slot[i] = atomicAdd(&cg[en >> 27], 1u);
    }
  }
  __syncthreads();
  if (tid < 128) {
    const unsigned c = CNT[tid];
    unsigned inc = c;
#pragma unroll
    for (int o = 1; o < 32; o <<= 1) { const unsigned v = __shfl_up(inc, o); if ((lane & 31) >= o) inc += v; }
    CNT[tid] = inc - c;
  }
  __syncthreads();
  if (actA) {
    const int t = tid >> 3;
    unsigned* wg = WG + (t >> 4) * 2048;
    const unsigned* cg = CNT + (t >> 4) * 32;
#pragma unroll
    for (int i = 0; i < 16; ++i) wg[cg[ent[i] >> 27] + slot[i]] = ent[i];
  }
  __syncthreads();
#pragma unroll 1
  for (int i = 0; i < 8; ++i) {
    const int t = wave * 8 + i;
    if (t < ntok) {
      const u32x4 pk = *(const u32x4*)(p.ws + WS_HXQ + (size_t)(row0 + t) * D + lane * 16);
      const float sc = ((const float*)(p.ws + WS_HXS))[row0 + t];
      *(u32x4*)(HQ + t * 1024 + lane * 16) = pk;
      if (lane == 0) HS[t] = sc;
    }
  }
  __syncthreads();
#ifdef PROBE_ABC
  }
#endif
  const bool gact = tg < ngroups;
  const int nt_g = gact ? ((ntok - tg * 16) < 16 ? (ntok - tg * 16) : 16) : 0;
  const int nent = nt_g * 128;
  const unsigned* wg = WG + tg * 2048;
  float* cfg = CF + tg * 2048;
  const int mrow = lane & 15, kq = lane >> 4;
  i32x4 areg[16];
  if (gact) {
    const int tsrc = (mrow < nt_g) ? (tg * 16 + mrow) : (tg * 16);
#pragma unroll
    for (int s2 = 0; s2 < 16; ++s2) areg[s2] = *(const i32x4*)(HQ + tsrc * 1024 + 64 * s2 + 16 * kq);
  }
  __syncthreads();
#ifdef PROBE_U2
#pragma unroll 1
  for (int urep = 0; urep < 2; ++urep)
#endif
  if (gact) {
#ifdef PROBE_U2
    const unsigned uemask = urep == 0 ? PROBE_EMASK : 0xffffffffu;
#else
    const unsigned uemask = 0xffffffffu;
#endif
    unsigned char* ust = smem + PM_HQ + wave * 8320;
    const int nch = nent >> 4;
    u32x4 rr[8];
    auto gl8 = [&](int k0) {
#pragma unroll
      for (int j = 0; j < 8; ++j) {
        const unsigned en = (unsigned)__builtin_amdgcn_readfirstlane((int)wg[k0 + j]) & uemask;
        rr[j] = *(const u32x4*)(UB + (size_t)(en >> 18) * D + lane * 16);
      }
    };
    if (ch < nch) gl8(16 * ch);
#pragma unroll 1
    for (int c = ch; c < nch; c += nwg) {
      const unsigned en_cur = wg[16 * c + mrow];
      const unsigned e = en_cur >> 18;
      const float us = US[e], vs = VS[e];
      i32x4 d0 = {0, 0, 0, 0}, d1 = {0, 0, 0, 0};
#pragma unroll
      for (int j = 0; j < 8; ++j) *(u32x4*)(ust + j * 1040 + lane * 16) = rr[j];
      gl8(16 * c + 8);
#pragma unroll
      for (int s2 = 0; s2 < 16; ++s2) {
        const i32x4 b = *(const i32x4*)(ust + (mrow & 7) * 1040 + 64 * s2 + 16 * kq);
        d0 = __builtin_amdgcn_mfma_i32_16x16x64_i8(areg[s2], b, d0, 0, 0, 0);
        if ((s2 & 3) == 3) __builtin_amdgcn_sched_barrier(0);
      }
#pragma unroll
      for (int j = 0; j < 8; ++j) *(u32x4*)(ust + j * 1040 + lane * 16) = rr[j];
      if (c + nwg < nch) gl8(16 * (c + nwg));
#pragma unroll
      for (int s2 = 0; s2 < 16; ++s2) {
        const i32x4 b = *(const i32x4*)(ust + (mrow & 7) * 1040 + 64 * s2 + 16 * kq);
        d1 = __builtin_amdgcn_mfma_i32_16x16x64_i8(areg[s2], b, d1, 0, 0, 0);
        if ((s2 & 3) == 3) __builtin_amdgcn_sched_barrier(0);
      }
      const int mp = (int)((en_cur >> 14) & 15u);
      if ((mp >> 2) == kq) {
        const int r = mp & 3;
        const i32x4 dd = mrow < 8 ? d0 : d1;
        const int dv = r == 0 ? dd[0] : r == 1 ? dd[1] : r == 2 ? dd[2] : dd[3];
        const float dot = us * HS[tg * 16 + mp] * (float)dv;
        const float cf = (float)(en_cur & 0x3fffu) * (1.f / 16383.f) * gelu_erf(dot) * vs;
        cfg[16 * c + mrow] = cf;
        atomicMax(&CMAX[tg * 16 + mp], __float_as_uint(fabsf(cf)));
      }
    }
  }
  __syncthreads();
  for (int k = tid; k < ngroups * 2048; k += NTHR) {
    const int g2 = k >> 11;
    const int ntg = (ntok - g2 * 16) < 16 ? (ntok - g2 * 16) : 16;
    if ((k & 2047) < ntg * 128) {
      const unsigned en = WG[k];
      const unsigned m = (en >> 14) & 15u;
      const float cmx = __uint_as_float(CMAX[g2 * 16 + m]);
      const float q = cmx > 0.f ? rintf(CF[k] * (127.f / cmx)) : 0.f;
      CM[k] = (unsigned short)((m << 8) | (((unsigned)(int)q) & 0xffu));
    }
  }
  __syncthreads();
  if (gact) {
    const int i16 = lane & 15, kq = lane >> 4;
    const unsigned short* cmg = CM + tg * 2048;
    const int nch = nent >> 5;
    float csc[4];
#pragma unroll
    for (int r = 0; r < 4; ++r) csc[r] = __uint_as_float(CMAX[tg * 16 + 4 * kq + r]) * (1.f / 127.f);
#pragma unroll 1
    for (int cbp = 0; cbp < 8 / nwg; ++cbp) {
      const int colb = (1024 / nwg) * ch + 128 * cbp + 8 * i16;
      i32x4 acc[8];
#ifdef PROBE_V2
#pragma unroll 1
      for (int vrep = 0; vrep < 2; ++vrep) {
      const unsigned vemask = vrep == 0 ? PROBE_EMASK : 0xffffffffu;
#else
      const unsigned vemask = 0xffffffffu;
#endif
#pragma unroll
      for (int c = 0; c < 8; ++c) acc[c] = (i32x4){0, 0, 0, 0};
      u32x2 x[8];
      if (nch > 0) {
        const u32x4 w0 = *(const u32x4*)(wg + 8 * kq), w1 = *(const u32x4*)(wg + 8 * kq + 4);
#pragma unroll
        for (int j = 0; j < 4; ++j) {
          x[j] = *(const u32x2*)(VB + (size_t)((w0[j] & vemask) >> 18) * D + colb);
          x[4 + j] = *(const u32x2*)(VB + (size_t)((w1[j] & vemask) >> 18) * D + colb);
        }
      }
#pragma unroll 1
      for (int c = 0; c < nch; ++c) {
        unsigned ylo[8], yhi[8];
#pragma unroll
        for (int w = 0; w < 2; ++w) {
          {
            const unsigned t0 = pm_perm(x[1][w], x[0][w], 0x05010400u), t1 = pm_perm(x[1][w], x[0][w], 0x07030602u);
            const unsigned t2 = pm_perm(x[3][w], x[2][w], 0x05010400u), t3 = pm_perm(x[3][w], x[2][w], 0x07030602u);
            ylo[4 * w + 0] = pm_perm(t2, t0, 0x05040100u); ylo[4 * w + 1] = pm_perm(t2, t0, 0x07060302u);
            ylo[4 * w + 2] = pm_perm(t3, t1, 0x05040100u); ylo[4 * w + 3] = pm_perm(t3, t1, 0x07060302u);
          }
          {
            const unsigned t0 = pm_perm(x[5][w], x[4][w], 0x05010400u), t1 = pm_perm(x[5][w], x[4][w], 0x07030602u);
            const unsigned t2 = pm_perm(x[7][w], x[6][w], 0x05010400u), t3 = pm_perm(x[7][w], x[6][w], 0x07030602u);
            yhi[4 * w + 0] = pm_perm(t2, t0, 0x05040100u); yhi[4 * w + 1] = pm_perm(t2, t0, 0x07060302u);
            yhi[4 * w + 2] = pm_perm(t3, t1, 0x05040100u); yhi[4 * w + 3] = pm_perm(t3, t1, 0x07060302u);
          }
        }
        const u32x4 cmv = *(const u32x4*)(cmg + 32 * c + 8 * kq);
        unsigned alo = 0, ahi = 0;
#pragma unroll
        for (int j = 0; j < 8; ++j) {
          const unsigned hw = (cmv[j >> 1] >> (16 * (j & 1))) & 0xffffu;
          const unsigned bv = ((hw >> 8) == (unsigned)i16) ? (hw & 0xffu) : 0u;
          if (j < 4) alo |= bv << (8 * j); else ahi |= bv << (8 * (j - 4));
        }
        if (c + 1 < nch) {
          const u32x4 w0 = *(const u32x4*)(wg + 32 * (c + 1) + 8 * kq), w1 = *(const u32x4*)(wg + 32 * (c + 1) + 8 * kq + 4);
#pragma unroll
          for (int j = 0; j < 4; ++j) {
            x[j] = *(const u32x2*)(VB + (size_t)((w0[j] & vemask) >> 18) * D + colb);
            x[4 + j] = *(const u32x2*)(VB + (size_t)((w1[j] & vemask) >> 18) * D + colb);
          }
        }
        const i32x4 av = {(int)alo, (int)ahi, 0, 0};
#pragma unroll
        for (int cc = 0; cc < 8; ++cc) {
          const i32x4 bv = {(int)ylo[cc], (int)yhi[cc], 0, 0};
          acc[cc] = __builtin_amdgcn_mfma_i32_16x16x64_i8(av, bv, acc[cc], 0, 0, 0);
        }
      }
#ifdef PROBE_V2
      }
#endif
#pragma unroll
      for (int r = 0; r < 4; ++r) {
        const int m = 4 * kq + r;
        if (m < nt_g) {
          const int row = row0 + tg * 16 + m;
          const float* g2p = mod + ((size_t)l * 5 + row_cls(row)) * 6144 + 5120 + colb;
          u16* xr = (u16*)(p.ws + WS_XW) + (size_t)row * D + colb;
          u32x4 xw4 = *(const u32x4*)xr;
#pragma unroll
          for (int q = 0; q < 2; ++q) {
            const float4 gv = *(const float4*)(g2p + q * 4);
            xw4[2 * q] = pack2(bflo(xw4[2 * q]) + gv.x * csc[r] * (float)acc[q * 4 + 0][r], bfhi(xw4[2 * q]) + gv.y * csc[r] * (float)acc[q * 4 + 1][r]);
            xw4[2 * q + 1] = pack2(bflo(xw4[2 * q + 1]) + gv.z * csc[r] * (float)acc[q * 4 + 2][r], bfhi(xw4[2 * q + 1]) + gv.w * csc[r] * (float)acc[q * 4 + 3][r]);
          }
          *(u32x4*)xr = xw4;
        }
      }
    }
  }
  asm volatile("s_waitcnt vmcnt(0)" ::: "memory");
  __syncthreads();
  __builtin_amdgcn_fence(__ATOMIC_ACQUIRE, "workgroup");
  asm volatile("s_waitcnt vmcnt(0)" ::: "memory");
#ifdef PROBE_E2
#pragma unroll 1
  for (int erep = 0; erep < 2; ++erep)
#endif
#pragma unroll 1
  for (int i = 0; i < 8; ++i) {
    const int t = wave * 8 + i;
    if (t < ntok) {
      const int row = row0 + t;
      const int cls = row_cls(row);
      const u16* xr = (const u16*)(p.ws + WS_XW) + (size_t)row * D + lane * 16;
      float xn[16];
      float ssq = 0.f;
      {
        const u32x4 w0 = *(const u32x4*)xr, w1 = *(const u32x4*)(xr + 8);
#pragma unroll
        for (int e = 0; e < 4; ++e) { xn[2 * e] = bflo(w0[e]); xn[2 * e + 1] = bfhi(w0[e]); xn[8 + 2 * e] = bflo(w1[e]); xn[8 + 2 * e + 1] = bfhi(w1[e]); }
#pragma unroll
        for (int e = 0; e < 16; ++e) ssq += xn[e] * xn[e];
      }
      ssq = wave_sum(ssq);
      const float rs = rsqrtf(ssq * (1.f / 1024.f) + EPS);
      if (l < DEPTH - 1) {
        const float* ng = p.norm1_g + (size_t)(l + 1) * D + lane * 16;
        const float* mr = mod + ((size_t)(l + 1) * 5 + cls) * 6144 + lane * 16;
        float y[16];
#pragma unroll
        for (int q = 0; q < 4; ++q) {
          const float4 n4 = *(const float4*)(ng + q * 4), sc4 = *(const float4*)(mr + 1024 + q * 4), sh4 = *(const float4*)(mr + q * 4);
          y[q * 4 + 0] = xn[q * 4 + 0] * rs * n4.x * (1.f + sc4.x) + sh4.x; y[q * 4 + 1] = xn[q * 4 + 1] * rs * n4.y * (1.f + sc4.y) + sh4.y;
          y[q * 4 + 2] = xn[q * 4 + 2] * rs * n4.z * (1.f + sc4.z) + sh4.z; y[q * 4 + 3] = xn[q * 4 + 3] * rs * n4.w * (1.f + sc4.w) + sh4.w;
        }
        {
          float am = 0.f;
#pragma unroll
          for (int e = 0; e < 16; ++e) am = fmaxf(am, fabsf(y[e]));
#pragma unroll
          for (int o2 = 32; o2 >= 1; o2 >>= 1) am = fmaxf(am, __shfl_xor(am, o2));
          const float qs = am > 0.f ? am * (1.f / 127.f) : 1.f, qi = 1.f / qs;
          u32x4 oq;
#pragma unroll
          for (int q = 0; q < 4; ++q) {
            unsigned w = 0;
#pragma unroll
            for (int e = 0; e < 4; ++e) w |= (((unsigned)(int)rintf(y[q * 4 + e] * qi)) & 0xffu) << (8 * e);
            oq[q] = w;
          }
          *(u32x4*)(p.ws + WS_HXQ + (size_t)row * D + lane * 16) = oq;
          if (lane == 0) ((float*)(p.ws + WS_HXS))[row] = qs;
        }
      } else {
        const float* fg = p.final_g + lane * 16;
        float* orow = p.out + (size_t)row * D + lane * 16;
#pragma unroll
        for (int q = 0; q < 4; ++q) {
          const float4 f4 = *(const float4*)(fg + q * 4);
          *(float4*)(orow + q * 4) = make_float4(xn[q * 4] * rs * f4.x, xn[q * 4 + 1] * rs * f4.y, xn[q * 4 + 2] * rs * f4.z, xn[q * 4 + 3] * rs * f4.w);
        }
      }
    }
  }
  __syncthreads();
}

DI void phase_peer_mfma(KP p, unsigned char* smem, int l, int bid, int nb, int tid) {
  const int npass = (l < DEPTH - 1) ? 2 : 1;
#pragma unroll 1
  for (int ps = 0; ps < npass; ++ps) {
    const int nt = ps == 0 ? 64 : 4;
    const int base = ps == 0 ? 0 : NLAT, lim = ps == 0 ? NLAT : NTOK;
#pragma unroll 1
    for (int r0 = base + bid * nt; r0 < lim; r0 += nb * nt) peer_mfma_pass(p, smem, l, r0, nt, tid);
  }
}

constexpr int PH_PER_LAYER = 9;
constexpr int N_PHASES = 2 + DEPTH * PH_PER_LAYER;
constexpr int SMEM_BYTES = 256 * 132 * 4;

#ifndef ONLYMASK
#define ONLYMASK 0xffff
#endif
#define PHON(x) ((ONLYMASK >> (x)) & 1)
DI void run_phase(KP p, unsigned char* smem, int ph, int bid, int nb, int tid) {
  if (ph == 0) { if (PHON(10)) phase_p0a(p, (float*)smem, bid, nb, tid); return; }
  if (ph == 1) { if (PHON(4)) { phase_norm<true>(p, p.norm1_g, 0, 0, 1024, bid, nb, NTOK, tid, true); phase_rowq(p, WS_WS, WS_WSQ, WS_WSS, 4 * 2048, bid, nb, tid); phase_rowq(p, WS_WIN, WS_WINQ, WS_WINS, 4 * 4096, bid, nb, tid); } return; }
  const int l = (ph - 2) / PH_PER_LAYER, s = (ph - 2) % PH_PER_LAYER;
  const bool last = (l == DEPTH - 1);
  switch (s) {
    case 0: if (PHON(0)) gemm8_phase<G8_Z>(p, smem, (const u16*)(p.ws + WS_HX), (const u16*)(p.ws + WS_WIN) + (size_t)l * 4096 * 1024, 4096, 1024, l, bid, nb, NTOK / 256, tid); break;
    case 1: if (PHON(7)) phase_rec1(p, smem, l, bid, nb, tid); break;
    case 2: if (PHON(8)) rec_pass2(p, bid, nb, tid); break;
    case 3: if (PHON(9)) phase_rec3(p, smem, l, bid, nb, tid); break;
    case 4: if (PHON(2)) phase_recpost(p, l, bid, nb, tid); break;
    case 5: if (PHON(3)) gemm8_phase<G8_RES>(p, smem, (const u16*)(p.ws + WS_CAT), (const u16*)(p.ws + WS_WOUT) + (size_t)l * 1024 * 1024, 1024, 1024, l, bid, nb, last ? NLAT / 256 : NTOK / 256, tid); break;
    case 6: if (PHON(4)) phase_norm(p, p.norm2_g + (size_t)l * D, l, 3072, 4096, bid, nb, last ? NLAT : NTOK, tid, true); break;
    case 7: if (PHON(5)) gemm8_phase<G8_TOPK>(p, smem, (const u16*)(p.ws + WS_HX), (const u16*)(p.ws + WS_WS) + (size_t)l * 2048 * 1024, 2048, 1024, l, bid, nb, last ? NLAT / 256 : NTOK / 256, tid); break;
    case 8: if (PHON(6)) phase_peer_mfma(p, smem, l, bid, nb, tid); break;
  }
}


#define XB_TMO      128
#define XB_XCNT(j)  (256  + 64 * (j))
#define XB_XSUB(j)  (1280 + 64 * (j))
#define XB_XGEN(j)  (2304 + 64 * (j))
#define XB_TOP      3328
#define XB_TOPGEN   3392
#define XCD_BAR_WORDS 3456
#define XB_SPIN_CAP (1u << 22)
#define LAS __attribute__((address_space(3)))
DI unsigned xb_ld(unsigned* p)              { return __hip_atomic_load(p, __ATOMIC_RELAXED, __HIP_MEMORY_SCOPE_AGENT); }
DI unsigned xb_add(unsigned* p, unsigned v) { return __hip_atomic_fetch_add(p, v, __ATOMIC_RELAXED, __HIP_MEMORY_SCOPE_AGENT); }
DI unsigned xb_xcc_id() { return (unsigned)__builtin_amdgcn_s_getreg((3 << 11) | 20) & 0xFu; }
#define XB_SPIN(cond, bar) do { unsigned _sp = 0; while (cond) { __builtin_amdgcn_s_sleep(1); \
    if ((++_sp & 255u) == 0u) { if (xb_ld(&(bar)[XB_TMO])) break; if (_sp > XB_SPIN_CAP) { atomicAdd(&(bar)[XB_TMO], 1u); break; } } } } while (0)
struct XcdBarrier { unsigned* bar; unsigned x; volatile LAS unsigned* st; };
DI XcdBarrier xcd_barrier_post(unsigned* bar, volatile LAS unsigned* st) {
  XcdBarrier b; b.bar = bar; b.x = xb_xcc_id(); b.st = st;
  if (threadIdx.x == 0) (void)xb_add(&bar[XB_XCNT(b.x)], 1u);
  return b;
}
DI void xcd_barrier_complete(unsigned* bar, unsigned x, unsigned& nloc, unsigned& nx) {
  const unsigned G = gridDim.x * gridDim.y * gridDim.z;
  unsigned sum, cnt, mine, sp = 0u;
  for (;;) {
    sum = 0u; cnt = 0u; mine = 0u;
#pragma unroll
    for (unsigned j = 0; j < 16; ++j) { const unsigned c = xb_ld(&bar[XB_XCNT(j)]); sum += c; cnt += (c > 0u) ? 1u : 0u; mine = (j == x) ? c : mine; }
    if (sum == G) break;
    __builtin_amdgcn_s_sleep(1);
    if ((++sp & 255u) == 0u) { if (xb_ld(&bar[XB_TMO])) break; if (sp > XB_SPIN_CAP) { atomicAdd(&bar[XB_TMO], 1u); break; } }
  }
  nloc = mine > 0u ? mine : 1u; nx = cnt > 0u ? cnt : 1u;
}
DI void xcd_barrier(const XcdBarrier& b) {
  asm volatile("s_waitcnt vmcnt(0)" ::: "memory");
  __syncthreads();
  if (threadIdx.x == 0) {
    unsigned* bar = b.bar;
    __builtin_amdgcn_s_waitcnt(0);
    unsigned nloc = b.st[0], nx = b.st[1];
    if (nloc == 0u) { xcd_barrier_complete(bar, b.x, nloc, nx); b.st[0] = nloc; b.st[1] = nx; }
    const unsigned old = xb_add(&bar[XB_XSUB(b.x)], 1u);
    const unsigned gen = old / nloc;
    if (old + 1u == (gen + 1u) * nloc) {
      __builtin_amdgcn_fence(__ATOMIC_RELEASE, "agent");
      asm volatile("s_waitcnt vmcnt(0)" ::: "memory");
      const unsigned og = xb_add(&bar[XB_TOP], 1u);
      const unsigned tg = og / nx;
      if (og + 1u == (tg + 1u) * nx) xb_add(&bar[XB_TOPGEN], 1u);
      else XB_SPIN(xb_ld(&bar[XB_TOPGEN]) == tg, bar);
      __builtin_amdgcn_fence(__ATOMIC_ACQUIRE, "agent");
      xb_add(&bar[XB_XGEN(b.x)], 1u);
      asm volatile("s_waitcnt vmcnt(0)" ::: "memory");
    } else {
      XB_SPIN(xb_ld(&bar[XB_XGEN(b.x)]) == gen, bar);
      __builtin_amdgcn_fence(__ATOMIC_ACQUIRE, "agent");
      asm volatile("s_waitcnt vmcnt(0)" ::: "memory");
    }
  }
  __syncthreads();
}

typedef const Params __attribute__((address_space(4)))* KArgs;

__global__ void __launch_bounds__(NTHR, 2) mega_kernel(Params p_unused) {
#if defined(__HIP_DEVICE_COMPILE__)
  __shared__ __attribute__((aligned(16))) unsigned char smem[SMEM_BYTES + 16];
  KArgs ka = (KArgs)__builtin_amdgcn_kernarg_segment_ptr();
  const int ph_lo = ka->ph_lo, ph_hi = ka->ph_hi;
#if !MULTI_LAUNCH
  cg::grid_group grid = cg::this_grid();
  volatile LAS unsigned* xbw = (volatile LAS unsigned*)(smem + SMEM_BYTES);
  if (threadIdx.x == 0) { xbw[0] = 0u; xbw[1] = 0u; }
  __syncthreads();
  XcdBarrier xb = xcd_barrier_post((unsigned*)(ka->ws + WS_BAR), xbw);
#endif
  int rep = 0;
  for (int ph = ph_lo; ph < ph_hi;) {
    int tid = threadIdx.x, bid = blockIdx.x, nb = gridDim.x;
    KArgs kq = ka;
    asm volatile("" : "+v"(tid), "+s"(bid), "+s"(nb), "+s"(kq));
#ifdef AMP_K
    if (AMP_COND(ph) && threadIdx.x == 0) *(volatile LAS unsigned long long*)(smem + SMEM_BYTES + 8) = wall_clock64();
#endif
    run_phase(*kq, smem, ph, bid, nb, tid);
    bool again = false;
#ifdef REPEAT_S
    if (rep == 0 && ((ph >= 2 && (ph - 2) % PH_PER_LAYER == REPEAT_S) || (REPEAT_S == 100 && ph == 0))) again = true;
#endif
#if !MULTI_LAUNCH
    if (again || ph + 1 < ph_hi) { if (ph == 0 && !again) grid.sync(); else xcd_barrier(xb); }
#endif
#ifdef AMP_K
    if (AMP_COND(ph)) {
      if (threadIdx.x == 0) {
        const unsigned long long t0 = *(volatile LAS unsigned long long*)(smem + SMEM_BYTES + 8), t1 = wall_clock64();
        const unsigned long long dt = (t1 - t0) * AMP_K;
        while (wall_clock64() - t1 < dt) __builtin_amdgcn_s_sleep(8);
      }
      __syncthreads();
    }
#endif
    if (again) rep = 1; else { rep = 0; ++ph; }
  }
#endif
}

extern "C" void kernel_launch(void* const* d_in, const int* in_sizes, int n_in, void* d_out, int out_size, void* d_ws, size_t ws_size, hipStream_t stream) {
  static int grid = 0;
  if (grid == 0) {
    if (n_in != 17 || ws_size < WS_END) { fprintf(stderr, "kernel_launch: unexpected n_in %d or ws_size %zu (need %zu)\n", n_in, ws_size, (size_t)WS_END); grid = -1; return; }
    int dev = 0, cus = 0, per_cu = 0;
    hipGetDevice(&dev);
    hipDeviceGetAttribute(&cus, hipDeviceAttributeMultiprocessorCount, dev);
    hipOccupancyMaxActiveBlocksPerMultiprocessor(&per_cu, (const void*)mega_kernel, NTHR, 0);
    if (per_cu < 1) { fprintf(stderr, "kernel_launch: occupancy query says %d blocks per CU\n", per_cu); grid = -1; return; }
    grid = cus;
  }
  if (grid < 0) return;
  Params p{};
  p.x = (const float*)d_in[0]; p.c = (const float*)d_in[1]; p.ctx = (const float*)d_in[2]; p.c_ctx = (const float*)d_in[3];
  p.w_mod = (const float*)d_in[4]; p.b_mod = (const float*)d_in[5]; p.norm1_g = (const float*)d_in[6]; p.norm2_g = (const float*)d_in[7];
  p.w_in = (const float*)d_in[8]; p.conv_w = (const float*)d_in[9]; p.w_out = (const float*)d_in[10]; p.lb_logits = (const float*)d_in[11];
  p.peer_wq = (const float*)d_in[12]; p.peer_subkeys = (const float*)d_in[13]; p.peer_u = (const float*)d_in[14]; p.peer_v = (const float*)d_in[15];
  p.final_g = (const float*)d_in[16]; p.out = (float*)d_out; p.ws = (unsigned char*)d_ws;
#if MULTI_LAUNCH
  for (int ph = 0; ph < N_PHASES; ++ph) {
    p.ph_lo = ph; p.ph_hi = ph + 1;
    hipLaunchKernelGGL(mega_kernel, dim3(grid), dim3(NTHR), 0, stream, p);
  }
#else
  p.ph_lo = 0; p.ph_hi = N_PHASES;
  if (hipMemsetAsync((char*)d_ws + WS_BAR, 0, 16384, stream) != hipSuccess) { fprintf(stderr, "kernel_launch: memset of barrier words failed\n"); return; }
  void* args[] = {&p};
  hipError_t e = hipLaunchCooperativeKernel((const void*)mega_kernel, dim3(grid), dim3(NTHR), args, 0, stream);
  if (e != hipSuccess) fprintf(stderr, "cooperative launch failed: %s (grid %d)\n", hipGetErrorString(e), grid);
#endif
}
```

```cpp
#include <hip/hip_runtime.h>
#include <hip/hip_cooperative_groups.h>
#include <stdint.h>
#include <stdio.h>
namespace cg = cooperative_groups;

#ifndef MULTI_LAUNCH
#define MULTI_LAUNCH 0
#endif

#define DI __device__ __forceinline__
typedef unsigned short u16;
using bf16x8 = __attribute__((ext_vector_type(8))) short;
using f32x16 = __attribute__((ext_vector_type(16))) float;
using u32x4  = __attribute__((ext_vector_type(4))) unsigned;
using u32x2  = __attribute__((ext_vector_type(2))) unsigned;
using f32x4  = __attribute__((ext_vector_type(4))) float;

constexpr int D = 1024, NLAT = 16384, NCTX = 1024, NTOK = 17408, DEPTH = 4, INC = 4096;
constexpr int SEQ = 4096, CTXL = 256, BATCH = 4;
constexpr int NTHR = 512;
constexpr int NEXP = 16384;
constexpr float EPS = 1e-6f;

constexpr size_t al256(size_t x) { return (x + 255) & ~(size_t)255; }
constexpr size_t WS_BAR   = 0;
constexpr size_t WS_MOD   = 16384;
constexpr size_t WS_LOWER = WS_MOD + al256((size_t)4 * 5 * 6144 * 4);
constexpr size_t WS_XW    = WS_LOWER + al256((size_t)4 * 2 * 512 * 4);
constexpr size_t WS_HX    = WS_XW + (size_t)NTOK * D * 4;
constexpr size_t WS_Z     = WS_HX + (size_t)NTOK * D * 2;
constexpr size_t WS_CAT   = WS_Z + (size_t)NTOK * INC * 2;
constexpr size_t WS_OF    = WS_CAT + (size_t)NTOK * D * 2;
constexpr size_t WS_OB    = WS_OF + (size_t)NTOK * 512 * 4;
constexpr size_t WS_TOPK  = WS_OB + (size_t)NTOK * 512 * 4;
constexpr size_t WS_WIN   = WS_TOPK + (size_t)NTOK * 256 * 4;
constexpr size_t WS_WOUT  = WS_WIN + (size_t)4 * 4096 * 1024 * 2;
constexpr size_t WS_WS    = WS_WOUT + (size_t)4 * 1024 * 1024 * 2;
constexpr size_t WS_UB    = WS_WS + (size_t)4 * 2048 * 1024 * 2;
constexpr size_t WS_VB    = WS_UB + (size_t)4 * NEXP * D;
constexpr size_t WS_US    = WS_VB + (size_t)4 * NEXP * D;
constexpr size_t WS_VS    = WS_US + (size_t)4 * NEXP * 4;
constexpr size_t WS_SLOC  = WS_VS + (size_t)4 * NEXP * 4;
constexpr size_t WS_SST   = WS_SLOC + (size_t)32 * 34 * 16384 * 2;
constexpr size_t WS_DT    = WS_SST + (size_t)32 * 34 * 16384 * 2;
constexpr size_t WS_HXQ   = WS_DT + (size_t)32 * 34 * 128 * 4;
constexpr size_t WS_HXS   = WS_HXQ + (size_t)NTOK * D;
constexpr size_t WS_WSQ   = WS_HXS + al256((size_t)NTOK * 4);
constexpr size_t WS_WSS   = WS_WSQ + (size_t)4 * 2048 * 1024;
constexpr size_t WS_WINQ  = WS_WSS + (size_t)4 * 2048 * 4;
constexpr size_t WS_WINS  = WS_WINQ + (size_t)4 * 4096 * 1024;
constexpr size_t WS_END   = WS_WINS + (size_t)4 * 4096 * 4;

struct Params {
  const float* x; const float* c; const float* ctx; const float* c_ctx; const float* w_mod; const float* b_mod;
  const float* norm1_g; const float* norm2_g; const float* w_in; const float* conv_w; const float* w_out;
  const float* lb_logits; const float* peer_wq; const float* peer_subkeys; const float* peer_u; const float* peer_v;
  const float* final_g; float* out; unsigned char* ws;
  int ph_lo, ph_hi;
};

typedef __attribute__((ext_vector_type(2))) __bf16 bf16v2;
typedef __attribute__((ext_vector_type(2))) float f32v2;
typedef const Params __attribute__((address_space(4)))& KP;

DI u16 f2bf(float x) { return __builtin_bit_cast(u16, (__bf16)x); }
DI float bf2f(u16 b) { return __uint_as_float(((unsigned)b) << 16); }
DI unsigned pack2(float a, float b) { f32v2 v = {a, b}; return __builtin_bit_cast(unsigned, __builtin_convertvector(v, bf16v2)); }
DI float bflo(unsigned w) { return __uint_as_float(w << 16); }
DI float bfhi(unsigned w) { return __uint_as_float(w & 0xffff0000u); }
DI float sigmoidf_(float x) { return 1.f / (1.f + __expf(-x)); }
DI float siluf_(float x) { return x / (1.f + __expf(-x)); }
DI float wave_sum(float v) {
#pragma unroll
  for (int o = 32; o >= 1; o >>= 1) v += __shfl_xor(v, o);
  return v;
}
DI int row_cls(int row) { return row < NLAT ? (row >> 12) : 4; }
DI unsigned sw128(int row, int col) { return (unsigned)(row * 256 + ((((col >> 3) ^ (row & 15))) << 4) + (col & 7) * 2); }

DI void p0_mod_groups(KP p, float* smem, int gb, int vb, int nvb, int tid) {
  const int ge = gb + 192;
  float* cond = smem;
  float* red = smem + 5 * 1024;
  for (int i = tid; i < 5 * 1024; i += NTHR) {
    const int r = i >> 10, k = i & 1023;
    const float v = r < 4 ? p.c[r * 1024 + k] : p.c_ctx[k];
    cond[i] = siluf_(v);
  }
  __syncthreads();
  const int col = tid & 31, ks = tid >> 5;
  const float* cd0 = cond + ks * 64;
  float* mod = (float*)(p.ws + WS_MOD);
  for (int g0 = gb + vb; g0 < ge; g0 += 3 * nvb) {
    float wa[16], wb[16];
    const unsigned vo = (unsigned)((ks * 64 * 6144 + col) * 4);
    auto wbase = [&](int g) { return (const char*)(p.w_mod + (size_t)(g / 192) * 1024 * 6144 + (g % 192) * 32); };
    {
      const char* w = wbase(g0);
#pragma unroll
      for (int u = 0; u < 16; ++u) wa[u] = *(const float*)(w + (size_t)u * 24576 + vo);
    }
#pragma unroll 1
    for (int q = 0; q < 3; ++q) {
      const int g = g0 + q * nvb;
      if (g >= ge) break;
      float a0 = 0, a1 = 0, a2 = 0, a3 = 0, a4 = 0;
#pragma unroll 1
      for (int hb = 0; hb < 2; ++hb) {
        const float* cd = cd0 + 32 * hb;
        asm volatile("" : "+v"(cd));
        {
          const char* w = wbase(g) + (size_t)(32 * hb + 16) * 24576;
#pragma unroll
          for (int u = 0; u < 16; ++u) wb[u] = *(const float*)(w + (size_t)u * 24576 + vo);
        }
#pragma unroll
        for (int u = 0; u < 16; ++u) { a0 += cd[u] * wa[u]; a1 += cd[1024 + u] * wa[u]; a2 += cd[2048 + u] * wa[u]; a3 += cd[3072 + u] * wa[u]; a4 += cd[4096 + u] * wa[u]; }
        __builtin_amdgcn_sched_barrier(0);
        if (hb == 0 || (q + 1 < 3 && g + nvb < ge)) {
          const char* w = hb == 0 ? wbase(g) + (size_t)32 * 24576 : wbase(g + nvb);
#pragma unroll
          for (int u = 0; u < 16; ++u) wa[u] = *(const float*)(w + (size_t)u * 24576 + vo);
        }
#pragma unroll
        for (int u = 0; u < 16; ++u) { a0 += cd[16 + u] * wb[u]; a1 += cd[1040 + u] * wb[u]; a2 += cd[2064 + u] * wb[u]; a3 += cd[3088 + u] * wb[u]; a4 += cd[4112 + u] * wb[u]; }
        __builtin_amdgcn_sched_barrier(0);
      }
      float* rq = red + q * 2560;
      rq[(ks * 5 + 0) * 32 + col] = a0; rq[(ks * 5 + 1) * 32 + col] = a1; rq[(ks * 5 + 2) * 32 + col] = a2;
      rq[(ks * 5 + 3) * 32 + col] = a3; rq[(ks * 5 + 4) * 32 + col] = a4;
    }
    __syncthreads();
    if (tid < 480) {
      const int q = tid / 160, rr = tid % 160, r = rr >> 5, cc = rr & 31, g = g0 + q * nvb;
      if (g < ge) {
        const float* rq = red + q * 2560;
        float sacc = 0.f;
#pragma unroll
        for (int t = 0; t < 16; ++t) sacc += rq[(t * 5 + r) * 32 + cc];
        const int l = g / 192, ng = g % 192;
        mod[((size_t)l * 5 + r) * 6144 + ng * 32 + cc] = sacc + p.b_mod[l * 6144 + ng * 32 + cc];
      }
    }
    __syncthreads();
  }
}

DI void p0_transpose_waves(KP p, float* smem, int bid, int nb, int tid) {
  const int lane = tid & 63, wave = tid >> 6;
  float* t = smem + wave * (64 * 33);
  const int kr = lane >> 3, c4 = (lane & 7) * 4;
  const int j = lane >> 1, hf = lane & 1;
  float4 v[8];
  const float* src = nullptr; u16* dst = nullptr; int K = 1024, N = 0, k0 = 0, n0 = 0;
  auto decode = [&](int it) {
    if (it < 8192) { const int l = it >> 11, r = it & 2047; k0 = (r >> 7) * 64; n0 = (r & 127) * 32; N = 4096; src = p.w_in + (size_t)l * 1024 * 4096; dst = (u16*)(p.ws + WS_WIN) + (size_t)l * 4096 * 1024; }
    else { const int i2 = it - 8192, l = i2 >> 9, r = i2 & 511; k0 = (r >> 5) * 64; n0 = (r & 31) * 32; N = 1024; src = p.w_out + (size_t)l * 1024 * 1024; dst = (u16*)(p.ws + WS_WOUT) + (size_t)l * 1024 * 1024; }
  };
  auto gload = [&]() {
#pragma unroll
    for (int pp = 0; pp < 8; ++pp) v[pp] = *(const float4*)(src + (size_t)(k0 + kr + 8 * pp) * N + n0 + c4);
  };
  int it = bid * 8 + wave;
  const int step = nb * 8;
  if (it < 10240) { decode(it); gload(); }
#pragma unroll 1
  while (it < 10240) {
#pragma unroll
    for (int pp = 0; pp < 8; ++pp) {
      float* tt = t + (kr + 8 * pp) * 33 + c4;
      tt[0] = v[pp].x; tt[1] = v[pp].y; tt[2] = v[pp].z; tt[3] = v[pp].w;
    }
    u16* drow = dst + (size_t)(n0 + j) * K + k0 + 32 * hf;
    const int nxt = it + step;
    if (nxt < 10240) { decode(nxt); gload(); }
    __builtin_amdgcn_fence(__ATOMIC_ACQ_REL, "wavefront");
    __builtin_amdgcn_wave_barrier();
#pragma unroll
    for (int q = 0; q < 4; ++q) {
      const float* tt = t + (32 * hf + 8 * q) * 33 + j;
      u32x4 o;
      o[0] = pack2(tt[0 * 33], tt[1 * 33]); o[1] = pack2(tt[2 * 33], tt[3 * 33]);
      o[2] = pack2(tt[4 * 33], tt[5 * 33]); o[3] = pack2(tt[6 * 33], tt[7 * 33]);
      *(u32x4*)(drow + 8 * q) = o;
    }
    __builtin_amdgcn_fence(__ATOMIC_ACQ_REL, "wavefront");
    __builtin_amdgcn_wave_barrier();
    it = nxt;
  }
}

DI void p0_ws_item(KP p, float* smemf, int item, int tid) {
  const int l = item >> 8, hp = (item >> 4) & 15, kt = item & 15;
  unsigned char* smem = (unsigned char*)smemf;
  unsigned char* SK = smem;
  unsigned char* WQ = smem + 32768;
  const float* skg = p.peer_subkeys + ((size_t)l * 16 + hp) * 128 * 128;
#pragma unroll
  for (int u = 0; u < 4; ++u) {
    const int q = tid + NTHR * u, row = q >> 4, c8 = (q & 15) * 8;
    const float4 a = *(const float4*)(skg + row * 128 + c8), b = *(const float4*)(skg + row * 128 + c8 + 4);
    u32x4 o; o[0] = pack2(a.x, a.y); o[1] = pack2(a.z, a.w); o[2] = pack2(b.x, b.y); o[3] = pack2(b.z, b.w);
    *(u32x4*)(SK + sw128(row, c8)) = o;
  }
  const float* wqg = p.peer_wq + (size_t)l * 1024 * 2048 + (size_t)(kt * 64) * 2048 + hp * 128;
#pragma unroll
  for (int u = 0; u < 2; ++u) {
    const int q = tid + NTHR * u, row = q >> 4, c8 = (q & 15) * 8;
    const float4 a = *(const float4*)(wqg + (size_t)row * 2048 + c8), b = *(const float4*)(wqg + (size_t)row * 2048 + c8 + 4);
    u32x4 o; o[0] = pack2(a.x, a.y); o[1] = pack2(a.z, a.w); o[2] = pack2(b.x, b.y); o[3] = pack2(b.z, b.w);
    *(u32x4*)(WQ + sw128(row, c8)) = o;
  }
  __syncthreads();
  const int lane = tid & 63, wave = tid >> 6, r = lane & 31, h = lane >> 5;
  const int km = wave >> 2, kn = wave & 3;
  f32x16 acc;
#pragma unroll
  for (int e = 0; e < 16; ++e) acc[e] = 0.f;
#pragma unroll
  for (int ks = 0; ks < 8; ++ks) {
    const bf16x8 av = *(const bf16x8*)(WQ + sw128(32 * km + r, 16 * ks + 8 * h));
    const bf16x8 bv = *(const bf16x8*)(SK + sw128(32 * kn + r, 16 * ks + 8 * h));
    acc = __builtin_amdgcn_mfma_f32_32x32x16_bf16(av, bv, acc, 0, 0, 0);
  }
  u16* dst = (u16*)(p.ws + WS_WS) + ((size_t)l * 2048 + hp * 128 + 32 * kn + r) * 1024 + kt * 64 + 32 * km + 4 * h;
#pragma unroll
  for (int g = 0; g < 4; ++g) {
    u32x2 o; o[0] = pack2(acc[4 * g], acc[4 * g + 1]); o[1] = pack2(acc[4 * g + 2], acc[4 * g + 3]);
    *(u32x2*)(dst + 8 * g) = o;
  }
  __syncthreads();
}

DI void p0_quant_rows(const float* src, unsigned char* dst, float* scl, int row0, int tid, float off) {
  const int lane = tid & 63, wave = tid >> 6;
  auto qrow = [&](int row, const float4& x0, const float4& x1, const float4& x2, const float4& x3) {
    float v[16] = {x0.x, x0.y, x0.z, x0.w, x1.x, x1.y, x1.z, x1.w, x2.x, x2.y, x2.z, x2.w, x3.x, x3.y, x3.z, x3.w};
    float am = 0.f;
#pragma unroll
    for (int e = 0; e < 16; ++e) am = fmaxf(am, fabsf(v[e]));
#pragma unroll
    for (int o = 32; o >= 1; o >>= 1) am = fmaxf(am, __shfl_xor(am, o));
    const float sc = am > 0.f ? am * (1.f / 127.f) : 1.f;
    const float inv = 1.f / sc;
    u32x4 o4;
#pragma unroll
    for (int q = 0; q < 4; ++q) {
      unsigned w = 0;
#pragma unroll
      for (int e = 0; e < 4; ++e) {
        const float qv = fminf(fmaxf(rintf(v[q * 4 + e] * inv), -127.f), 127.f) + off;
        w |= (((unsigned)(int)qv) & 0xffu) << (8 * e);
      }
      o4[q] = w;
    }
    *(u32x4*)(dst + (size_t)row * D + lane * 16) = o4;
    if (lane == 0) scl[row] = sc;
  };
#pragma unroll 1
  for (int i = 0; i < 8; i += 2) {
    const int rA = row0 + i * 8 + wave, rB = rA + 8;
    const float* sa = src + (size_t)rA * D + lane * 16;
    const float* sb = src + (size_t)rB * D + lane * 16;
    const float4 a0 = *(const float4*)(sa), a1 = *(const float4*)(sa + 4), a2 = *(const float4*)(sa + 8), a3 = *(const float4*)(sa + 12);
    const float4 b0 = *(const float4*)(sb), b1 = *(const float4*)(sb + 4), b2 = *(const float4*)(sb + 8), b3 = *(const float4*)(sb + 12);
    qrow(rA, a0, a1, a2, a3);
    qrow(rB, b0, b1, b2, b3);
  }
}

DI void p0_quant_waves(KP p, int bid, int nb, int tid) {
  const int lane = tid & 63, wave = tid >> 6;
  auto qrow = [&](int rr, const float4& x0, const float4& x1, const float4& x2, const float4& x3) {
    unsigned char* dst = p.ws + (rr < NEXP ? WS_UB : WS_VB);
    float* scl = (float*)(p.ws + (rr < NEXP ? WS_US : WS_VS));
    const int row = rr & (NEXP - 1);
    float v[16] = {x0.x, x0.y, x0.z, x0.w, x1.x, x1.y, x1.z, x1.w, x2.x, x2.y, x2.z, x2.w, x3.x, x3.y, x3.z, x3.w};
    float am = 0.f;
#pragma unroll
    for (int e = 0; e < 16; ++e) am = fmaxf(am, fabsf(v[e]));
#pragma unroll
    for (int o = 32; o >= 1; o >>= 1) am = fmaxf(am, __shfl_xor(am, o));
    const float sc = am > 0.f ? am * (1.f / 127.f) : 1.f;
    const float inv = 1.f / sc;
    u32x4 o4;
#pragma unroll
    for (int q = 0; q < 4; ++q) {
      unsigned w = 0;
#pragma unroll
      for (int e = 0; e < 4; ++e) {
        const float qv = fminf(fmaxf(rintf(v[q * 4 + e] * inv), -127.f), 127.f);
        w |= (((unsigned)(int)qv) & 0xffu) << (8 * e);
      }
      o4[q] = w;
    }
    *(u32x4*)(dst + (size_t)row * D + lane * 16) = o4;
    if (lane == 0) scl[row] = sc;
  };
  auto srow = [&](int rr) { return (rr < NEXP ? p.peer_u + (size_t)rr * D : p.peer_v + (size_t)(rr - NEXP) * D) + lane * 16; };
  const int step = nb * 8;
  int rA = bid * 8 + wave, rB = rA + step;
  float4 a0, a1, a2, a3, b0, b1, b2, b3;
  if (rA < 2 * NEXP) { const float* sa = srow(rA); a0 = *(const float4*)(sa); a1 = *(const float4*)(sa + 4); a2 = *(const float4*)(sa + 8); a3 = *(const float4*)(sa + 12); }
  if (rB < 2 * NEXP) { const float* sb = srow(rB); b0 = *(const float4*)(sb); b1 = *(const float4*)(sb + 4); b2 = *(const float4*)(sb + 8); b3 = *(const float4*)(sb + 12); }
#pragma unroll 1
  while (rA < 2 * NEXP) {
    qrow(rA, a0, a1, a2, a3);
    const int nA = rA + 2 * step;
    if (nA < 2 * NEXP) { const float* sa = srow(nA); a0 = *(const float4*)(sa); a1 = *(const float4*)(sa + 4); a2 = *(const float4*)(sa + 8); a3 = *(const float4*)(sa + 12); }
    if (rB < 2 * NEXP) qrow(rB, b0, b1, b2, b3);
    const int nB = rB + 2 * step;
    if (nB < 2 * NEXP) { const float* sb = srow(nB); b0 = *(const float4*)(sb); b1 = *(const float4*)(sb + 4); b2 = *(const float4*)(sb + 8); b3 = *(const float4*)(sb + 12); }
    rA = nA; rB = nB;
  }
}

constexpr int P0_N_WS = 1024;

DI void phase_p0a(KP p, float* smem, int bid, int nb, int tid) {
  if (bid == nb - 1) {
    float* lower = (float*)(p.ws + WS_LOWER);
    for (int e = tid; e < 1024; e += NTHR) {
      const float a0 = p.lb_logits[e], a1 = p.lb_logits[1024 + e], a2 = p.lb_logits[2048 + e], a3 = p.lb_logits[3072 + e];
      const float m = fmaxf(fmaxf(a0, a1), fmaxf(a2, a3));
      const float e0 = expf(a0 - m), e1 = expf(a1 - m), e2 = expf(a2 - m), e3 = expf(a3 - m);
      const float inv = 1.f / (e0 + e1 + e2 + e3);
      lower[e] = 0.f; lower[1024 + e] = e1 * inv; lower[2048 + e] = (e1 + e2) * inv; lower[3072 + e] = (e1 + e2 + e3) * inv;
    }
  }
  p0_mod_groups(p, smem, 0, bid, nb, tid);
  for (int i = bid; i < P0_N_WS; i += nb) p0_ws_item(p, smem, i, tid);
  p0_transpose_waves(p, smem, bid, nb, tid);
  p0_quant_waves(p, bid, nb, tid);
}

template <bool FIRST = false>
DI void phase_norm(KP p, const float* g, int l, int sh_off, int sc_off, int bid, int nb, int row_end, int tid, bool wq = false) {
  const int lane = tid & 63, wave = tid >> 6;
  u16* xw = (u16*)(p.ws + WS_XW);
  const float* mod = (const float*)(p.ws + WS_MOD) + (size_t)l * 5 * 6144;
  const int rpb = (row_end + nb - 1) / nb;
  const int rb0 = bid * rpb, rb1 = (rb0 + rpb < row_end) ? rb0 + rpb : row_end;
  int cur_cls = -1;
  float ga[16], sha[16];
  for (int row = rb0 + wave; row < rb1; row += 8) {
    const int cls = row_cls(row);
    if (cls != cur_cls) {
      cur_cls = cls;
      const float* mr = mod + (size_t)cls * 6144;
#pragma unroll
      for (int q = 0; q < 4; ++q) {
        const int c0 = lane * 16 + q * 4;
        const float4 gg = *(const float4*)(g + c0), sh = *(const float4*)(mr + sh_off + c0), sc = *(const float4*)(mr + sc_off + c0);
        ga[q * 4] = gg.x * (1.f + sc.x); ga[q * 4 + 1] = gg.y * (1.f + sc.y); ga[q * 4 + 2] = gg.z * (1.f + sc.z); ga[q * 4 + 3] = gg.w * (1.f + sc.w);
        sha[q * 4] = sh.x; sha[q * 4 + 1] = sh.y; sha[q * 4 + 2] = sh.z; sha[q * 4 + 3] = sh.w;
      }
    }
    float v[16];
    if (FIRST) {
      const float* xr = (row < NLAT ? p.x + (size_t)row * D : p.ctx + (size_t)(row - NLAT) * D) + lane * 16;
      u32x4 w0, w1;
#pragma unroll
      for (int q = 0; q < 4; ++q) {
        const float4 a = *(const float4*)(xr + q * 4);
        const unsigned lo = pack2(a.x, a.y), hi = pack2(a.z, a.w);
        if (q < 2) { w0[2 * q] = lo; w0[2 * q + 1] = hi; } else { w1[2 * (q - 2)] = lo; w1[2 * (q - 2) + 1] = hi; }
      }
      *(u32x4*)(xw + (size_t)row * D + lane * 16) = w0; *(u32x4*)(xw + (size_t)row * D + lane * 16 + 8) = w1;
#pragma unroll
      for (int e = 0; e < 4; ++e) { v[2 * e] = bflo(w0[e]); v[2 * e + 1] = bfhi(w0[e]); v[8 + 2 * e] = bflo(w1[e]); v[8 + 2 * e + 1] = bfhi(w1[e]); }
    } else {
      const u32x4 w0 = *(const u32x4*)(xw + (size_t)row * D + lane * 16), w1 = *(const u32x4*)(xw + (size_t)row * D + lane * 16 + 8);
#pragma unroll
      for (int e = 0; e < 4; ++e) { v[2 * e] = bflo(w0[e]); v[2 * e + 1] = bfhi(w0[e]); v[8 + 2 * e] = bflo(w1[e]); v[8 + 2 * e + 1] = bfhi(w1[e]); }
    }
    float ss = 0.f;
#pragma unroll
    for (int e = 0; e < 16; ++e) ss += v[e] * v[e];
    ss = wave_sum(ss);
    const float rs = rsqrtf(ss * (1.f / 1024.f) + EPS);
#pragma unroll
    for (int e = 0; e < 16; ++e) v[e] = v[e] * rs * ga[e] + sha[e];
    {
      float am = 0.f;
#pragma unroll
      for (int e = 0; e < 16; ++e) am = fmaxf(am, fabsf(v[e]));
#pragma unroll
      for (int o2 = 32; o2 >= 1; o2 >>= 1) am = fmaxf(am, __shfl_xor(am, o2));
      const float sc = am > 0.f ? am * (1.f / 127.f) : 1.f, inv = 1.f / sc;
      u32x4 oq;
#pragma unroll
      for (int q = 0; q < 4; ++q) {
        unsigned w = 0;
#pragma unroll
        for (int e = 0; e < 4; ++e) w |= (((unsigned)(int)rintf(v[q * 4 + e] * inv)) & 0xffu) << (8 * e);
        oq[q] = w;
      }
      *(u32x4*)(p.ws + WS_HXQ + (size_t)row * D + lane * 16) = oq;
      if (lane == 0) ((float*)(p.ws + WS_HXS))[row] = sc;
    }
  }
}

DI int win_new_row(int n) {
  if (n >= 2560 && n < 3072) { const int ch = n - 2560, a = ch >> 7, r = ch & 127; return (a < 2 ? 10 + a : 12 + a) * 256 + r; }
  if (n >= 3584) { const int ch = n - 3584, a = ch >> 7, r = ch & 127; return (a < 2 ? 10 + a : 12 + a) * 256 + 128 + r; }
  return n;
}
DI void phase_rowq(KP p, size_t src_off, size_t dst_off, size_t scl_off, int nrows, int bid, int nb, int tid, bool win_perm = false) {
  const int lane = tid & 63, wave = tid >> 6;
  const u16* src = (const u16*)(p.ws + src_off);
  for (int row = bid * 8 + wave; row < nrows; row += nb * 8) {
    const u32x4 a = *(const u32x4*)(src + (size_t)row * 1024 + lane * 16), b = *(const u32x4*)(src + (size_t)row * 1024 + lane * 16 + 8);
    float v[16];
#pragma unroll
    for (int e = 0; e < 4; ++e) { v[2 * e] = bflo(a[e]); v[2 * e + 1] = bfhi(a[e]); v[8 + 2 * e] = bflo(b[e]); v[8 + 2 * e + 1] = bfhi(b[e]); }
    float am = 0.f;
#pragma unroll
    for (int e = 0; e < 16; ++e) am = fmaxf(am, fabsf(v[e]));
#pragma unroll
    for (int o2 = 32; o2 >= 1; o2 >>= 1) am = fmaxf(am, __shfl_xor(am, o2));
    const float sc = am > 0.f ? am * (1.f / 127.f) : 1.f, inv = 1.f / sc;
    u32x4 o;
#pragma unroll
    for (int q = 0; q < 4; ++q) {
      unsigned w = 0;
#pragma unroll
      for (int e = 0; e < 4; ++e) w |= (((unsigned)(int)rintf(v[q * 4 + e] * inv)) & 0xffu) << (8 * e);
      o[q] = w;
    }
    const int drow = win_perm ? (row & ~4095) + win_new_row(row & 4095) : row;
    *(u32x4*)(p.ws + dst_off + (size_t)drow * 1024 + lane * 16) = o;
    if (lane == 0) ((float*)(p.ws + scl_off))[drow] = sc;
  }
}

constexpr int GEMM_LDS_STAGE = 256 * 128 + 128 * 128;
enum { EPI_Z = 0, EPI_RES = 1, EPI_TOPK = 2 };

DI unsigned lds_off(int row, int c) { return (unsigned)(row * 128 + ((c ^ ((row >> 1) & 7)) << 4)); }

template <int EPI, int BN, bool DEEP = false>
DI void gemm_tile(KP p, unsigned char* smem, const u16* A, const u16* Bt, int N, int K, int l, int m0, int n0, int tid) {
  constexpr int WN = BN / 64, WM = 8 / WN, IM = 256 / WM / 32, NB = BN / 64;
  constexpr int STAGE = 32768 + BN * 128;
  const int lane = tid & 63, wave = tid >> 6;
  const int wm = wave / WN, wn = wave % WN, r = lane & 31, h = lane >> 5;
  f32x16 acc[IM][2];
#pragma unroll
  for (int i = 0; i < IM; ++i)
#pragma unroll
    for (int j = 0; j < 2; ++j)
#pragma unroll
      for (int e = 0; e < 16; ++e) acc[i][j][e] = 0.f;
  u32x4 ra[4], rb[NB];
  const int nk = K / 64;
  const unsigned voff = (unsigned)(((tid >> 3) * K + (tid & 7) * 8) * 2);
  auto gload = [&](int kt) {
#pragma unroll
    for (int i = 0; i < 4; ++i) {
      const char* base = (const char*)(A + (size_t)(m0 + 64 * i) * K + kt * 64);
      ra[i] = *(const u32x4*)(base + voff);
    }
#pragma unroll
    for (int i = 0; i < NB; ++i) {
      const char* base = (const char*)(Bt + (size_t)(n0 + 64 * i) * K + kt * 64);
      rb[i] = *(const u32x4*)(base + voff);
    }
  };
  auto lstore = [&](int buf) {
    unsigned char* sa = smem + buf * STAGE;
    unsigned char* sb = sa + 32768;
#pragma unroll
    for (int i = 0; i < 4; ++i) {
      const int q = tid + i * NTHR, row = q >> 3, c = q & 7;
      *(u32x4*)(sa + lds_off(row, c)) = ra[i];
    }
#pragma unroll
    for (int i = 0; i < NB; ++i) {
      const int q = tid + i * NTHR, row = q >> 3, c = q & 7;
      *(u32x4*)(sb + lds_off(row, c)) = rb[i];
    }
  };
  auto compute = [&](int kt) {
    const unsigned char* sa = smem + (kt & 1) * STAGE;
    const unsigned char* sb = sa + 32768;
#pragma unroll
    for (int s = 0; s < 4; ++s) {
      bf16x8 fa[IM], fb[2];
#pragma unroll
      for (int i = 0; i < IM; ++i) fa[i] = *(const bf16x8*)(sa + lds_off(wm * (IM * 32) + i * 32 + r, 2 * s + h));
#pragma unroll
      for (int j = 0; j < 2; ++j) fb[j] = *(const bf16x8*)(sb + lds_off(wn * 64 + j * 32 + r, 2 * s + h));
#pragma unroll
      for (int i = 0; i < IM; ++i)
#pragma unroll
        for (int j = 0; j < 2; ++j) acc[i][j] = __builtin_amdgcn_mfma_f32_32x32x16_bf16(fa[i], fb[j], acc[i][j], 0, 0, 0);
      if constexpr (BN == 256) __builtin_amdgcn_sched_barrier(0);
    }
  };
  if constexpr (!DEEP) {
    gload(0);
    lstore(0);
    __syncthreads();
    for (int kt = 0; kt < nk; ++kt) {
      if (kt + 1 < nk) gload(kt + 1);
      compute(kt);
      if (kt + 1 < nk) lstore((kt + 1) & 1);
      __syncthreads();
    }
  } else {
    u32x4 ra2[4], rb2[NB];
    auto gload2 = [&](int kt) {
#pragma unroll
      for (int i = 0; i < 4; ++i) ra2[i] = *(const u32x4*)((const char*)(A + (size_t)(m0 + 64 * i) * K + kt * 64) + voff);
#pragma unroll
      for (int i = 0; i < NB; ++i) rb2[i] = *(const u32x4*)((const char*)(Bt + (size_t)(n0 + 64 * i) * K + kt * 64) + voff);
    };
    auto lstore2 = [&](int buf) {
      unsigned char* sa = smem + buf * STAGE;
      unsigned char* sb = sa + 32768;
#pragma unroll
      for (int i = 0; i < 4; ++i) { const int q = tid + i * NTHR; *(u32x4*)(sa + lds_off(q >> 3, q & 7)) = ra2[i]; }
#pragma unroll
      for (int i = 0; i < NB; ++i) { const int q = tid + i * NTHR; *(u32x4*)(sb + lds_off(q >> 3, q & 7)) = rb2[i]; }
    };
    gload(0);
    gload2(1);
    lstore(0);
    if (2 < nk) gload(2);
    __syncthreads();
    for (int kt = 0; kt < nk; kt += 2) {
      if (kt + 1 < nk) { lstore2(1); if (kt + 3 < nk) gload2(kt + 3); }
      compute(kt);
      __syncthreads();
      if (kt + 2 < nk) { lstore(0); if (kt + 4 < nk) gload(kt + 4); }
      compute(kt + 1);
      __syncthreads();
    }
  }
#pragma unroll 1
  for (int hf = 0; hf < BN / 128; ++hf) {
    const bool mine = (wn >> 1) == hf;
    const int n0h = n0 + hf * 128, lc = (wn & 1) * 64 + r, lr = wm * (IM * 32) + 4 * h;
    if constexpr (EPI == EPI_Z) {
      u16* st = (u16*)smem;
      if (mine) {
        u16* lb = st + lr * 136 + lc;
#pragma unroll
        for (int i = 0; i < IM; ++i)
#pragma unroll
          for (int j = 0; j < 2; ++j)
#pragma unroll
            for (int e = 0; e < 16; ++e) lb[(i * 32 + (e & 3) + 8 * (e >> 2)) * 136 + j * 32] = f2bf(acc[i][j][e]);
      }
      __syncthreads();
      u16* Z = (u16*)(p.ws + WS_Z) + (size_t)m0 * N + n0h;
#pragma unroll 2
      for (int i = 0; i < 8; ++i) {
        const int q = tid + i * NTHR, row = q >> 4, c = q & 15;
        *(u32x4*)(Z + (size_t)row * N + c * 8) = *(const u32x4*)(st + row * 136 + c * 8);
      }
      __syncthreads();
    } else if constexpr (EPI == EPI_RES) {
      float* st = (float*)smem;
      if (mine) {
        float* lb = st + lr * 132 + lc;
#pragma unroll
        for (int i = 0; i < IM; ++i)
#pragma unroll
          for (int j = 0; j < 2; ++j)
#pragma unroll
            for (int e = 0; e < 16; ++e) lb[(i * 32 + (e & 3) + 8 * (e >> 2)) * 132 + j * 32] = acc[i][j][e];
      }
      __syncthreads();
      float* xw = (float*)(p.ws + WS_XW) + (size_t)m0 * D + n0h;
      const float* g1p = (const float*)(p.ws + WS_MOD) + ((size_t)l * 5 + row_cls(m0)) * 6144 + 2048 + n0h;
      const int c = tid & 31;
      const float4 g1 = *(const float4*)(g1p + c * 4);
#pragma unroll 2
      for (int i = 0; i < 16; ++i) {
        const int row = (tid >> 5) + i * 16;
        const float4 a = *(const float4*)(st + row * 132 + c * 4);
        float4 xv = *(const float4*)(xw + (size_t)row * D + c * 4);
        xv.x += g1.x * a.x; xv.y += g1.y * a.y; xv.z += g1.z * a.z; xv.w += g1.w * a.w;
        *(float4*)(xw + (size_t)row * D + c * 4) = xv;
      }
      __syncthreads();
    } else {
      float* st = (float*)smem;
      if (mine) {
        float* lb = st + lr * 129 + lc;
#pragma unroll
        for (int i = 0; i < IM; ++i)
#pragma unroll
          for (int j = 0; j < 2; ++j)
#pragma unroll
            for (int e = 0; e < 16; ++e) lb[(i * 32 + (e & 3) + 8 * (e >> 2)) * 129 + j * 32] = acc[i][j][e];
      }
      __syncthreads();
      if (tid < 256) {
        float t16[16];
#pragma unroll
        for (int i = 0; i < 16; ++i) t16[i] = __uint_as_float(0xff800000u);
        for (int kk = 0; kk < 128; ++kk) {
          const float sv = st[tid * 129 + kk];
          const float x = __uint_as_float((__float_as_uint(sv) & ~0x7fu) | (unsigned)(127 - kk));
#pragma unroll
          for (int i = 15; i >= 1; --i) t16[i] = __builtin_amdgcn_fmed3f(x, t16[i - 1], t16[i]);
          t16[0] = fmaxf(t16[0], x);
        }
        unsigned* tk = (unsigned*)(p.ws + WS_TOPK) + ((size_t)(m0 + tid) * 16 + (n0h >> 7)) * 16;
#pragma unroll
        for (int q = 0; q < 4; ++q) {
          u32x4 o; o[0] = __float_as_uint(t16[q * 4]); o[1] = __float_as_uint(t16[q * 4 + 1]); o[2] = __float_as_uint(t16[q * 4 + 2]); o[3] = __float_as_uint(t16[q * 4 + 3]);
          *(u32x4*)(tk + q * 4) = o;
        }
      }
      __syncthreads();
    }
  }
}

template <int EPI>
DI void gemm_phase(KP p, unsigned char* smem, const u16* A, const u16* Bt, int M, int N, int K, int l, int bid, int nb, int m_tiles_active, int tid) {
  const int ntn = N / 128;
  const int ntiles = m_tiles_active * ntn;
#pragma unroll 1
  for (int tile = bid; tile < ntiles; tile += nb)
    gemm_tile<EPI, 128, true>(p, smem, A, Bt, N, K, l, (tile / ntn) * 256, (tile % ntn) * 128, tid);
}

namespace pg8 {
#define PG8_LAS __attribute__((address_space(3)))
typedef unsigned short bf16_t;
typedef short bf16x8 __attribute__((ext_vector_type(8)));
typedef float f32x4 __attribute__((ext_vector_type(4)));
typedef unsigned u32x4 __attribute__((ext_vector_type(4)));
constexpr int BM = 256, BK = 64, HALF = 128, HTB = HALF * BK * 2  , STAGE_BYTES = 8 * HTB, NXCD = 8, WGM = 8;

__host__ __device__ __forceinline__ int lds_byte(int r, int c) { const int st = (r >> 4) * 2 + (c >> 5), rr = r & 15, cc = c & 31, ob = rr * 64 + cc * 2; return st * 1024 + (ob ^ (((ob >> 9) & 1) << 5)); }
__host__ __device__ __forceinline__ void stage_rc(int b, int& R, int& C) { const int st = b / 1024, sb = b % 1024, swz = sb ^ (((sb >> 9) & 1) << 5); R = (st >> 1) * 16 + swz / 64; C = (st & 1) * 32 + (swz % 64) / 2; }
__host__ __device__ __forceinline__ int perm32(int rho) { const int n = rho >> 4, i = rho & 15; return 8 * (i >> 2) + 4 * n + (i & 3); }

struct Unit { int pm, pn; };
struct Gemm { const bf16_t* A; const bf16_t* Bt; int M, N, K; };

template <class Epi, class Sched>
__device__ __forceinline__ void gemm_phase(PG8_LAS unsigned char* lds, const Gemm g, const Sched& S, const Epi& E, const int tid) {
    const int wid = __builtin_amdgcn_readfirstlane(tid >> 6), lane = tid & 63, wr = wid >> 2, wc = wid & 3, fr = lane & 15, fq = lane >> 4;
    const int K = g.K, nt = K / BK;
    unsigned voffA[2], voffB[2];
#pragma unroll
    for (int i = 0; i < 2; ++i) { int R, C; stage_rc((tid >> 6) * 2048 + i * 1024 + (tid & 63) * 16, R, C); const int Rb = Epi::PERM ? ((R & ~31) + perm32(R & 31)) : R;
        voffA[i] = (unsigned)(R * K + C) * 2u; voffB[i] = (unsigned)(Rb * K + C) * 2u; }
    const size_t kstep = (size_t)(BK * 2);
    const size_t hstep = (size_t)HALF * K * 2;
    const size_t tstep = 2 * hstep;
    const unsigned ldsw = (unsigned)wid * 2048u;
    const int aoff = lds_byte(wr * 64 + fr, fq * 8), boff = lds_byte(wc * 32 + fr, fq * 8);
#define PG8_SA(b, h) (((b) * 2 + (h)) * HTB)
#define PG8_SB(b, h) ((4 + (b) * 2 + (h)) * HTB)
#define PG8_STAGE(bufoff, gbase, voff) do { _Pragma("unroll") for (int _i = 0; _i < 2; ++_i) \
        __builtin_amdgcn_global_load_lds((const unsigned*)((const char*)(gbase) + (voff)[_i]), (PG8_LAS unsigned*)(lds + (bufoff) + ldsw + _i * 1024), 16, 0, 0); } while (0)
#define PG8_LDA(dst, b, h) do { _Pragma("unroll") for (int m = 0; m < 4; ++m) _Pragma("unroll") for (int k = 0; k < 2; ++k) dst[m][k] = *(const PG8_LAS bf16x8*)(lds + PG8_SA(b, h) + aoff + m * 2048 + k * 1024); } while (0)
#define PG8_LDB(dst, b, h) do { _Pragma("unroll") for (int n = 0; n < 2; ++n) _Pragma("unroll") for (int k = 0; k < 2; ++k) dst[n][k] = *(const PG8_LAS bf16x8*)(lds + PG8_SB(b, h) + boff + n * 2048 + k * 1024); } while (0)
#define PG8_MMA(ai, bj, At, Bt) do { __builtin_amdgcn_s_setprio(1); _Pragma("unroll") for (int m = 0; m < 4; ++m) _Pragma("unroll") for (int n = 0; n < 2; ++n) _Pragma("unroll") for (int k = 0; k < 2; ++k) \
        acc[ai][bj][m][n] = __builtin_amdgcn_mfma_f32_16x16x32_bf16(Bt[n][k], At[m][k], acc[ai][bj][m][n], 0, 0, 0); __builtin_amdgcn_s_setprio(0); } while (0)
#define PG8_WAIT_V(n) asm volatile("s_waitcnt vmcnt(" #n ")" ::: "memory")
#define PG8_WAIT_L(n) asm volatile("s_waitcnt lgkmcnt(" #n ")" ::: "memory")
#define PG8_BAR __builtin_amdgcn_s_barrier()
#define PG8_SCHED __builtin_amdgcn_sched_barrier(0)
    Unit cur, nxt; int ui = 0;
    if (!S.next(0, cur)) return;
    f32x4 acc[2][2][4][2];
#pragma unroll
    for (int a = 0; a < 2; ++a)
#pragma unroll
        for (int b = 0; b < 2; ++b)
#pragma unroll
            for (int m = 0; m < 4; ++m)
#pragma unroll
                for (int n = 0; n < 2; ++n) acc[a][b][m][n] = (f32x4){0.f, 0.f, 0.f, 0.f};
    bf16x8 At[4][2], B0[2][2], B1[2][2];
    const char* cA = (const char*)g.A + (size_t)cur.pm * tstep; const char* cB = (const char*)g.Bt + (size_t)cur.pn * tstep;
    S.a_ready(cur);
    PG8_STAGE(PG8_SB(0, 0), cB, voffB); PG8_STAGE(PG8_SA(0, 0), cA, voffA); PG8_STAGE(PG8_SB(0, 1), cB + hstep, voffB); PG8_STAGE(PG8_SA(0, 1), cA + hstep, voffA);
    if (wr == 1) PG8_BAR;
    PG8_WAIT_V(4); PG8_BAR;
    PG8_STAGE(PG8_SB(1, 0), cB + kstep, voffB); PG8_STAGE(PG8_SA(1, 0), cA + kstep, voffA); PG8_STAGE(PG8_SB(1, 1), cB + hstep + kstep, voffB);
    PG8_WAIT_V(6); PG8_BAR;
    for (;;) {
        const bool has_next = S.next(ui + 1, nxt);
        const char* nA = has_next ? (const char*)g.A + (size_t)nxt.pm * tstep : cA; const char* nB = has_next ? (const char*)g.Bt + (size_t)nxt.pn * tstep : cB;
        for (int t = 0; t < nt; t += 2) {
            const bool last = (t == nt - 2);
            const char* a1 = cA + (size_t)(t + 1) * kstep;
            const char* a2 = last ? nA : cA + (size_t)(t + 2) * kstep; const char* b2 = last ? nB : cB + (size_t)(t + 2) * kstep;
            const char* a3 = a2 + kstep; const char* b3 = b2 + kstep;
            if (last && has_next) S.a_ready(nxt);
            PG8_LDB(B0, 0, 0); PG8_SCHED; PG8_LDA(At, 0, 0); PG8_STAGE(PG8_SA(1, 1), a1 + hstep, voffA);
            PG8_WAIT_L(8); PG8_BAR; PG8_WAIT_L(0); PG8_MMA(0, 0, At, B0); PG8_BAR; PG8_SCHED;
            PG8_LDB(B1, 0, 1); PG8_STAGE(PG8_SB(0, 0), b2, voffB);
            PG8_BAR; PG8_WAIT_L(0); PG8_MMA(0, 1, At, B1); PG8_BAR;
            PG8_LDA(At, 0, 1); PG8_STAGE(PG8_SA(0, 0), a2, voffA);
            PG8_BAR; PG8_WAIT_L(0); PG8_MMA(1, 0, At, B0); PG8_BAR; PG8_SCHED;
            PG8_STAGE(PG8_SB(0, 1), b2 + hstep, voffB);
            PG8_WAIT_V(6); PG8_BAR; PG8_MMA(1, 1, At, B1); PG8_BAR;
            PG8_LDB(B0, 1, 0); PG8_SCHED; PG8_LDA(At, 1, 0); PG8_STAGE(PG8_SA(0, 1), a2 + hstep, voffA);
            PG8_WAIT_L(8); PG8_BAR; PG8_WAIT_L(0); PG8_MMA(0, 0, At, B0); PG8_BAR; PG8_SCHED;
            PG8_LDB(B1, 1, 1); PG8_STAGE(PG8_SB(1, 0), b3, voffB);
            PG8_BAR; PG8_WAIT_L(0); PG8_MMA(0, 1, At, B1); PG8_BAR;
            PG8_LDA(At, 1, 1); PG8_STAGE(PG8_SA(1, 0), a3, voffA);
            PG8_BAR; PG8_WAIT_L(0); PG8_MMA(1, 0, At, B0); PG8_BAR; PG8_SCHED;
            PG8_STAGE(PG8_SB(1, 1), b3 + hstep, voffB);
            PG8_WAIT_V(6); PG8_BAR; PG8_MMA(1, 1, At, B1); PG8_BAR;
        }
        if constexpr (!Epi::AFTER_DRAIN) { E(acc, cur, wr, wc, fr, fq); S.done(cur); }
        if (!has_next) break;
#pragma unroll
        for (int a = 0; a < 2; ++a)
#pragma unroll
            for (int b = 0; b < 2; ++b)
#pragma unroll
                for (int m = 0; m < 4; ++m)
#pragma unroll
                    for (int n = 0; n < 2; ++n) acc[a][b][m][n] = (f32x4){0.f, 0.f, 0.f, 0.f};
        cur = nxt; cA = nA; cB = nB; ++ui;
    }
    PG8_WAIT_V(0);
    if (wr == 0) PG8_BAR;
    PG8_BAR;
    if constexpr (Epi::AFTER_DRAIN) { E.fused(acc, cur, wr, wc, fr, fq, lds, wid, lane); S.done(cur); }
#undef PG8_SA
#undef PG8_SB
#undef PG8_STAGE
#undef PG8_LDA
#undef PG8_LDB
#undef PG8_MMA
#undef PG8_WAIT_V
#undef PG8_WAIT_L
#undef PG8_BAR
#undef PG8_SCHED
}

typedef int i32x4 __attribute__((ext_vector_type(4)));
template <class Epi, class Sched>
__device__ __forceinline__ void gemm_phase_i8(PG8_LAS unsigned char* lds, const Gemm g, const Sched& S, const Epi& E, const int tid) {
    const int wid = __builtin_amdgcn_readfirstlane(tid >> 6), lane = tid & 63, wr = wid >> 2, wc = wid & 3, fr = lane & 15, fq = lane >> 4;
    const int K = g.K  , nt = K / (2 * BK);
    unsigned voffA[2], voffB[2];
#pragma unroll
    for (int i = 0; i < 2; ++i) { int R, C; stage_rc((tid >> 6) * 2048 + i * 1024 + (tid & 63) * 16, R, C); const int Rb = Epi::PERM ? ((R & ~31) + perm32(R & 31)) : R;
        voffA[i] = (unsigned)(R * K + 2 * C); voffB[i] = (unsigned)(Rb * K + 2 * C); }
    const size_t kstep = (size_t)(BK * 2);
    const size_t hstep = (size_t)HALF * K;
    const size_t tstep = 2 * hstep;
    const unsigned ldsw = (unsigned)wid * 2048u;
    const int aoff = lds_byte(wr * 64 + fr, fq * 8), boff = lds_byte(wc * 32 + fr, fq * 8);
#define PG8_SA(b, h) (((b) * 2 + (h)) * HTB)
#define PG8_SB(b, h) ((4 + (b) * 2 + (h)) * HTB)
#define PG8_STAGE(bufoff, gbase, voff) do { _Pragma("unroll") for (int _i = 0; _i < 2; ++_i) \
        __builtin_amdgcn_global_load_lds((const unsigned*)((const char*)(gbase) + (voff)[_i]), (PG8_LAS unsigned*)(lds + (bufoff) + ldsw + _i * 1024), 16, 0, 0); } while (0)
#define PG8_LDA(dst, b, h) do { _Pragma("unroll") for (int m = 0; m < 4; ++m) _Pragma("unroll") for (int k = 0; k < 2; ++k) dst[m][k] = *(const PG8_LAS bf16x8*)(lds + PG8_SA(b, h) + aoff + m * 2048 + k * 1024); } while (0)
#define PG8_LDB(dst, b, h) do { _Pragma("unroll") for (int n = 0; n < 2; ++n) _Pragma("unroll") for (int k = 0; k < 2; ++k) dst[n][k] = *(const PG8_LAS bf16x8*)(lds + PG8_SB(b, h) + boff + n * 2048 + k * 1024); } while (0)
#define PG8_MMA(ai, bj, At, Bt) do { __builtin_amdgcn_s_setprio(1); _Pragma("unroll") for (int m = 0; m < 4; ++m) _Pragma("unroll") for (int n = 0; n < 2; ++n) _Pragma("unroll") for (int k = 0; k < 2; ++k) \
        acc[ai][bj][m][n] = __builtin_amdgcn_mfma_i32_16x16x64_i8(__builtin_bit_cast(i32x4, Bt[n][k]), __builtin_bit_cast(i32x4, At[m][k]), acc[ai][bj][m][n], 0, 0, 0); __builtin_amdgcn_s_setprio(0); } while (0)
#define PG8_WAIT_V(n) asm volatile("s_waitcnt vmcnt(" #n ")" ::: "memory")
#define PG8_WAIT_L(n) asm volatile("s_waitcnt lgkmcnt(" #n ")" ::: "memory")
#define PG8_BAR __builtin_amdgcn_s_barrier()
#define PG8_SCHED __builtin_amdgcn_sched_barrier(0)
    Unit cur, nxt; int ui = 0;
    if (!S.next(0, cur)) return;
    i32x4 acc[2][2][4][2];
#pragma unroll
    for (int a = 0; a < 2; ++a)
#pragma unroll
        for (int b = 0; b < 2; ++b)
#pragma unroll
            for (int m = 0; m < 4; ++m)
#pragma unroll
                for (int n = 0; n < 2; ++n) acc[a][b][m][n] = (i32x4){0, 0, 0, 0};
    bf16x8 At[4][2], B0[2][2], B1[2][2];
    const char* cA = (const char*)g.A + (size_t)cur.pm * tstep; const char* cB = (const char*)g.Bt + (size_t)cur.pn * tstep;
    S.a_ready(cur);
    PG8_STAGE(PG8_SB(0, 0), cB, voffB); PG8_STAGE(PG8_SA(0, 0), cA, voffA); PG8_STAGE(PG8_SB(0, 1), cB + hstep, voffB); PG8_STAGE(PG8_SA(0, 1), cA + hstep, voffA);
    if (wr == 1) PG8_BAR;
    PG8_WAIT_V(4); PG8_BAR;
    PG8_STAGE(PG8_SB(1, 0), cB + kstep, voffB); PG8_STAGE(PG8_SA(1, 0), cA + kstep, voffA); PG8_STAGE(PG8_SB(1, 1), cB + hstep + kstep, voffB);
    PG8_WAIT_V(6); PG8_BAR;
    for (;;) {
        const bool has_next = S.next(ui + 1, nxt);
        const char* nA = has_next ? (const char*)g.A + (size_t)nxt.pm * tstep : cA; const char* nB = has_next ? (const char*)g.Bt + (size_t)nxt.pn * tstep : cB;
        for (int t = 0; t < nt; t += 2) {
            const bool last = (t == nt - 2);
            const char* a1 = cA + (size_t)(t + 1) * kstep;
            const char* a2 = last ? nA : cA + (size_t)(t + 2) * kstep; const char* b2 = last ? nB : cB + (size_t)(t + 2) * kstep;
            const char* a3 = a2 + kstep; const char* b3 = b2 + kstep;
            if (last && has_next) S.a_ready(nxt);
            PG8_LDB(B0, 0, 0); PG8_SCHED; PG8_LDA(At, 0, 0); PG8_STAGE(PG8_SA(1, 1), a1 + hstep, voffA);
            PG8_WAIT_L(8); PG8_BAR; PG8_WAIT_L(0); PG8_MMA(0, 0, At, B0); PG8_BAR; PG8_SCHED;
            PG8_LDB(B1, 0, 1); PG8_STAGE(PG8_SB(0, 0), b2, voffB);
            PG8_BAR; PG8_WAIT_L(0); PG8_MMA(0, 1, At, B1); PG8_BAR;
            PG8_LDA(At, 0, 1); PG8_STAGE(PG8_SA(0, 0), a2, voffA);
            PG8_BAR; PG8_WAIT_L(0); PG8_MMA(1, 0, At, B0); PG8_BAR; PG8_SCHED;
            PG8_STAGE(PG8_SB(0, 1), b2 + hstep, voffB);
            PG8_WAIT_V(6); PG8_BAR; PG8_MMA(1, 1, At, B1); PG8_BAR;
            PG8_LDB(B0, 1, 0); PG8_SCHED; PG8_LDA(At, 1, 0); PG8_STAGE(PG8_SA(0, 1), a2 + hstep, voffA);
            PG8_WAIT_L(8); PG8_BAR; PG8_WAIT_L(0); PG8_MMA(0, 0, At, B0); PG8_BAR; PG8_SCHED;
            PG8_LDB(B1, 1, 1); PG8_STAGE(PG8_SB(1, 0), b3, voffB);
            PG8_BAR; PG8_WAIT_L(0); PG8_MMA(0, 1, At, B1); PG8_BAR;
            PG8_LDA(At, 1, 1); PG8_STAGE(PG8_SA(1, 0), a3, voffA);
            PG8_BAR; PG8_WAIT_L(0); PG8_MMA(1, 0, At, B0); PG8_BAR; PG8_SCHED;
            PG8_STAGE(PG8_SB(1, 1), b3 + hstep, voffB);
            PG8_WAIT_V(6); PG8_BAR; PG8_MMA(1, 1, At, B1); PG8_BAR;
        }
        if constexpr (!Epi::AFTER_DRAIN) { E(acc, cur, wr, wc, fr, fq); S.done(cur); }
        if (!has_next) break;
#pragma unroll
        for (int a = 0; a < 2; ++a)
#pragma unroll
            for (int b = 0; b < 2; ++b)
#pragma unroll
                for (int m = 0; m < 4; ++m)
#pragma unroll
                    for (int n = 0; n < 2; ++n) acc[a][b][m][n] = (i32x4){0, 0, 0, 0};
        cur = nxt; cA = nA; cB = nB; ++ui;
    }
    PG8_WAIT_V(0);
    if (wr == 0) PG8_BAR;
    PG8_BAR;
    if constexpr (Epi::AFTER_DRAIN) { E.fused(acc, cur, wr, wc, fr, fq, lds, wid, lane); S.done(cur); }
#undef PG8_SA
#undef PG8_SB
#undef PG8_STAGE
#undef PG8_LDA
#undef PG8_LDB
#undef PG8_MMA
#undef PG8_WAIT_V
#undef PG8_WAIT_L
#undef PG8_BAR
#undef PG8_SCHED
}

struct LinOrder {
  int nN, nunits, G, c;
  __device__ __forceinline__ bool next(int i, Unit& u) const { const int L = i * G + c; if (L >= nunits) return false; u.pm = L / nN; u.pn = L % nN; return true; }
  __device__ __forceinline__ void a_ready(const Unit&) const {}
  __device__ __forceinline__ void done(const Unit&) const {}
};
struct XcdOrder {
  int nN, nM, G, c;
  __device__ __forceinline__ bool next(int i, Unit& u) const {
    if (G & 7) { const int L = i * G + c; if (L >= nM * nN) return false; u.pm = L / nN; u.pn = L % nN; return true; }
    const int x = c & 7, y = c >> 3, j = y + (G >> 3) * i, T = (nM - x + 7) >> 3;
    if (j >= T * nN) return false;
    u.pm = x + 8 * (j / nN); u.pn = nN == 16 ? ((j % nN) + 3 * (j / nN) + 2 * x) % nN : (j % nN + x) % nN; return true;
  }
  __device__ __forceinline__ void a_ready(const Unit&) const {}
  __device__ __forceinline__ void done(const Unit&) const {}
};
struct OneUnit {
  Unit u0;
  __device__ __forceinline__ bool next(int i, Unit& u) const { if (i) return false; u = u0; return true; }
  __device__ __forceinline__ void a_ready(const Unit&) const {}
  __device__ __forceinline__ void done(const Unit&) const {}
};
struct EpiZ {
  static constexpr bool PERM = true, AFTER_DRAIN = false;
  bf16_t* O; int ldc;
  __device__ __forceinline__ void operator()(const f32x4 (&acc)[2][2][4][2], const Unit& u, int wr, int wc, int fr, int fq) const {
    const int row0 = u.pm * BM + wr * 64 + fr, col0 = u.pn * BM + wc * 32 + 8 * fq;
#pragma unroll
    for (int ai = 0; ai < 2; ++ai)
#pragma unroll
      for (int m = 0; m < 4; ++m) { bf16_t* rowp = O + (size_t)(row0 + ai * HALF + m * 16) * ldc + col0;
#pragma unroll
        for (int bj = 0; bj < 2; ++bj) { const f32x4 v0 = acc[ai][bj][m][0], v1 = acc[ai][bj][m][1];
          u32x4 w; w.x = ::pack2(v0[0], v0[1]); w.y = ::pack2(v0[2], v0[3]); w.z = ::pack2(v1[0], v1[1]); w.w = ::pack2(v1[2], v1[3]);
          *(u32x4*)(rowp + bj * HALF) = w; } }
  }
};
struct EpiRes {
  static constexpr bool PERM = true, AFTER_DRAIN = false;
  bf16_t* xw; const float* modl;
  __device__ __forceinline__ void operator()(const f32x4 (&acc)[2][2][4][2], const Unit& u, int wr, int wc, int fr, int fq) const {
    const int row0 = u.pm * BM + wr * 64 + fr, col0 = u.pn * BM + wc * 32 + 8 * fq;
    const float* g1p = modl + (size_t)::row_cls(u.pm * BM) * 6144 + 2048 + col0;
    f32x4 gv[2][2];
#pragma unroll
    for (int bj = 0; bj < 2; ++bj)
#pragma unroll
      for (int n = 0; n < 2; ++n) gv[bj][n] = *(const f32x4*)(g1p + bj * HALF + 4 * n);
#pragma unroll
    for (int ai = 0; ai < 2; ++ai)
#pragma unroll
      for (int m = 0; m < 4; ++m) { bf16_t* rowp = xw + (size_t)(row0 + ai * HALF + m * 16) * 1024 + col0;
#pragma unroll
        for (int bj = 0; bj < 2; ++bj) { const f32x4 v0 = acc[ai][bj][m][0], v1 = acc[ai][bj][m][1];
          u32x4 w = *(const u32x4*)(rowp + bj * HALF);
          w.x = ::pack2(::bflo(w.x) + gv[bj][0][0] * v0[0], ::bfhi(w.x) + gv[bj][0][1] * v0[1]); w.y = ::pack2(::bflo(w.y) + gv[bj][0][2] * v0[2], ::bfhi(w.y) + gv[bj][0][3] * v0[3]);
          w.z = ::pack2(::bflo(w.z) + gv[bj][1][0] * v1[0], ::bfhi(w.z) + gv[bj][1][1] * v1[1]); w.w = ::pack2(::bflo(w.w) + gv[bj][1][2] * v1[2], ::bfhi(w.w) + gv[bj][1][3] * v1[3]);
          *(u32x4*)(rowp + bj * HALF) = w; } }
  }
};
struct EpiTopk {
  static constexpr bool PERM = false, AFTER_DRAIN = true;
  unsigned* topk;
  __device__ __forceinline__ void operator()(const f32x4 (&)[2][2][4][2], const Unit&, int, int, int, int) const {}
  __device__ __forceinline__ void fused(const f32x4 (&acc)[2][2][4][2], const Unit& u, int wr, int wc, int fr, int fq, PG8_LAS unsigned char* lds, int wid, int lane) const {
    PG8_LAS float* st = (PG8_LAS float*)lds;
    const int tid = wid * 64 + lane;
#pragma unroll 1
    for (int bj = 0; bj < 2; ++bj) {
#pragma unroll
      for (int ai = 0; ai < 2; ++ai)
#pragma unroll
        for (int m = 0; m < 4; ++m)
#pragma unroll
          for (int n = 0; n < 2; ++n) {
            PG8_LAS float* q = st + (ai * HALF + wr * 64 + m * 16 + fr) * 129 + wc * 32 + n * 16 + 4 * fq;
            const f32x4 v = bj == 0 ? acc[ai][0][m][n] : acc[ai][1][m][n];
            q[0] = v[0]; q[1] = v[1]; q[2] = v[2]; q[3] = v[3];
          }
      asm volatile("s_waitcnt lgkmcnt(0)" ::: "memory"); __builtin_amdgcn_s_barrier(); asm volatile("" ::: "memory");
      if (tid < 256) {
        float t16[16];
#pragma unroll
        for (int i = 0; i < 16; ++i) t16[i] = __uint_as_float(0xff800000u);
        for (int kk = 0; kk < 128; ++kk) {
          const float sv = st[tid * 129 + kk];
          const float x = __uint_as_float((__float_as_uint(sv) & ~0x7fu) | (unsigned)(127 - kk));
#pragma unroll
          for (int i = 15; i >= 1; --i) t16[i] = __builtin_amdgcn_fmed3f(x, t16[i - 1], t16[i]);
          t16[0] = fmaxf(t16[0], x);
        }
        unsigned* tk = topk + ((size_t)(u.pm * BM + tid) * 16 + (u.pn * 2 + bj)) * 16;
#pragma unroll
        for (int q = 0; q < 4; ++q) {
          u32x4 o; o.x = __float_as_uint(t16[q * 4]); o.y = __float_as_uint(t16[q * 4 + 1]); o.z = __float_as_uint(t16[q * 4 + 2]); o.w = __float_as_uint(t16[q * 4 + 3]);
          *(u32x4*)(tk + q * 4) = o;
        }
      }
      asm volatile("s_waitcnt lgkmcnt(0)" ::: "memory"); __builtin_amdgcn_s_barrier(); asm volatile("" ::: "memory");
    }
  }
};
struct EpiZI8 {
  static constexpr bool PERM = true, AFTER_DRAIN = false;
  bf16_t* O; int ldc; const float* rsc; const float* csc; const float* lower;
  __device__ __forceinline__ void operator()(const i32x4 (&acc)[2][2][4][2], const Unit& u, int wr, int wc, int fr, int fq) const {
    const int row0 = u.pm * BM + wr * 64 + fr, col0 = u.pn * BM + wc * 32 + 8 * fq;
    f32x4 cs[2][2];
#pragma unroll
    for (int bj = 0; bj < 2; ++bj)
#pragma unroll
      for (int n = 0; n < 2; ++n) cs[bj][n] = *(const f32x4*)(csc + col0 + bj * HALF + 4 * n);
    if (ldc == 4096 && (u.pn == 10 || u.pn == 11 || u.pn == 14 || u.pn == 15)) {
      const int ucol = 2560 + (u.pn < 12 ? u.pn - 10 : u.pn - 12) * 128 + wc * 32 + 8 * fq;
#pragma unroll
      for (int ai = 0; ai < 2; ++ai)
#pragma unroll
        for (int m = 0; m < 4; ++m) { const int row = row0 + ai * HALF + m * 16; const float rs = rsc[row];
          const i32x4 c0 = acc[ai][0][m][0], c1 = acc[ai][0][m][1], h0 = acc[ai][1][m][0], h1 = acc[ai][1][m][1];
          u32x4 w;
          w.x = ::pack2(((float)c0[0] * rs * cs[0][0][0]) * ((float)h0[0] * rs * cs[1][0][0]), ((float)c0[1] * rs * cs[0][0][1]) * ((float)h0[1] * rs * cs[1][0][1]));
          w.y = ::pack2(((float)c0[2] * rs * cs[0][0][2]) * ((float)h0[2] * rs * cs[1][0][2]), ((float)c0[3] * rs * cs[0][0][3]) * ((float)h0[3] * rs * cs[1][0][3]));
          w.z = ::pack2(((float)c1[0] * rs * cs[0][1][0]) * ((float)h1[0] * rs * cs[1][1][0]), ((float)c1[1] * rs * cs[0][1][1]) * ((float)h1[1] * rs * cs[1][1][1]));
          w.w = ::pack2(((float)c1[2] * rs * cs[0][1][2]) * ((float)h1[2] * rs * cs[1][1][2]), ((float)c1[3] * rs * cs[0][1][3]) * ((float)h1[3] * rs * cs[1][1][3]));
          *(u32x4*)(O + (size_t)row * ldc + ucol) = w; }
      return;
    }
    if (lower != nullptr && u.pn >= 2 && u.pn <= 5) {
      f32x4 lbv[2][2];
#pragma unroll
      for (int bj = 0; bj < 2; ++bj)
#pragma unroll
        for (int n = 0; n < 2; ++n) lbv[bj][n] = *(const f32x4*)(lower + (col0 - 512) + bj * HALF + 4 * n);
#pragma unroll
      for (int ai = 0; ai < 2; ++ai)
#pragma unroll
        for (int m = 0; m < 4; ++m) { const int row = row0 + ai * HALF + m * 16; const float rs = rsc[row]; bf16_t* rowp = O + (size_t)row * ldc + col0;
#pragma unroll
          for (int bj = 0; bj < 2; ++bj) {
            float kv[8];
#pragma unroll
            for (int n = 0; n < 2; ++n)
#pragma unroll
              for (int e = 0; e < 4; ++e) {
                const float z = (float)acc[ai][bj][m][n][e] * rs * cs[bj][n][e];
                const float ez = fminf(__builtin_amdgcn_exp2f(-z * 1.4426950408889634f), 1e30f);
                kv[4 * n + e] = (1.f - lbv[bj][n][e]) * (ez * __builtin_amdgcn_rcpf(1.f + ez));
              }
            u32x4 w; w.x = ::pack2(kv[0], kv[1]); w.y = ::pack2(kv[2], kv[3]); w.z = ::pack2(kv[4], kv[5]); w.w = ::pack2(kv[6], kv[7]);
            *(u32x4*)(rowp + bj * HALF) = w; } }
      return;
    }
#pragma unroll
    for (int ai = 0; ai < 2; ++ai)
#pragma unroll
      for (int m = 0; m < 4; ++m) { const int row = row0 + ai * HALF + m * 16; const float rs = rsc[row]; bf16_t* rowp = O + (size_t)row * ldc + col0;
#pragma unroll
        for (int bj = 0; bj < 2; ++bj) { const i32x4 a0 = acc[ai][bj][m][0], a1 = acc[ai][bj][m][1];
          u32x4 w;
          w.x = ::pack2((float)a0[0] * rs * cs[bj][0][0], (float)a0[1] * rs * cs[bj][0][1]); w.y = ::pack2((float)a0[2] * rs * cs[bj][0][2], (float)a0[3] * rs * cs[bj][0][3]);
          w.z = ::pack2((float)a1[0] * rs * cs[bj][1][0], (float)a1[1] * rs * cs[bj][1][1]); w.w = ::pack2((float)a1[2] * rs * cs[bj][1][2], (float)a1[3] * rs * cs[bj][1][3]);
          *(u32x4*)(rowp + bj * HALF) = w; } }
  }
};
struct EpiTopkI8 {
  static constexpr bool PERM = false, AFTER_DRAIN = true;
  unsigned* topk; const float* rsc; const float* csc;
  __device__ __forceinline__ void operator()(const i32x4 (&)[2][2][4][2], const Unit&, int, int, int, int) const {}
  __device__ __forceinline__ void fused(const i32x4 (&acc)[2][2][4][2], const Unit& u, int wr, int wc, int fr, int fq, PG8_LAS unsigned char* lds, int wid, int lane) const {
    PG8_LAS float* st = (PG8_LAS float*)lds;
    const int tid = wid * 64 + lane;
    float rs[2][4];
#pragma unroll
    for (int ai = 0; ai < 2; ++ai)
#pragma unroll
      for (int m = 0; m < 4; ++m) rs[ai][m] = rsc[u.pm * BM + ai * HALF + wr * 64 + m * 16 + fr];
#pragma unroll 1
    for (int bj = 0; bj < 2; ++bj) {
      f32x4 cs[2];
#pragma unroll
      for (int n = 0; n < 2; ++n) cs[n] = *(const f32x4*)(csc + u.pn * BM + bj * HALF + wc * 32 + n * 16 + 4 * fq);
#pragma unroll
      for (int ai = 0; ai < 2; ++ai)
#pragma unroll
        for (int m = 0; m < 4; ++m)
#pragma unroll
          for (int n = 0; n < 2; ++n) {
            PG8_LAS float* q = st + (ai * HALF + wr * 64 + m * 16 + fr) * 129 + wc * 32 + n * 16 + 4 * fq;
            const i32x4 v = bj == 0 ? acc[ai][0][m][n] : acc[ai][1][m][n];
            q[0] = (float)v[0] * rs[ai][m] * cs[n][0]; q[1] = (float)v[1] * rs[ai][m] * cs[n][1]; q[2] = (float)v[2] * rs[ai][m] * cs[n][2]; q[3] = (float)v[3] * rs[ai][m] * cs[n][3];
          }
      asm volatile("s_waitcnt lgkmcnt(0)" ::: "memory"); __builtin_amdgcn_s_barrier(); asm volatile("" ::: "memory");
      if (tid < 256) {
        float t16[16];
#pragma unroll
        for (int i = 0; i < 16; ++i) t16[i] = __uint_as_float(0xff800000u);
        float nx[8];
#pragma unroll
        for (int j = 0; j < 8; ++j) nx[j] = st[tid * 129 + j];
#pragma unroll 1
        for (int kk = 0; kk < 128; kk += 8) {
          float cur[8];
#pragma unroll
          for (int j = 0; j < 8; ++j) cur[j] = nx[j];
          if (kk + 8 < 128) {
#pragma unroll
            for (int j = 0; j < 8; ++j) nx[j] = st[tid * 129 + kk + 8 + j];
          }
#pragma unroll
          for (int j = 0; j < 8; ++j) {
            const float x = __uint_as_float((__float_as_uint(cur[j]) & ~0x7fu) | (unsigned)(127 - kk - j));
#pragma unroll
            for (int i = 15; i >= 1; --i) t16[i] = __builtin_amdgcn_fmed3f(x, t16[i - 1], t16[i]);
            t16[0] = fmaxf(t16[0], x);
          }
        }
        unsigned* tk = topk + ((size_t)(u.pm * BM + tid) * 16 + (u.pn * 2 + bj)) * 16;
#pragma unroll
        for (int q = 0; q < 4; ++q) {
          u32x4 o; o.x = __float_as_uint(t16[q * 4]); o.y = __float_as_uint(t16[q * 4 + 1]); o.z = __float_as_uint(t16[q * 4 + 2]); o.w = __float_as_uint(t16[q * 4 + 3]);
          *(u32x4*)(tk + q * 4) = o;
        }
      }
      asm volatile("s_waitcnt lgkmcnt(0)" ::: "memory"); __builtin_amdgcn_s_barrier(); asm volatile("" ::: "memory");
    }
  }
};
}

enum { G8_Z = 0, G8_RES = 1, G8_TOPK = 2 };
struct TailSlot { bool idle; int idx, cnt; };
DI TailSlot tail_slot(int nM, int nN, int nb, int bid) {
  TailSlot t; t.idle = false; t.idx = 0; t.cnt = 0;
  if (nb & 7) { const int rem = (nM * nN) % nb; if (rem != 0) { t.idle = bid >= rem; t.idx = bid - rem; t.cnt = nb - rem; } return t; }
  const int G8 = nb >> 3, x = bid & 7, y = bid >> 3;
  int R = 0;
  for (int xx = 0; xx < 8; ++xx) { const int U = ((nM - xx + 7) >> 3) * nN, r = (U + G8 - 1) / G8; R = r > R ? r : R; }
  for (int xx = 0; xx < 8; ++xx) {
    const int U = ((nM - xx + 7) >> 3) * nN;
    int busy = U - G8 * (R - 1); busy = busy < 0 ? 0 : (busy > G8 ? G8 : busy);
    const int idl = G8 - busy;
    if (xx < x) t.idx += idl;
    if (xx == x) { t.idle = y >= busy; t.idx += y - busy; }
    t.cnt += idl;
  }
  if (t.cnt == 0) t.idle = false;
  return t;
}
template <int EPI>
DI void gemm8_phase(KP p, unsigned char* smem, const u16* A, const u16* Bt, int N, int K, int l, int bid, int nb, int m_tiles_active, int tid) {
  pg8::Gemm g{A, Bt, m_tiles_active * 256, N, K};
  const int nN = N / 256, nunits = m_tiles_active * nN;
  PG8_LAS unsigned char* lds = (PG8_LAS unsigned char*)smem;
  if constexpr (EPI == G8_Z) {
    pg8::XcdOrder S{nN, m_tiles_active, nb, bid};
    pg8::Gemm g8{(const pg8::bf16_t*)(p.ws + WS_HXQ), (const pg8::bf16_t*)(p.ws + WS_WINQ + (size_t)l * 4096 * 1024), m_tiles_active * 256, N, K};
    pg8::EpiZI8 E{(pg8::bf16_t*)(p.ws + WS_Z), N, (const float*)(p.ws + WS_HXS), (const float*)(p.ws + WS_WINS) + (size_t)l * 4096, (const float*)(p.ws + WS_LOWER) + (size_t)l * 2 * 512};
    pg8::gemm_phase_i8<pg8::EpiZI8, pg8::XcdOrder>(lds, g8, S, E, tid);
  } else if constexpr (EPI == G8_RES) {
    pg8::XcdOrder S{nN, m_tiles_active, nb, bid};
    pg8::EpiRes E{(pg8::bf16_t*)(p.ws + WS_XW), (const float*)(p.ws + WS_MOD) + (size_t)l * 5 * 6144};
    pg8::gemm_phase<pg8::EpiRes, pg8::XcdOrder>(lds, g, S, E, tid);
  } else {
    pg8::Gemm g8{(const pg8::bf16_t*)(p.ws + WS_HXQ), (const pg8::bf16_t*)(p.ws + WS_WSQ + (size_t)l * 2048 * 1024), m_tiles_active * 256, N, K};
    pg8::EpiTopkI8 E{(unsigned*)(p.ws + WS_TOPK), (const float*)(p.ws + WS_HXS), (const float*)(p.ws + WS_WSS) + (size_t)l * 2048};
#pragma unroll 1
    for (int i = 0;; ++i) {
      pg8::XcdOrder X{nN, m_tiles_active, nb, bid};
      pg8::Unit u0;
      if (!X.next(i, u0)) break;
      pg8::OneUnit S{u0};
      pg8::gemm_phase_i8<pg8::EpiTopkI8, pg8::OneUnit>(lds, g8, S, E, tid);
    }
  }
  __syncthreads();
  const TailSlot ts = tail_slot(m_tiles_active, nN, nb, bid);
  if constexpr (EPI == G8_Z) {
    if (l + 1 < DEPTH && ts.idle) p0_mod_groups(p, (float*)smem, 192 * (l + 1), ts.idx, ts.cnt, tid);
  }
  if constexpr (EPI == G8_RES || EPI == G8_TOPK) {
    const bool far_only = !(nb & 7) && m_tiles_active == 68;
    const bool qrun = far_only ? ((bid & 7) >= 4) : ts.idle;
    const int qidx = far_only ? (bid >> 3) * 4 + (bid & 7) - 4 : ts.idx, qcnt = far_only ? (nb >> 3) * 4 : ts.cnt;
    if (l + 1 < DEPTH && qrun) {
      const float* src = (EPI == G8_RES ? p.peer_u : p.peer_v);
      unsigned char* dst = p.ws + (EPI == G8_RES ? WS_UB : WS_VB);
      float* scl = (float*)(p.ws + (EPI == G8_RES ? WS_US : WS_VS));
#pragma unroll 1
      for (int it = qidx; it < 256; it += qcnt) p0_quant_rows(src, dst, scl, (l + 1) * NEXP + it * 64, tid, 0.f);
    }
  }
}

constexpr float LOG2E = 1.4426950408889634f;
DI int seg_row0(int b, int j) { return j < 2 ? NLAT + b * CTXL + 128 * j : b * SEQ + 128 * (j - 2); }
DI int pi_bwd(int j) { return j < 2 ? 1 - j : 35 - j; }
DI float ex2(float x) { return __builtin_amdgcn_exp2f(x); }
DI unsigned sw32(int row, int col) { return (unsigned)(row * 64 + ((((col >> 3) ^ ((row >> 2) & 3))) << 4) + (col & 7) * 2); }
DI bf16x8 pack8(float a0, float a1, float a2, float a3, float a4, float a5, float a6, float a7) {
  u32x4 p; p[0] = pack2(a0, a1); p[1] = pack2(a2, a3); p[2] = pack2(a4, a5); p[3] = pack2(a6, a7);
  return __builtin_bit_cast(bf16x8, p);
}
DI bf16x8 cat8(u32x2 lo, u32x2 hi) { u32x4 p; p[0] = lo[0]; p[1] = lo[1]; p[2] = hi[0]; p[3] = hi[1]; return __builtin_bit_cast(bf16x8, p); }

DI void rec_pass1(KP p, unsigned char* smem, int l, int item, int tid) {
  const int j = item % 34, bh = item / 34, b = bh >> 2, hd = bh & 3;
  const int R0 = seg_row0(b, j);
  const int lane = tid & 63, wave = tid >> 6, r = lane & 31, h = lane >> 5;
  unsigned char* KOT = smem;
  unsigned char* VT = smem + 65536;
  float* TX = (float*)(smem + 98304);
  const u16* Z = (const u16*)(p.ws + WS_Z);
  const int k = tid & 127, qd = tid >> 7;
  unsigned char* STG = smem + 100352;
  u32x4 pre[4];
  auto gstage = [&](int colbase) {
#pragma unroll
    for (int u = 0; u < 4; ++u) { const int q = tid + NTHR * u; pre[u] = *(const u32x4*)(Z + (size_t)(R0 + (q >> 4)) * INC + colbase + (q & 15) * 8); }
  };
  auto wstage = [&]() {
#pragma unroll
    for (int u = 0; u < 4; ++u) { const int q = tid + NTHR * u; *(u32x4*)(STG + q * 16) = pre[u]; }
  };
  gstage(hd * 128);
  wstage();
  __syncthreads();
  gstage(512 + hd * 128);
  {
    u16 vv[32];
#pragma unroll
    for (int ii = 0; ii < 32; ++ii) vv[ii] = *(const u16*)(STG + (32 * qd + ii) * 256 + k * 2);
#pragma unroll
    for (int c4 = 0; c4 < 4; ++c4) {
      u32x4 o;
#pragma unroll
      for (int e = 0; e < 4; ++e) o[e] = (unsigned)vv[c4 * 8 + 2 * e] | ((unsigned)vv[c4 * 8 + 2 * e + 1] << 16);
      *(u32x4*)(VT + sw128(k, 32 * qd + 8 * c4)) = o;
    }
  }
  __syncthreads();
#pragma unroll 1
  for (int d = 0; d < 2; ++d) {
    wstage();
    __syncthreads();
    if (d == 0) gstage(1024 + hd * 128);
    const float lb = ((const float*)(p.ws + WS_LOWER))[((size_t)l * 2 + d) * 512 + hd * 128 + k];
    float fv[32], kk[32];
    float tot = 1.f;
#pragma unroll
    for (int ii = 0; ii < 32; ++ii) {
      const float kv = bf2f(*(const u16*)(STG + (32 * qd + ii) * 256 + k * 2));
      const float f = fmaxf(1.f - kv, 1e-20f);
      fv[ii] = f;
      kk[ii] = kv;
      tot *= f;
    }
    TX[qd * 128 + k] = tot;
    __syncthreads();
    const float t0 = TX[k], t1 = TX[128 + k], t2 = TX[256 + k], t3 = TX[384 + k];
    float run;
    if (d == 0) run = (qd == 0 ? t1 * t2 * t3 : qd == 1 ? t2 * t3 : qd == 2 ? t3 : 1.f);
    else run = (qd == 0 ? 1.f : qd == 1 ? t0 : qd == 2 ? t0 * t1 : t0 * t1 * t2);
    float ko[32];
    if (d == 0) {
#pragma unroll
      for (int ii = 31; ii >= 0; --ii) { ko[ii] = kk[ii] * run; run *= fv[ii]; }
    } else {
#pragma unroll
      for (int ii = 0; ii < 32; ++ii) { ko[ii] = kk[ii] * run; run *= fv[ii]; }
    }
#pragma unroll
    for (int c4 = 0; c4 < 4; ++c4) {
      u32x4 o;
#pragma unroll
      for (int e = 0; e < 4; ++e) o[e] = pack2(ko[c4 * 8 + 2 * e], ko[c4 * 8 + 2 * e + 1]);
      *(u32x4*)(KOT + d * 32768 + sw128(k, 32 * qd + 8 * c4)) = o;
    }
    if (qd == 0) {
      const int pi = d ? pi_bwd(j) : j;
      ((float*)(p.ws + WS_DT))[((size_t)(bh * 2 + d) * 34 + pi) * 128 + k] = t0 * t1 * t2 * t3;
    }
    __syncthreads();
  }
  {
    const int d = wave >> 2, w4 = wave & 3;
    f32x16 acc[4];
#pragma unroll
    for (int mt = 0; mt < 4; ++mt)
#pragma unroll
      for (int e = 0; e < 16; ++e) acc[mt][e] = 0.f;
#pragma unroll
    for (int ks = 0; ks < 8; ++ks) {
      const bf16x8 bv = *(const bf16x8*)(VT + sw128(32 * w4 + r, 16 * ks + 8 * h));
#pragma unroll
      for (int mt = 0; mt < 4; ++mt) {
        const bf16x8 av = *(const bf16x8*)(KOT + d * 32768 + sw128(32 * mt + r, 16 * ks + 8 * h));
        acc[mt] = __builtin_amdgcn_mfma_f32_32x32x16_bf16(av, bv, acc[mt], 0, 0, 0);
      }
    }
    const int pi = d ? pi_bwd(j) : j;
    u16* sl = (u16*)(p.ws + WS_SLOC) + ((size_t)(bh * 2 + d) * 34 + pi) * 16384;
#pragma unroll
    for (int mt = 0; mt < 4; ++mt)
#pragma unroll
      for (int g = 0; g < 4; ++g) {
        u32x2 o; o[0] = pack2(acc[mt][4 * g], acc[mt][4 * g + 1]); o[1] = pack2(acc[mt][4 * g + 2], acc[mt][4 * g + 3]);
        *(u32x2*)(sl + ((((w4 * 4 + mt) * 4 + g) * 64 + lane) * 4)) = o;
      }
  }
  __syncthreads();
}

DI void rec_pass2(KP p, int bid, int nb, int tid) {
  const u16* SL = (const u16*)(p.ws + WS_SLOC);
  u16* SS = (u16*)(p.ws + WS_SST);
  const float* DT = (const float*)(p.ws + WS_DT);
  for (int gid = bid * NTHR + tid; gid < 32 * 4096; gid += nb * NTHR) {
    const int seq = gid >> 12, grp = gid & 4095;
    const int lane = grp & 63, g = (grp >> 6) & 3, mt = (grp >> 8) & 3;
    const int k0 = 32 * mt + 8 * g + 4 * (lane >> 5);
    const u16* sl = SL + (size_t)seq * 34 * 16384 + grp * 4;
    u16* ss = SS + (size_t)seq * 34 * 16384 + grp * 4;
    const float* dt = DT + (size_t)seq * 34 * 128 + k0;
    float s0 = 0.f, s1 = 0.f, s2 = 0.f, s3 = 0.f;
#pragma unroll 3
    for (int pi = 0; pi < 33; ++pi) {
      const u32x2 w = *(const u32x2*)(sl + (size_t)pi * 16384);
      const float4 dd = *(const float4*)(dt + pi * 128);
      s0 = dd.x * s0 + bflo(w[0]); s1 = dd.y * s1 + bfhi(w[0]); s2 = dd.z * s2 + bflo(w[1]); s3 = dd.w * s3 + bfhi(w[1]);
      u32x2 o; o[0] = pack2(s0, s1); o[1] = pack2(s2, s3);
      *(u32x2*)(ss + (size_t)(pi + 1) * 16384) = o;
    }
  }
}

DI void rec_pass3(KP p, unsigned char* smem, int l, int item, int tid, bool ctx_early = false) {
  const int j = item % 34, bh = item / 34, b = bh >> 2, hd = bh & 3;
  const int R0 = seg_row0(b, j);
  const int lane = tid & 63, wave = __builtin_amdgcn_readfirstlane(tid >> 6), r = lane & 31, h = lane >> 5;
  const int d = wave >> 2, w4 = wave & 3, tt = w4 * 64 + lane;
  unsigned char* base = smem + d * 67584;
  unsigned char* SZ = base, *SQ = base + 8192, *SV = base + 16384;
  unsigned char* QT = base + 24576, *KT = base + 32768, *QI = base + 40960, *KOT = base + 49152, *VT = base + 57344;
  float* DTc = (float*)(base + 65536);
  float* TX = (float*)(base + 66048);
  const u16* Z = (const u16*)(p.ws + WS_Z);
  u16* O = (u16*)(p.ws + (d ? WS_OB : WS_OF));
  const int pi = d ? pi_bwd(j) : j;
  f32x16 S[4];
  if (pi == 0) {
#pragma unroll
    for (int mt = 0; mt < 4; ++mt)
#pragma unroll
      for (int e = 0; e < 16; ++e) S[mt][e] = 0.f;
  } else {
    const u16* ss = ctx_early ? (const u16*)(p.ws + WS_SLOC) + ((size_t)(bh * 2 + d) * 34 + (pi - 1)) * 16384
                              : (const u16*)(p.ws + WS_SST) + ((size_t)(bh * 2 + d) * 34 + pi) * 16384;
#pragma unroll
    for (int mt = 0; mt < 4; ++mt)
#pragma unroll
      for (int g = 0; g < 4; ++g) {
        const u32x2 w = *(const u32x2*)(ss + ((((w4 * 4 + mt) * 4 + g) * 64 + lane) * 4));
        S[mt][4 * g] = bflo(w[0]); S[mt][4 * g + 1] = bfhi(w[0]); S[mt][4 * g + 2] = bflo(w[1]); S[mt][4 * g + 3] = bfhi(w[1]);
      }
  }
  const int k = (w4 & 1) * 64 + lane, half = w4 >> 1;
  const float lb = ((const float*)(p.ws + WS_LOWER))[((size_t)l * 2 + d) * 512 + hd * 128 + k];
  const int zg_col = (d ? 1024 : 512) + hd * 128, q_col = 1536 + hd * 128, v_col = hd * 128;
  u32x4 pz[2], pq[2], pv[2];
  auto gl = [&](int c) {
#pragma unroll
    for (int u = 0; u < 2; ++u) {
      const int q = tt + 256 * u, i = q >> 4, c16 = q & 15;
      const int n = d ? (127 - 32 * c - i) : (32 * c + i);
      const u16* zr = Z + (size_t)(R0 + n) * INC + c16 * 8;
      pz[u] = *(const u32x4*)(zr + zg_col); pq[u] = *(const u32x4*)(zr + q_col); pv[u] = *(const u32x4*)(zr + v_col);
    }
  };
  gl(0);
#pragma unroll 1
  for (int c = 0; c < 4; ++c) {
#pragma unroll
    for (int u = 0; u < 2; ++u) {
      const int q = tt + 256 * u;
      *(u32x4*)(SZ + q * 16) = pz[u]; *(u32x4*)(SQ + q * 16) = pq[u]; *(u32x4*)(SV + q * 16) = pv[u];
    }
    __syncthreads();
    if (c + 1 < 4) gl(c + 1);
    float fa[16];
    {
      float prod = 1.f;
#pragma unroll
      for (int ii = 0; ii < 16; ++ii) {
        const int i = 16 * half + ii;
        const float f = fmaxf(1.f - bf2f(*(const u16*)(SZ + i * 256 + k * 2)), 1e-20f);
        fa[ii] = f; prod *= f;
      }
      TX[half * 128 + k] = prod;
    }
    __syncthreads();
    {
      const float e0 = TX[k], e1 = TX[128 + k];
      unsigned kop[8];
      float khi = 0.f;
      if (half == 0) {
        float pf = 1.f;
#pragma unroll
        for (int ii = 0; ii < 16; ++ii) {
          pf *= fa[ii];
          const float qq = bf2f(*(const u16*)(SQ + ii * 256 + k * 2));
          *(u16*)(QI + sw128(ii, k)) = f2bf(qq * pf);
        }
        __builtin_amdgcn_sched_barrier(0);
        float sf = 1.f, sgp = 1.f;
#pragma unroll
        for (int ii = 15; ii >= 0; --ii) {
          const float qq = bf2f(*(const u16*)(SQ + ii * 256 + k * 2));
          const float kt = (1.f - fa[ii]) * sf;
          { const float kov = kt * e1; if (ii & 1) khi = kov; else kop[ii >> 1] = pack2(kov, khi); }
          *(u16*)(QT + sw128(ii, k)) = f2bf(qq * sgp); *(u16*)(KT + sw128(ii, k)) = f2bf(kt);
          sf *= fa[ii]; sgp = fminf(sgp * __builtin_amdgcn_rcpf(fa[ii]), 1.329e36f);
        }
      } else {
        float pf = 1.f, pg = 1.f;
#pragma unroll
        for (int ii = 0; ii < 16; ++ii) {
          const int i = 16 + ii;
          pf *= fa[ii]; pg = fminf(pg * __builtin_amdgcn_rcpf(fa[ii]), 1.329e36f);
          const float qq = bf2f(*(const u16*)(SQ + i * 256 + k * 2));
          const float qt = qq * pf;
          *(u16*)(QT + sw128(i, k)) = f2bf(qt); *(u16*)(QI + sw128(i, k)) = f2bf(qt * e0); *(u16*)(KT + sw128(i, k)) = f2bf((1.f - fa[ii]) * pg);
        }
        __builtin_amdgcn_sched_barrier(0);
        float sf = 1.f;
#pragma unroll
        for (int ii = 15; ii >= 0; --ii) { const float kov = (1.f - fa[ii]) * sf; if (ii & 1) khi = kov; else kop[ii >> 1] = pack2(kov, khi); sf *= fa[ii]; }
      }
      if (half == 0) DTc[k] = e0 * e1;
      u32x4 o0, o1;
#pragma unroll
      for (int e = 0; e < 4; ++e) { o0[e] = kop[e]; o1[e] = kop[4 + e]; }
      *(u32x4*)(KOT + sw32(k, 16 * half)) = o0; *(u32x4*)(KOT + sw32(k, 16 * half + 8)) = o1;
      u32x4 v0, v1;
#pragma unroll
      for (int e = 0; e < 4; ++e) {
        v0[e] = (unsigned)*(const u16*)(SV + (16 * half + 2 * e) * 256 + k * 2) | ((unsigned)*(const u16*)(SV + (16 * half + 2 * e + 1) * 256 + k * 2) << 16);
        v1[e] = (unsigned)*(const u16*)(SV + (16 * half + 8 + 2 * e) * 256 + k * 2) | ((unsigned)*(const u16*)(SV + (16 * half + 8 + 2 * e + 1) * 256 + k * 2) << 16);
      }
      *(u32x4*)(VT + sw32(k, 16 * half)) = v0; *(u32x4*)(VT + sw32(k, 16 * half + 8)) = v1;
    }
    __syncthreads();
    {
      f32x16 X;
#pragma unroll
      for (int e = 0; e < 16; ++e) X[e] = 0.f;
#pragma unroll 2
      for (int ks = 0; ks < 8; ++ks) {
        const bf16x8 a = *(const bf16x8*)(KT + sw128(r, 16 * ks + 8 * h));
        const bf16x8 bq = *(const bf16x8*)(QT + sw128(r, 16 * ks + 8 * h));
        X = __builtin_amdgcn_mfma_f32_32x32x16_bf16(a, bq, X, 0, 0, 0);
      }
      { int rm = r, hm = h; asm volatile("" : "+v"(rm), "+v"(hm));
#pragma unroll
        for (int e = 0; e < 16; ++e) { const int sidx = (e & 3) + 8 * (e >> 2) + 4 * hm; if (sidx > rm) X[e] = 0.f; } }
      f32x16 o;
#pragma unroll
      for (int e = 0; e < 16; ++e) o[e] = 0.f;
#pragma unroll
      for (int s2 = 0; s2 < 2; ++s2) {
        const bf16x8 xa = pack8(X[8 * s2], X[8 * s2 + 1], X[8 * s2 + 2], X[8 * s2 + 3], X[8 * s2 + 4], X[8 * s2 + 5], X[8 * s2 + 6], X[8 * s2 + 7]);
        const u32x2 lo = *(const u32x2*)(VT + sw32(32 * w4 + r, 16 * s2 + 4 * h));
        const u32x2 hi = *(const u32x2*)(VT + sw32(32 * w4 + r, 16 * s2 + 8 + 4 * h));
        o = __builtin_amdgcn_mfma_f32_32x32x16_bf16(xa, cat8(lo, hi), o, 0, 0, 0);
      }
#pragma unroll
      for (int mt = 0; mt < 4; ++mt)
#pragma unroll
        for (int s2 = 0; s2 < 2; ++s2) {
          const bf16x8 sb = pack8(S[mt][8 * s2], S[mt][8 * s2 + 1], S[mt][8 * s2 + 2], S[mt][8 * s2 + 3], S[mt][8 * s2 + 4], S[mt][8 * s2 + 5], S[mt][8 * s2 + 6], S[mt][8 * s2 + 7]);
          const u32x2 lo = *(const u32x2*)(QI + sw128(r, 32 * mt + 16 * s2 + 4 * h));
          const u32x2 hi = *(const u32x2*)(QI + sw128(r, 32 * mt + 16 * s2 + 8 + 4 * h));
          o = __builtin_amdgcn_mfma_f32_32x32x16_bf16(cat8(lo, hi), sb, o, 0, 0, 0);
          if (s2 == 1) __builtin_amdgcn_sched_barrier(0);
        }
#pragma unroll
      for (int mt = 0; mt < 4; ++mt)
#pragma unroll
        for (int g = 0; g < 4; ++g) {
          const float4 dd = *(const float4*)(DTc + 32 * mt + 8 * g + 4 * h);
          S[mt][4 * g] *= dd.x; S[mt][4 * g + 1] *= dd.y; S[mt][4 * g + 2] *= dd.z; S[mt][4 * g + 3] *= dd.w;
        }
#pragma unroll
      for (int s2 = 0; s2 < 2; ++s2) {
        const bf16x8 bv = *(const bf16x8*)(VT + sw32(32 * w4 + r, 16 * s2 + 8 * h));
#pragma unroll
        for (int mt = 0; mt < 4; ++mt) {
          const bf16x8 av = *(const bf16x8*)(KOT + sw32(32 * mt + r, 16 * s2 + 8 * h));
          S[mt] = __builtin_amdgcn_mfma_f32_32x32x16_bf16(av, bv, S[mt], 0, 0, 0);
        }
      }
#pragma unroll
      for (int e = 0; e < 16; ++e) {
        const int i = (e & 3) + 8 * (e >> 2) + 4 * h;
        const int n = d ? (127 - 32 * c - i) : (32 * c + i);
        O[(size_t)(R0 + n) * 512 + hd * 128 + 32 * w4 + r] = f2bf(o[e]);
      }
    }
  }
  asm volatile("s_waitcnt vmcnt(0)" ::: "memory");
  __syncthreads();
  {
    const u16* OFp = (const u16*)(p.ws + WS_OF); const u16* OBp = (const u16*)(p.ws + WS_OB);
    u16* cat = (u16*)(p.ws + WS_CAT);
    int tq = tid, R0q = R0, hdq = hd; asm volatile("" : "+v"(tq), "+s"(R0q), "+s"(hdq));
    const int c16 = tq & 15, rr = tq >> 4;
    const u16* ofr = OFp + (size_t)(R0q + rr) * 512 + hdq * 128 + c16 * 8;
    const u16* obr = OBp + (size_t)(R0q + rr) * 512 + hdq * 128 + c16 * 8;
    const u16* gr = Z + (size_t)(R0q + rr) * INC + 2048 + hdq * 128 + c16 * 8;
    u16* cr = cat + (size_t)(R0q + rr) * D + hdq * 128 + c16 * 8;
    u32x4 af[4], ab[4], gw[4];
#pragma unroll
    for (int sw = 0; sw < 4; ++sw) {
      af[sw] = *(const u32x4*)(ofr + (size_t)sw * 32 * 512);
      ab[sw] = *(const u32x4*)(obr + (size_t)sw * 32 * 512);
      gw[sw] = *(const u32x4*)(gr + (size_t)sw * 32 * INC);
    }
#pragma unroll
    for (int sw = 0; sw < 4; ++sw) {
      float ov[8];
#pragma unroll
      for (int e = 0; e < 4; ++e) { ov[2 * e] = bflo(af[sw][e]) + bflo(ab[sw][e]); ov[2 * e + 1] = bfhi(af[sw][e]) + bfhi(ab[sw][e]); }
      float ss = 0.f;
#pragma unroll
      for (int e = 0; e < 8; ++e) ss += ov[e] * ov[e];
      ss += __shfl_xor(ss, 1); ss += __shfl_xor(ss, 2); ss += __shfl_xor(ss, 4); ss += __shfl_xor(ss, 8);
      const float rs = rsqrtf(ss * (1.f / 128.f) + EPS);
      u32x4 ow;
#pragma unroll
      for (int e = 0; e < 4; ++e) ow[e] = pack2(ov[2 * e] * rs * siluf_(bflo(gw[sw][e])), ov[2 * e + 1] * rs * siluf_(bfhi(gw[sw][e])));
      *(u32x4*)(cr + (size_t)sw * 32 * D) = ow;
    }
  }
}

DI void conv_rows8(KP p, int l, int row0, int tid, const float (&w0)[8], const float (&w1)[8], const float (&w2)[8]) {
  const int lane = tid & 63, row = row0 + (tid >> 6);
  const int ch = lane * 8;
  const u16* Z = (const u16*)(p.ws + WS_Z);
  u16* cat = (u16*)(p.ws + WS_CAT);
  int rm, rp; bool hm, hp_;
  if (row < NLAT) {
    const int t = row & 4095, gr = t >> 6, gc = t & 63;
    if (ch < 256) { hm = gc > 0; hp_ = gc < 63; rm = row - 1; rp = row + 1; }
    else { hm = gr > 0; hp_ = gr < 63; rm = row - 64; rp = row + 64; }
  } else {
    const int t = (row - NLAT) & 255;
    hm = t > 0; hp_ = t < 255; rm = row - 1; rp = row + 1;
  }
  if (!hm) rm = row;
  if (!hp_) rp = row;
  const u32x4 c0 = *(const u32x4*)(Z + (size_t)row * INC + 2560 + ch);
  const u32x4 cm = *(const u32x4*)(Z + (size_t)rm * INC + 2560 + ch);
  const u32x4 cp = *(const u32x4*)(Z + (size_t)rp * INC + 2560 + ch);
  const u32x4 bgv = *(const u32x4*)(Z + (size_t)row * INC + 3072 + ch);
  const float fm = hm ? 1.f : 0.f, fp = hp_ ? 1.f : 0.f;
  u32x4 o;
#pragma unroll
  for (int e = 0; e < 4; ++e) {
    float r2[2];
#pragma unroll
    for (int hh = 0; hh < 2; ++hh) {
      const float uc = hh ? bfhi(c0[e]) : bflo(c0[e]);
      const float um = hh ? bfhi(cm[e]) : bflo(cm[e]);
      const float up = hh ? bfhi(cp[e]) : bflo(cp[e]);
      const float bg = hh ? bfhi(bgv[e]) : bflo(bgv[e]);
      r2[hh] = bg * (w1[2 * e + hh] * uc + fm * w0[2 * e + hh] * um + fp * w2[2 * e + hh] * up);
    }
    o[e] = pack2(r2[0], r2[1]);
  }
  *(u32x4*)(cat + (size_t)row * D + 512 + ch) = o;
}

DI void phase_rec1(KP p, unsigned char* smem, int l, int bid, int nb, int tid) {
  for (int it = bid; it < 544; it += nb) rec_pass1(p, smem, l, it, tid);
  const float* cw = p.conv_w + (size_t)l * 3 * 512 + (tid & 63) * 8;
  const float4 w0a = *(const float4*)cw, w0b = *(const float4*)(cw + 4);
  const float4 w1a = *(const float4*)(cw + 512), w1b = *(const float4*)(cw + 516);
  const float4 w2a = *(const float4*)(cw + 1024), w2b = *(const float4*)(cw + 1028);
  const float w0[8] = {w0a.x, w0a.y, w0a.z, w0a.w, w0b.x, w0b.y, w0b.z, w0b.w};
  const float w1[8] = {w1a.x, w1a.y, w1a.z, w1a.w, w1b.x, w1b.y, w1b.z, w1b.w};
  const float w2[8] = {w2a.x, w2a.y, w2a.z, w2a.w, w2b.x, w2b.y, w2b.z, w2b.w};
  const int first = ((544 - bid + nb - 1) / nb) * nb + bid;
  for (int it = first; it < 544 + NTOK / 8; it += nb) conv_rows8(p, l, (it - 544) * 8, tid, w0, w1, w2);
}
DI void phase_rec3(KP p, unsigned char* smem, int l, int bid, int nb, int tid) {
  for (int q = bid; q < 512; q += nb) rec_pass3(p, smem, l, (q >> 5) * 34 + 2 + (q & 31), tid);
}
DI void phase_pass2(KP p, unsigned char* smem, int l, int bid, int nb, int tid) {
  const int nctx = (l == DEPTH - 1 || nb < 64) ? 0 : 32;
  if (bid < nctx) rec_pass3(p, smem, l, (bid >> 1) * 34 + (bid & 1), tid, true);
  else rec_pass2(p, bid - nctx, nb - nctx, tid);
  if (nb < 64 && l != DEPTH - 1) for (int q = bid; q < 32; q += nb) rec_pass3(p, smem, l, (q >> 1) * 34 + (q & 1), tid, true);
}

DI void phase_recpost(KP p, int l, int bid, int nb, int tid) {
  const int lane = tid & 63, wave = tid >> 6;
  const u16* OF = (const u16*)(p.ws + WS_OF);
  const u16* OB = (const u16*)(p.ws + WS_OB);
  const u16* Z = (const u16*)(p.ws + WS_Z);
  u16* cat = (u16*)(p.ws + WS_CAT);
  for (int row = bid * 8 + wave; row < NTOK; row += nb * 8) {
    const u32x4 af = *(const u32x4*)(OF + (size_t)row * 512 + lane * 8), ab = *(const u32x4*)(OB + (size_t)row * 512 + lane * 8);
    float o[8];
#pragma unroll
    for (int e = 0; e < 4; ++e) { o[2 * e] = bflo(af[e]) + bflo(ab[e]); o[2 * e + 1] = bfhi(af[e]) + bfhi(ab[e]); }
    float ss = 0.f;
#pragma unroll
    for (int e = 0; e < 8; ++e) ss += o[e] * o[e];
    ss += __shfl_xor(ss, 1); ss += __shfl_xor(ss, 2); ss += __shfl_xor(ss, 4); ss += __shfl_xor(ss, 8);
    const float rs = rsqrtf(ss * (1.f / 128.f) + EPS);
    const u32x4 gw = *(const u32x4*)(Z + (size_t)row * INC + 2048 + lane * 8);
    u32x4 ow;
#pragma unroll
    for (int e = 0; e < 4; ++e) {
      const float g0 = bflo(gw[e]), g1 = bfhi(gw[e]);
      ow[e] = pack2(o[2 * e] * rs * siluf_(g0), o[2 * e + 1] * rs * siluf_(g1));
    }
    *(u32x4*)(cat + (size_t)row * D + lane * 8) = ow;
  }
}

DI float gelu_erf(float x) { return 0.5f * x * (1.f + erff(x * 0.70710678118654752f)); }

using i32x4 = __attribute__((ext_vector_type(4))) int;
constexpr int PM_CF = 0, PM_WG = 32768, PM_HQ = 65536, PM_CM = 65536, PM_IB = 65536, PM_MISC = 133120;
DI unsigned pm_perm(unsigned hi, unsigned lo, unsigned sel) { return __builtin_amdgcn_perm(hi, lo, sel); }

DI void peer_vsweep16(KP p, int l, int row0, int tg, int nt_g, int nent, const unsigned* wg, const unsigned char* tkg, const unsigned char* cqg,
                      const unsigned* cmaxg, const unsigned char* VB, int col0, int npass, int lane) {
  const int i16 = lane & 15, kq = lane >> 4;
  const unsigned tsplat = (unsigned)i16 * 0x01010101u;
  const int nch = nent >> 5;
  const float* mod = (const float*)(p.ws + WS_MOD);
  float csc[4];
#pragma unroll
  for (int r = 0; r < 4; ++r) csc[r] = __uint_as_float(cmaxg[4 * kq + r]) * (1.f / 127.f);
#pragma unroll 1
  for (int cbp = 0; cbp < npass; ++cbp) {
    const int colb = col0 + 256 * cbp + 16 * i16;
    i32x4 acc[16];
#pragma unroll
    for (int c = 0; c < 16; ++c) acc[c] = (i32x4){0, 0, 0, 0};
    u32x4 x[8];
    if (nch > 0) {
      const u32x4 w0 = *(const u32x4*)(wg + 8 * kq), w1 = *(const u32x4*)(wg + 8 * kq + 4);
#pragma unroll
      for (int j = 0; j < 4; ++j) {
        x[j] = *(const u32x4*)(VB + (unsigned)(((w0[j] >> 8) & 0xfffffc00u) | (unsigned)colb));
        x[4 + j] = *(const u32x4*)(VB + (unsigned)(((w1[j] >> 8) & 0xfffffc00u) | (unsigned)colb));
      }
    }
#pragma unroll 1
    for (int c = 0; c < nch; ++c) {
      unsigned ylo[16], yhi[16];
#pragma unroll
      for (int w = 0; w < 4; ++w) {
        {
          const unsigned t0 = pm_perm(x[1][w], x[0][w], 0x05010400u), t1 = pm_perm(x[1][w], x[0][w], 0x07030602u);
          const unsigned t2 = pm_perm(x[3][w], x[2][w], 0x05010400u), t3 = pm_perm(x[3][w], x[2][w], 0x07030602u);
          ylo[4 * w + 0] = pm_perm(t2, t0, 0x05040100u); ylo[4 * w + 1] = pm_perm(t2, t0, 0x07060302u);
          ylo[4 * w + 2] = pm_perm(t3, t1, 0x05040100u); ylo[4 * w + 3] = pm_perm(t3, t1, 0x07060302u);
        }
        {
          const unsigned t0 = pm_perm(x[5][w], x[4][w], 0x05010400u), t1 = pm_perm(x[5][w], x[4][w], 0x07030602u);
          const unsigned t2 = pm_perm(x[7][w], x[6][w], 0x05010400u), t3 = pm_perm(x[7][w], x[6][w], 0x07030602u);
          yhi[4 * w + 0] = pm_perm(t2, t0, 0x05040100u); yhi[4 * w + 1] = pm_perm(t2, t0, 0x07060302u);
          yhi[4 * w + 2] = pm_perm(t3, t1, 0x05040100u); yhi[4 * w + 3] = pm_perm(t3, t1, 0x07060302u);
        }
      }
      const u32x2 tk8 = *(const u32x2*)(tkg + 32 * c + 8 * kq), cq8 = *(const u32x2*)(cqg + 32 * c + 8 * kq);
      const unsigned x0 = tk8[0] ^ tsplat, x1 = tk8[1] ^ tsplat;
      const unsigned z0 = ~(((x0 & 0x7f7f7f7fu) + 0x7f7f7f7fu) | x0) & 0x80808080u, z1 = ~(((x1 & 0x7f7f7f7fu) + 0x7f7f7f7fu) | x1) & 0x80808080u;
      const unsigned alo = cq8[0] & ((z0 - (z0 >> 7)) | z0), ahi = cq8[1] & ((z1 - (z1 >> 7)) | z1);
      const long av = (long)(((unsigned long long)ahi << 32) | alo);
      if (c + 1 < nch) {
        const u32x4 w0 = *(const u32x4*)(wg + 32 * (c + 1) + 8 * kq), w1 = *(const u32x4*)(wg + 32 * (c + 1) + 8 * kq + 4);
#pragma unroll
        for (int j = 0; j < 4; ++j) {
          x[j] = *(const u32x4*)(VB + (unsigned)(((w0[j] >> 8) & 0xfffffc00u) | (unsigned)colb));
          x[4 + j] = *(const u32x4*)(VB + (unsigned)(((w1[j] >> 8) & 0xfffffc00u) | (unsigned)colb));
        }
      }
#pragma unroll
      for (int cc = 0; cc < 16; ++cc) {
        const long bv = (long)(((unsigned long long)yhi[cc] << 32) | ylo[cc]);
        acc[cc] = __builtin_amdgcn_mfma_i32_16x16x32_i8(av, bv, acc[cc], 0, 0, 0);
      }
    }
#pragma unroll
    for (int r = 0; r < 4; ++r) {
      const int m = 4 * kq + r;
      if (m < nt_g) {
        const int row = row0 + tg * 16 + m;
        const float* g2p = mod + ((size_t)l * 5 + row_cls(row)) * 6144 + 5120 + colb;
        u16* xr = (u16*)(p.ws + WS_XW) + (size_t)row * D + colb;
#pragma unroll
        for (int hh = 0; hh < 2; ++hh) {
          u32x4 xw4 = *(const u32x4*)(xr + 8 * hh);
#pragma unroll
          for (int q = 0; q < 2; ++q) {
            const float4 gv = *(const float4*)(g2p + 8 * hh + q * 4);
            xw4[2 * q] = pack2(bflo(xw4[2 * q]) + gv.x * csc[r] * (float)acc[8 * hh + q * 4 + 0][r], bfhi(xw4[2 * q]) + gv.y * csc[r] * (float)acc[8 * hh + q * 4 + 1][r]);
            xw4[2 * q + 1] = pack2(bflo(xw4[2 * q + 1]) + gv.z * csc[r] * (float)acc[8 * hh + q * 4 + 2][r], bfhi(xw4[2 * q + 1]) + gv.w * csc[r] * (float)acc[8 * hh + q * 4 + 3][r]);
          }
          *(u32x4*)(xr + 8 * hh) = xw4;
        }
      }
    }
  }
}

DI void peer_mfma_pass(KP p, unsigned char* smem, int l, int row0, int ntok, int tid) {
  const int lane = tid & 63, wave = __builtin_amdgcn_readfirstlane(tid >> 6);
  const int ngroups = (ntok + 15) >> 4;
  const int nwg = ngroups >= 4 ? 2 : 8;
  const int tg = ngroups >= 4 ? (wave >> 1) : 0, ch = ngroups >= 4 ? (wave & 1) : wave;
  float* CF = (float*)(smem + PM_CF);
  unsigned* WG = (unsigned*)(smem + PM_WG);
  unsigned char* HQ = smem + PM_HQ;
  unsigned short* CM = (unsigned short*)(smem + PM_CM);
  unsigned* CNT = (unsigned*)(smem + PM_MISC);
  float* HS = (float*)(smem + PM_MISC) + 128;
  unsigned* CMAX = (unsigned*)(smem + PM_MISC) + 192;
  float* SS = (float*)(smem + PM_MISC) + 256;
  const unsigned char* UB = p.ws + WS_UB + (size_t)l * NEXP * D;
  const unsigned char* VB = p.ws + WS_VB + (size_t)l * NEXP * D;
  const float* US = (const float*)(p.ws + WS_US) + (size_t)l * NEXP;
  const float* VS = (const float*)(p.ws + WS_VS) + (size_t)l * NEXP;
  const float* mod = (const float*)(p.ws + WS_MOD);
#ifdef PROBE_ABC
#pragma unroll 1
  for (int arep = 0; arep < 2; ++arep) {
#endif
  if (tid < 128) CNT[tid] = 0u;
  if (tid < 64) { CMAX[tid] = 0u; SS[tid] = 0.f; }
  __syncthreads();
  unsigned ent[16], slot[16];
  const bool actA = tid < ntok * 8;
  if (actA) {
    const int t = tid >> 3, head = tid & 7;
    unsigned char* IB = smem + PM_IB + tid * 32;
    const unsigned* t1 = (const unsigned*)(p.ws + WS_TOPK) + ((size_t)(row0 + t) * 16 + head * 2) * 16;
    float s1[16], s2[16];
#pragma unroll
    for (int q = 0; q < 4; ++q) {
      const u32x4 a = *(const u32x4*)(t1 + q * 4), b = *(const u32x4*)(t1 + 16 + q * 4);
#pragma unroll
      for (int e = 0; e < 4; ++e) {
        s1[q * 4 + e] = __uint_as_float(a[e]); s2[q * 4 + e] = __uint_as_float(b[e]);
        IB[q * 4 + e] = (unsigned char)(127u - (a[e] & 127u));
        IB[16 + q * 4 + e] = (unsigned char)(127u - (b[e] & 127u));
      }
    }
    float t16[16];
#pragma unroll
    for (int i = 0; i < 16; ++i) t16[i] = __uint_as_float(0xff800000u);
#pragma unroll
    for (int i = 0; i < 16; ++i)
#pragma unroll
      for (int j = 0; j < 16; ++j)
        if ((i + 1) * (j + 1) <= 16) {
          const float sm = s1[i] + s2[j];
          const float x = __uint_as_float((__float_as_uint(sm) & ~0xffu) | (unsigned)(255 - (i * 16 + j)));
#pragma unroll
          for (int q = 15; q >= 1; --q) t16[q] = __builtin_amdgcn_fmed3f(x, t16[q - 1], t16[q]);
          t16[0] = fmaxf(t16[0], x);
        }
    float den = 0.f;
#pragma unroll
    for (int i = 0; i < 16; ++i) den += __expf(t16[i] - t16[0]);
    const float inv = 16383.f / den;
    const unsigned mtag = (unsigned)(t & 15) << 14;
    unsigned* cg = CNT + (t >> 4) * 32;
#pragma unroll
    for (int i = 0; i < 16; ++i) {
      const unsigned ci = 255u - (__float_as_uint(t16[i]) & 255u);
      const unsigned i1 = IB[ci >> 4], i2 = IB[16 + (ci & 15)];
      const unsigned gq = (unsigned)(int)rintf(__expf(t16[i] - t16[0]) * inv);
      const unsigned en = ((i1 * 128u + i2) << 18) | mtag | gq;
      ent[i] = en;
      slot[i] = atomicAdd(&cg[en >> 27], 1u);
    }
  }
  __syncthreads();
  if (tid < 128) {
    const unsigned c = CNT[tid];
    unsigned inc = c;
#pragma unroll
    for (int o = 1; o < 32; o <<= 1) { const unsigned v = __shfl_up(inc, o); if ((lane & 31) >= o) inc += v; }
    CNT[tid] = inc - c;
  }
  __syncthreads();
  if (actA) {
    const int t = tid >> 3;
    unsigned* wg = WG + (t >> 4) * 2048;
    const unsigned* cg = CNT + (t >> 4) * 32;
#pragma unroll
    for (int i = 0; i < 16; ++i) wg[cg[ent[i] >> 27] + slot[i]] = ent[i];
  }
  __syncthreads();
#pragma unroll 1
  for (int i = 0; i < 8; ++i) {
    const int t = wave * 8 + i;
    if (t < ntok) {
      const u32x4 pk = *(const u32x4*)(p.ws + WS_HXQ + (size_t)(row0 + t) * D + lane * 16);
      const float sc = ((const float*)(p.ws + WS_HXS))[row0 + t];
      *(u32x4*)(HQ + t * 1024 + lane * 16) = pk;
      if (lane == 0) HS[t] = sc;
    }
  }
  __syncthreads();
#ifdef PROBE_ABC
  }
#endif
  const bool gact = tg < ngroups;
  const int nt_g = gact ? ((ntok - tg * 16) < 16 ? (ntok - tg * 16) : 16) : 0;
  const int nent = nt_g * 128;
  const unsigned* wg = WG + tg * 2048;
  float* cfg = CF + tg * 2048;
  const int mrow = lane & 15, kq = lane >> 4;
  i32x4 areg[16];
  if (gact) {
    const int tsrc = (mrow < nt_g) ? (tg * 16 + mrow) : (tg * 16);
#pragma unroll
    for (int s2 = 0; s2 < 16; ++s2) areg[s2] = *(const i32x4*)(HQ + tsrc * 1024 + 64 * s2 + 16 * kq);
  }
  __syncthreads();
#ifdef PROBE_U2
#pragma unroll 1
  for (int urep = 0; urep < 2; ++urep)
#endif
  if (gact) {
#ifdef PROBE_U2
    const unsigned uemask = urep == 0 ? PROBE_EMASK : 0xffffffffu;
#else
    const unsigned uemask = 0xffffffffu;
#endif
    unsigned char* ust = smem + PM_HQ + wave * 8448;
    const int nch = nent >> 4;
    const int hrow = lane >> 5, l32 = lane & 31;
    u32x4 rr[8];
    unsigned eo[8];
    auto ent = [&](int k0) {
#pragma unroll
      for (int j = 0; j < 8; ++j) eo[j] = ((wg[k0 + 2 * j + hrow] & uemask) >> 8) & 0xfffffc00u;
    };
    auto glh = [&](int kh) {
#pragma unroll
      for (int j = 0; j < 8; ++j) rr[j] = *(const u32x4*)(UB + (unsigned)(eo[j] + (unsigned)(kh * 512 + l32 * 16)));
    };
    if (ch < nch) { ent(16 * ch); glh(0); }
#pragma unroll 1
    for (int c = ch; c < nch; c += nwg) {
      const unsigned en_cur = wg[16 * c + mrow];
      const unsigned e = en_cur >> 18;
      const float us = US[e], vs = VS[e];
      i32x4 dd = {0, 0, 0, 0};
#pragma unroll
      for (int j = 0; j < 8; ++j) *(u32x4*)(ust + (2 * j + hrow) * 528 + l32 * 16) = rr[j];
      glh(1);
#pragma unroll
      for (int s2 = 0; s2 < 8; ++s2) {
        const i32x4 b = *(const i32x4*)(ust + mrow * 528 + 64 * s2 + 16 * kq);
        dd = __builtin_amdgcn_mfma_i32_16x16x64_i8(areg[s2], b, dd, 0, 0, 0);
      }
#pragma unroll
      for (int j = 0; j < 8; ++j) *(u32x4*)(ust + (2 * j + hrow) * 528 + l32 * 16) = rr[j];
      if (c + nwg < nch) { ent(16 * (c + nwg)); glh(0); }
#pragma unroll
      for (int s2 = 0; s2 < 8; ++s2) {
        const i32x4 b = *(const i32x4*)(ust + mrow * 528 + 64 * s2 + 16 * kq);
        dd = __builtin_amdgcn_mfma_i32_16x16x64_i8(areg[8 + s2], b, dd, 0, 0, 0);
      }
      const int mp = (int)((en_cur >> 14) & 15u);
      if ((mp >> 2) == kq) {
        const int r = mp & 3;
        const int dv = r == 0 ? dd[0] : r == 1 ? dd[1] : r == 2 ? dd[2] : dd[3];
        const float dot = us * HS[tg * 16 + mp] * (float)dv;
        const float cf = (float)(en_cur & 0x3fffu) * (1.f / 16383.f) * gelu_erf(dot) * vs;
        cfg[16 * c + mrow] = cf;
        atomicMax(&CMAX[tg * 16 + mp], __float_as_uint(fabsf(cf)));
      }
    }
  }
  __syncthreads();
  for (int k = tid; k < ngroups * 2048; k += NTHR) {
    const int g2 = k >> 11;
    const int ntg = (ntok - g2 * 16) < 16 ? (ntok - g2 * 16) : 16;
    if ((k & 2047) < ntg * 128) {
      const unsigned en = WG[k];
      const unsigned m = (en >> 14) & 15u;
      const float cmx = __uint_as_float(CMAX[g2 * 16 + m]);
      const float q = cmx > 0.f ? rintf(CF[k] * (127.f / cmx)) : 0.f;
      ((unsigned char*)CM)[k] = (unsigned char)m; ((unsigned char*)CM)[8192 + k] = (unsigned char)(((unsigned)(int)q) & 0xffu);
    }
  }
  __syncthreads();
  if (gact && nwg == 2) peer_vsweep16(p, l, row0, tg, nt_g, nent, wg, (const unsigned char*)CM + tg * 2048, (const unsigned char*)CM + 8192 + tg * 2048, CMAX + tg * 16, VB, 512 * ch, 2, lane);
  if (gact && nwg != 2) {
    const int i16 = lane & 15, kq = lane >> 4;
    const unsigned char* tkg = (const unsigned char*)CM + tg * 2048;
    const unsigned char* cqg = (const unsigned char*)CM + 8192 + tg * 2048;
    const unsigned tsplat = (unsigned)i16 * 0x01010101u;
    const int nch = nent >> 5;
    float csc[4];
#pragma unroll
    for (int r = 0; r < 4; ++r) csc[r] = __uint_as_float(CMAX[tg * 16 + 4 * kq + r]) * (1.f / 127.f);
#pragma unroll 1
    for (int cbp = 0; cbp < 8 / nwg; ++cbp) {
      const int colb = (1024 / nwg) * ch + 128 * cbp + 8 * i16;
      i32x4 acc[8];
#ifdef PROBE_V2
#pragma unroll 1
      for (int vrep = 0; vrep < 2; ++vrep) {
      const unsigned vemask = vrep == 0 ? PROBE_EMASK : 0xffffffffu;
#else
      const unsigned vemask = 0xffffffffu;
#endif
#pragma unroll
      for (int c = 0; c < 8; ++c) acc[c] = (i32x4){0, 0, 0, 0};
      u32x2 x[8];
      if (nch > 0) {
        const u32x4 w0 = *(const u32x4*)(wg + 8 * kq), w1 = *(const u32x4*)(wg + 8 * kq + 4);
#pragma unroll
        for (int j = 0; j < 4; ++j) {
          x[j] = *(const u32x2*)(VB + (unsigned)((((w0[j] & vemask) >> 8) & 0xfffffc00u) | (unsigned)colb));
          x[4 + j] = *(const u32x2*)(VB + (unsigned)((((w1[j] & vemask) >> 8) & 0xfffffc00u) | (unsigned)colb));
        }
      }
#pragma unroll 1
      for (int c = 0; c < nch; ++c) {
        unsigned ylo[8], yhi[8];
#pragma unroll
        for (int w = 0; w < 2; ++w) {
          {
            const unsigned t0 = pm_perm(x[1][w], x[0][w], 0x05010400u), t1 = pm_perm(x[1][w], x[0][w], 0x07030602u);
            const unsigned t2 = pm_perm(x[3][w], x[2][w], 0x05010400u), t3 = pm_perm(x[3][w], x[2][w], 0x07030602u);
            ylo[4 * w + 0] = pm_perm(t2, t0, 0x05040100u); ylo[4 * w + 1] = pm_perm(t2, t0, 0x07060302u);
            ylo[4 * w + 2] = pm_perm(t3, t1, 0x05040100u); ylo[4 * w + 3] = pm_perm(t3, t1, 0x07060302u);
          }
          {
            const unsigned t0 = pm_perm(x[5][w], x[4][w], 0x05010400u), t1 = pm_perm(x[5][w], x[4][w], 0x07030602u);
            const unsigned t2 = pm_perm(x[7][w], x[6][w], 0x05010400u), t3 = pm_perm(x[7][w], x[6][w], 0x07030602u);
            yhi[4 * w + 0] = pm_perm(t2, t0, 0x05040100u); yhi[4 * w + 1] = pm_perm(t2, t0, 0x07060302u);
            yhi[4 * w + 2] = pm_perm(t3, t1, 0x05040100u); yhi[4 * w + 3] = pm_perm(t3, t1, 0x07060302u);
          }
        }
        const u32x2 tk8 = *(const u32x2*)(tkg + 32 * c + 8 * kq), cq8 = *(const u32x2*)(cqg + 32 * c + 8 * kq);
        unsigned alo, ahi;
        {
          const unsigned x0 = tk8[0] ^ tsplat, x1 = tk8[1] ^ tsplat;
          const unsigned z0 = ~(((x0 & 0x7f7f7f7fu) + 0x7f7f7f7fu) | x0) & 0x80808080u, z1 = ~(((x1 & 0x7f7f7f7fu) + 0x7f7f7f7fu) | x1) & 0x80808080u;
          alo = cq8[0] & ((z0 - (z0 >> 7)) | z0); ahi = cq8[1] & ((z1 - (z1 >> 7)) | z1);
        }
        if (c + 1 < nch) {
          const u32x4 w0 = *(const u32x4*)(wg + 32 * (c + 1) + 8 * kq), w1 = *(const u32x4*)(wg + 32 * (c + 1) + 8 * kq + 4);
#pragma unroll
          for (int j = 0; j < 4; ++j) {
            x[j] = *(const u32x2*)(VB + (unsigned)((((w0[j] & vemask) >> 8) & 0xfffffc00u) | (unsigned)colb));
            x[4 + j] = *(const u32x2*)(VB + (unsigned)((((w1[j] & vemask) >> 8) & 0xfffffc00u) | (unsigned)colb));
          }
        }
        const long av = (long)(((unsigned long long)ahi << 32) | alo);
#pragma unroll
        for (int cc = 0; cc < 8; ++cc) {
          const long bv = (long)(((unsigned long long)yhi[cc] << 32) | ylo[cc]);
          acc[cc] = __builtin_amdgcn_mfma_i32_16x16x32_i8(av, bv, acc[cc], 0, 0, 0);
        }
      }
#ifdef PROBE_V2
      }
#endif
#pragma unroll
      for (int r = 0; r < 4; ++r) {
        const int m = 4 * kq + r;
        if (m < nt_g) {
          const int row = row0 + tg * 16 + m;
          const float* g2p = mod + ((size_t)l * 5 + row_cls(row)) * 6144 + 5120 + colb;
          u16* xr = (u16*)(p.ws + WS_XW) + (size_t)row * D + colb;
          u32x4 xw4 = *(const u32x4*)xr;
#pragma unroll
          for (int q = 0; q < 2; ++q) {
            const float4 gv = *(const float4*)(g2p + q * 4);
            xw4[2 * q] = pack2(bflo(xw4[2 * q]) + gv.x * csc[r] * (float)acc[q * 4 + 0][r], bfhi(xw4[2 * q]) + gv.y * csc[r] * (float)acc[q * 4 + 1][r]);
            xw4[2 * q + 1] = pack2(bflo(xw4[2 * q + 1]) + gv.z * csc[r] * (float)acc[q * 4 + 2][r], bfhi(xw4[2 * q + 1]) + gv.w * csc[r] * (float)acc[q * 4 + 3][r]);
          }
          *(u32x4*)xr = xw4;
        }
      }
    }
  }
  asm volatile("s_waitcnt vmcnt(0)" ::: "memory");
  __syncthreads();
  __builtin_amdgcn_fence(__ATOMIC_ACQUIRE, "workgroup");
  asm volatile("s_waitcnt vmcnt(0)" ::: "memory");
  float ga2[16], sha2[16];
  {
    const int cls0 = row_cls(row0);
    const float* ng = (l < DEPTH - 1) ? p.norm1_g + (size_t)(l + 1) * D + lane * 16 : p.final_g + lane * 16;
    const float* mr = mod + ((size_t)((l < DEPTH - 1) ? l + 1 : l) * 5 + cls0) * 6144 + lane * 16;
#pragma unroll
    for (int q = 0; q < 4; ++q) {
      const float4 n4 = *(const float4*)(ng + q * 4);
      float4 sc4 = make_float4(0.f, 0.f, 0.f, 0.f), sh4 = sc4;
      if (l < DEPTH - 1) { sc4 = *(const float4*)(mr + 1024 + q * 4); sh4 = *(const float4*)(mr + q * 4); }
      ga2[q * 4] = n4.x * (1.f + sc4.x); ga2[q * 4 + 1] = n4.y * (1.f + sc4.y); ga2[q * 4 + 2] = n4.z * (1.f + sc4.z); ga2[q * 4 + 3] = n4.w * (1.f + sc4.w);
      sha2[q * 4] = sh4.x; sha2[q * 4 + 1] = sh4.y; sha2[q * 4 + 2] = sh4.z; sha2[q * 4 + 3] = sh4.w;
    }
  }
#pragma unroll 1
  for (int i = 0; i < 8; ++i) {
    const int t = wave * 8 + i;
    if (t < ntok) {
      const int row = row0 + t;
      const u16* xr = (const u16*)(p.ws + WS_XW) + (size_t)row * D + lane * 16;
      float xn[16];
      float ssq = 0.f;
      {
        const u32x4 w0 = *(const u32x4*)xr, w1 = *(const u32x4*)(xr + 8);
#pragma unroll
        for (int e = 0; e < 4; ++e) { xn[2 * e] = bflo(w0[e]); xn[2 * e + 1] = bfhi(w0[e]); xn[8 + 2 * e] = bflo(w1[e]); xn[8 + 2 * e + 1] = bfhi(w1[e]); }
#pragma unroll
        for (int e = 0; e < 16; ++e) ssq += xn[e] * xn[e];
      }
      ssq = wave_sum(ssq);
      const float rs = rsqrtf(ssq * (1.f / 1024.f) + EPS);
      if (l < DEPTH - 1) {
        float y[16];
#pragma unroll
        for (int e = 0; e < 16; ++e) y[e] = xn[e] * rs * ga2[e] + sha2[e];
        {
          float am = 0.f;
#pragma unroll
          for (int e = 0; e < 16; ++e) am = fmaxf(am, fabsf(y[e]));
#pragma unroll
          for (int o2 = 32; o2 >= 1; o2 >>= 1) am = fmaxf(am, __shfl_xor(am, o2));
          const float qs = am > 0.f ? am * (1.f / 127.f) : 1.f, qi = 1.f / qs;
          u32x4 oq;
#pragma unroll
          for (int q = 0; q < 4; ++q) {
            unsigned w = 0;
#pragma unroll
            for (int e = 0; e < 4; ++e) w |= (((unsigned)(int)rintf(y[q * 4 + e] * qi)) & 0xffu) << (8 * e);
            oq[q] = w;
          }
          *(u32x4*)(p.ws + WS_HXQ + (size_t)row * D + lane * 16) = oq;
          if (lane == 0) ((float*)(p.ws + WS_HXS))[row] = qs;
        }
      } else {
        float* orow = p.out + (size_t)row * D + lane * 16;
#pragma unroll
        for (int q = 0; q < 4; ++q) {
          *(float4*)(orow + q * 4) = make_float4(xn[q * 4] * rs * ga2[q * 4], xn[q * 4 + 1] * rs * ga2[q * 4 + 1], xn[q * 4 + 2] * rs * ga2[q * 4 + 2], xn[q * 4 + 3] * rs * ga2[q * 4 + 3]);
        }
      }
    }
  }
  __syncthreads();
}

DI void phase_peer_mfma(KP p, unsigned char* smem, int l, int bid, int nb, int tid) {
  const int npass = (l < DEPTH - 1) ? 2 : 1;
#pragma unroll 1
  for (int ps = 0; ps < npass; ++ps) {
    const int nt = ps == 0 ? 64 : 4;
    const int base = ps == 0 ? 0 : NLAT, lim = ps == 0 ? NLAT : NTOK;
#pragma unroll 1
    for (int r0 = base + bid * nt; r0 < lim; r0 += nb * nt) peer_mfma_pass(p, smem, l, r0, nt, tid);
  }
}

constexpr int PH_PER_LAYER = 8;
constexpr int N_PHASES = 2 + DEPTH * PH_PER_LAYER;
constexpr int SMEM_BYTES = 256 * 132 * 4;

#ifndef ONLYMASK
#define ONLYMASK 0xffff
#endif
#define PHON(x) ((ONLYMASK >> (x)) & 1)
DI void run_phase(KP p, unsigned char* smem, int ph, int bid, int nb, int tid) {
  if (ph == 0) { if (PHON(10)) phase_p0a(p, (float*)smem, bid, nb, tid); return; }
  if (ph == 1) { if (PHON(4)) { phase_norm<true>(p, p.norm1_g, 0, 0, 1024, bid, nb, NTOK, tid, true); phase_rowq(p, WS_WS, WS_WSQ, WS_WSS, 4 * 2048, bid, nb, tid); phase_rowq(p, WS_WIN, WS_WINQ, WS_WINS, 4 * 4096, bid, nb, tid, true); } return; }
  const int l = (ph - 2) / PH_PER_LAYER, s = (ph - 2) % PH_PER_LAYER;
  const bool last = (l == DEPTH - 1);
  switch (s) {
    case 0: if (PHON(0)) gemm8_phase<G8_Z>(p, smem, (const u16*)(p.ws + WS_HX), (const u16*)(p.ws + WS_WIN) + (size_t)l * 4096 * 1024, 4096, 1024, l, bid, nb, NTOK / 256, tid); break;
    case 1: if (PHON(7)) phase_rec1(p, smem, l, bid, nb, tid); break;
    case 2: if (PHON(8)) phase_pass2(p, smem, l, bid, nb, tid); break;
    case 3: if (PHON(9)) phase_rec3(p, smem, l, bid, nb, tid); break;
    case 4: if (PHON(3)) gemm8_phase<G8_RES>(p, smem, (const u16*)(p.ws + WS_CAT), (const u16*)(p.ws + WS_WOUT) + (size_t)l * 1024 * 1024, 1024, 1024, l, bid, nb, last ? NLAT / 256 : NTOK / 256, tid); break;
    case 5: if (PHON(4)) phase_norm(p, p.norm2_g + (size_t)l * D, l, 3072, 4096, bid, nb, last ? NLAT : NTOK, tid, true); break;
    case 6: if (PHON(5)) gemm8_phase<G8_TOPK>(p, smem, (const u16*)(p.ws + WS_HX), (const u16*)(p.ws + WS_WS) + (size_t)l * 2048 * 1024, 2048, 1024, l, bid, nb, last ? NLAT / 256 : NTOK / 256, tid); break;
    case 7: if (PHON(6)) phase_peer_mfma(p, smem, l, bid, nb, tid); break;
  }
}


#define XB_TMO      128
#define XB_XCNT(j)  (256  + 64 * (j))
#define XB_XSUB(j)  (1280 + 64 * (j))
#define XB_XGEN(j)  (2304 + 64 * (j))
#define XB_TOP      3328
#define XB_TOPGEN   3392
#define XCD_BAR_WORDS 3456
#define XB_SPIN_CAP (1u << 22)
#define LAS __attribute__((address_space(3)))
DI unsigned xb_ld(unsigned* p)              { return __hip_atomic_load(p, __ATOMIC_RELAXED, __HIP_MEMORY_SCOPE_AGENT); }
DI unsigned xb_add(unsigned* p, unsigned v) { return __hip_atomic_fetch_add(p, v, __ATOMIC_RELAXED, __HIP_MEMORY_SCOPE_AGENT); }
DI unsigned xb_xcc_id() { return (unsigned)__builtin_amdgcn_s_getreg((3 << 11) | 20) & 0xFu; }
#define XB_SPIN(cond, bar) do { unsigned _sp = 0; while (cond) { __builtin_amdgcn_s_sleep(1); \
    if ((++_sp & 255u) == 0u) { if (xb_ld(&(bar)[XB_TMO])) break; if (_sp > XB_SPIN_CAP) { atomicAdd(&(bar)[XB_TMO], 1u); break; } } } } while (0)
struct XcdBarrier { unsigned* bar; unsigned x; volatile LAS unsigned* st; };
DI XcdBarrier xcd_barrier_post(unsigned* bar, volatile LAS unsigned* st) {
  XcdBarrier b; b.bar = bar; b.x = xb_xcc_id(); b.st = st;
  if (threadIdx.x == 0) (void)xb_add(&bar[XB_XCNT(b.x)], 1u);
  return b;
}
DI void xcd_barrier_complete(unsigned* bar, unsigned x, unsigned& nloc, unsigned& nx) {
  const unsigned G = gridDim.x * gridDim.y * gridDim.z;
  unsigned sum, cnt, mine, sp = 0u;
  for (;;) {
    sum = 0u; cnt = 0u; mine = 0u;
#pragma unroll
    for (unsigned j = 0; j < 16; ++j) { const unsigned c = xb_ld(&bar[XB_XCNT(j)]); sum += c; cnt += (c > 0u) ? 1u : 0u; mine = (j == x) ? c : mine; }
    if (sum == G) break;
    __builtin_amdgcn_s_sleep(1);
    if ((++sp & 255u) == 0u) { if (xb_ld(&bar[XB_TMO])) break; if (sp > XB_SPIN_CAP) { atomicAdd(&bar[XB_TMO], 1u); break; } }
  }
  nloc = mine > 0u ? mine : 1u; nx = cnt > 0u ? cnt : 1u;
}
DI void xcd_barrier(const XcdBarrier& b) {
  asm volatile("s_waitcnt vmcnt(0)" ::: "memory");
  __syncthreads();
  if (threadIdx.x == 0) {
    unsigned* bar = b.bar;
    __builtin_amdgcn_s_waitcnt(0);
    unsigned nloc = b.st[0], nx = b.st[1];
    if (nloc == 0u) { xcd_barrier_complete(bar, b.x, nloc, nx); b.st[0] = nloc; b.st[1] = nx; }
    const unsigned old = xb_add(&bar[XB_XSUB(b.x)], 1u);
    const unsigned gen = old / nloc;
    if (old + 1u == (gen + 1u) * nloc) {
      __builtin_amdgcn_fence(__ATOMIC_RELEASE, "agent");
      asm volatile("s_waitcnt vmcnt(0)" ::: "memory");
      const unsigned og = xb_add(&bar[XB_TOP], 1u);
      const unsigned tg = og / nx;
      asm volatile("buffer_inv sc1" ::: "memory");
      if (og + 1u == (tg + 1u) * nx) xb_add(&bar[XB_TOPGEN], 1u);
      else XB_SPIN(xb_ld(&bar[XB_TOPGEN]) == tg, bar);
      xb_add(&bar[XB_XGEN(b.x)], 1u);
      asm volatile("s_waitcnt vmcnt(0)" ::: "memory");
    } else {
      asm volatile("buffer_inv sc1" ::: "memory");
      XB_SPIN(xb_ld(&bar[XB_XGEN(b.x)]) == gen, bar);
      asm volatile("s_waitcnt vmcnt(0)" ::: "memory");
    }
  }
  __syncthreads();
}

typedef const Params __attribute__((address_space(4)))* KArgs;

__global__ void __launch_bounds__(NTHR, 2) mega_kernel(Params p_unused) {
#if defined(__HIP_DEVICE_COMPILE__)
  __shared__ __attribute__((aligned(16))) unsigned char smem[SMEM_BYTES + 16];
  KArgs ka = (KArgs)__builtin_amdgcn_kernarg_segment_ptr();
  const int ph_lo = ka->ph_lo, ph_hi = ka->ph_hi;
#if !MULTI_LAUNCH
  cg::grid_group grid = cg::this_grid();
  volatile LAS unsigned* xbw = (volatile LAS unsigned*)(smem + SMEM_BYTES);
  if (threadIdx.x == 0) { xbw[0] = 0u; xbw[1] = 0u; }
  __syncthreads();
  XcdBarrier xb = xcd_barrier_post((unsigned*)(ka->ws + WS_BAR), xbw);
#endif
  int rep = 0;
  const int wave_s = __builtin_amdgcn_readfirstlane((int)(threadIdx.x >> 6));
  for (int ph = ph_lo; ph < ph_hi;) {
    int tid = wave_s * 64 + (int)__builtin_amdgcn_mbcnt_hi(~0u, __builtin_amdgcn_mbcnt_lo(~0u, 0u)), bid = blockIdx.x, nb = gridDim.x;
    KArgs kq = ka;
    asm volatile("" : "+v"(tid), "+s"(bid), "+s"(nb), "+s"(kq));
#ifdef AMP_K
    if (AMP_COND(ph) && threadIdx.x == 0) *(volatile LAS unsigned long long*)(smem + SMEM_BYTES + 8) = wall_clock64();
#endif
    run_phase(*kq, smem, ph, bid, nb, tid);
    bool again = false;
#ifdef REPEAT_S
    if (rep == 0 && ((ph >= 2 && (ph - 2) % PH_PER_LAYER == REPEAT_S) || (REPEAT_S == 100 && ph == 0))) again = true;
#endif
#if !MULTI_LAUNCH
    if (again || ph + 1 < ph_hi) { if (ph_lo < 0) grid.sync(); xcd_barrier(xb); }
#endif
#ifdef AMP_K
    if (AMP_COND(ph)) {
      if (threadIdx.x == 0) {
        const unsigned long long t0 = *(volatile LAS unsigned long long*)(smem + SMEM_BYTES + 8), t1 = wall_clock64();
        const unsigned long long dt = (t1 - t0) * AMP_K;
        while (wall_clock64() - t1 < dt) __builtin_amdgcn_s_sleep(8);
      }
      __syncthreads();
    }
#endif
    if (again) rep = 1; else { rep = 0; ++ph; }
  }
#endif
}

extern "C" void kernel_launch(void* const* d_in, const int* in_sizes, int n_in, void* d_out, int out_size, void* d_ws, size_t ws_size, hipStream_t stream) {
  static int grid = 0;
  if (grid == 0) {
    if (n_in != 17 || ws_size < WS_END) { fprintf(stderr, "kernel_launch: unexpected n_in %d or ws_size %zu (need %zu)\n", n_in, ws_size, (size_t)WS_END); grid = -1; return; }
    int dev = 0, cus = 0, per_cu = 0;
    hipGetDevice(&dev);
    hipDeviceGetAttribute(&cus, hipDeviceAttributeMultiprocessorCount, dev);
    hipOccupancyMaxActiveBlocksPerMultiprocessor(&per_cu, (const void*)mega_kernel, NTHR, 0);
    if (per_cu < 1) { fprintf(stderr, "kernel_launch: occupancy query says %d blocks per CU\n", per_cu); grid = -1; return; }
    grid = cus;
  }
  if (grid < 0) return;
  Params p{};
  p.x = (const float*)d_in[0]; p.c = (const float*)d_in[1]; p.ctx = (const float*)d_in[2]; p.c_ctx = (const float*)d_in[3];
  p.w_mod = (const float*)d_in[4]; p.b_mod = (const float*)d_in[5]; p.norm1_g = (const float*)d_in[6]; p.norm2_g = (const float*)d_in[7];
  p.w_in = (const float*)d_in[8]; p.conv_w = (const float*)d_in[9]; p.w_out = (const float*)d_in[10]; p.lb_logits = (const float*)d_in[11];
  p.peer_wq = (const float*)d_in[12]; p.peer_subkeys = (const float*)d_in[13]; p.peer_u = (const float*)d_in[14]; p.peer_v = (const float*)d_in[15];
  p.final_g = (const float*)d_in[16]; p.out = (float*)d_out; p.ws = (unsigned char*)d_ws;
#if MULTI_LAUNCH
  for (int ph = 0; ph < N_PHASES; ++ph) {
    p.ph_lo = ph; p.ph_hi = ph + 1;
    hipLaunchKernelGGL(mega_kernel, dim3(grid), dim3(NTHR), 0, stream, p);
  }
#else
  p.ph_lo = 0; p.ph_hi = N_PHASES;
  if (hipMemsetAsync((char*)d_ws + WS_BAR, 0, 16384, stream) != hipSuccess) { fprintf(stderr, "kernel_launch: memset of barrier words failed\n"); return; }
  void* args[] = {&p};
  hipError_t e = hipLaunchCooperativeKernel((const void*)mega_kernel, dim3(grid), dim3(NTHR), args, 0, stream);
  if (e != hipSuccess) fprintf(stderr, "cooperative launch failed: %s (grid %d)\n", hipGetErrorString(e), grid);
#endif
}
```
